# Optimizing an MI355X kernel written in HIP

```python
import math
import jax
import jax.numpy as jnp
from jax import lax
import numpy as np

D_MODEL = 1024
BATCH = 16
SEQ = 4096
DEPTH = 2

EPS = 1e-6
N_BRANCH = 3
GDN_HEADS = 4
GDN_DK = 128
GDN_DV = 128
GDN_CONV = 4
GDN_CHUNK = 64
GDN_KEY_W = GDN_HEADS * GDN_DK
GDN_VAL_W = GDN_HEADS * GDN_DV
HGRN_HEADS = 4
HGRN_DK = 128
HGRN_DV = 128
HGRN_CHUNK = 16
HGRN_KEY_W = HGRN_HEADS * HGRN_DK
HGRN_VAL_W = HGRN_HEADS * HGRN_DV
SSD_HEADS = 8
SSD_HEAD_DIM = 64
SSD_GROUPS = 2
SSD_HEADS_PER_GROUP = SSD_HEADS // SSD_GROUPS
SSD_STATE = 128
SSD_CONV = 4
SSD_CHUNK = 64
SSD_INNER = SSD_HEADS * SSD_HEAD_DIM
SSD_XBC_W = SSD_INNER + 2 * SSD_GROUPS * SSD_STATE
FFN_HIDDEN = 2816
FFN_CONV = 3

SPLIT_SIZES = (
    2 * GDN_KEY_W + GDN_VAL_W,
    GDN_HEADS,
    GDN_HEADS,
    GDN_VAL_W,
    HGRN_KEY_W,
    HGRN_KEY_W,
    HGRN_VAL_W,
    HGRN_VAL_W,
    SSD_INNER,
    SSD_XBC_W,
    SSD_HEADS,
    N_BRANCH * D_MODEL,
)
N_IN = sum(SPLIT_SIZES)

kernel_name = "hybrid_gdn_hgrn2_ssd_adaln_block"


def _f32(t):
    return t.astype(jnp.float32)


def rms_norm(x, w):
    xf = x.astype(jnp.float32)
    y = xf * lax.rsqrt(jnp.mean(xf * xf, axis=-1, keepdims=True) + EPS)
    return (y * w.astype(jnp.float32)).astype(x.dtype)


def l2_normalize(x):
    return x * lax.rsqrt(jnp.sum(x * x, axis=-1, keepdims=True) + EPS)


def modulate(h, shift, scale):
    return h * (1.0 + scale[:, None, :]) + shift[:, None, :]


def causal_dwconv(x, w, b=None):
    k_width = w.shape[0]
    s = x.shape[1]
    xp = jnp.pad(x, ((0, 0), (k_width - 1, 0), (0, 0)))
    y = w[k_width - 1] * x
    for k in range(k_width - 1):
        y = y + w[k] * xp[:, k:k + s]
    if b is not None:
        y = y + b
    return y


def to_chunks(t, c):
    b, s = t.shape[:2]
    t = t.reshape((b, s // c, c) + t.shape[2:])
    t = jnp.swapaxes(t, 0, 1)
    return jnp.swapaxes(t, 2, 3)


def from_chunks(t):
    t = jnp.swapaxes(jnp.swapaxes(t, 2, 3), 0, 1)
    return t.reshape((t.shape[0], t.shape[1] * t.shape[2]) + t.shape[3:])


def gated_delta_chunked(q, k, v, g, beta):
    b, s, h, dk = q.shape
    dv = v.shape[-1]
    c = GDN_CHUNK
    qc = to_chunks(q * (dk ** -0.5), c)
    kc = to_chunks(k, c)
    vc = to_chunks(v, c)
    bc = to_chunks(beta, c)
    big_g = jnp.cumsum(to_chunks(g, c), axis=-1)
    incl = jnp.tril(jnp.ones((c, c), bool))
    strict = jnp.tril(jnp.ones((c, c), bool), -1)
    diff = big_g[..., :, None] - big_g[..., None, :]
    decay = jnp.where(incl, jnp.exp(jnp.where(incl, diff, 0.0)), 0.0)
    kb = kc * bc[..., None]
    m = jnp.where(strict, jnp.einsum('nbhlk,nbhsk->nbhls', kb, kc) * decay, 0.0)
    a = m + jnp.eye(c, dtype=m.dtype)
    rhs = jnp.concatenate([vc * bc[..., None], kb * jnp.exp(big_g)[..., None]], axis=-1)
    sol = lax.linalg.triangular_solve(a, rhs, left_side=True, lower=True, unit_diagonal=True)
    u, w = sol[..., :dv], sol[..., dv:]
    attn = jnp.einsum('nbhlk,nbhsk->nbhls', qc, kc) * decay
    qg = qc * jnp.exp(big_g)[..., None]
    k_end = kc * jnp.exp(big_g[..., -1:] - big_g)[..., None]
    g_end = jnp.exp(big_g[..., -1])

    def step(state, inp):
        qg_i, k_end_i, u_i, w_i, attn_i, g_end_i = inp
        v_new = u_i - jnp.einsum('bhlk,bhkv->bhlv', w_i, state)
        o = (jnp.einsum('bhlk,bhkv->bhlv', qg_i, state)
             + jnp.einsum('bhls,bhsv->bhlv', attn_i, v_new))
        state = state * g_end_i[..., None, None] + jnp.einsum('bhsk,bhsv->bhkv', k_end_i, v_new)
        return state, o

    state0 = jnp.zeros((b, h, dk, dv), q.dtype)
    _, o = lax.scan(step, state0, (qg, k_end, u, w, attn, g_end))
    return from_chunks(o)


def hgrn2_chunked(q, k, v, logf):
    b, s, h, dk = q.shape
    dv = v.shape[-1]
    c = HGRN_CHUNK
    qc, kc, vc = to_chunks(q, c), to_chunks(k, c), to_chunks(v, c)
    big_g = jnp.cumsum(to_chunks(logf, c), axis=-2)
    g_ref = big_g[..., c // 2 - 1:c // 2, :]
    incl = jnp.tril(jnp.ones((c, c), bool))
    scores = jnp.einsum('nbhlk,nbhsk->nbhls', qc * jnp.exp(big_g - g_ref), kc * jnp.exp(g_ref - big_g))
    attn = jnp.where(incl, scores, 0.0)
    o_intra = jnp.einsum('nbhls,nbhsv->nbhlv', attn, vc)
    qg = qc * jnp.exp(big_g)
    k_end = kc * jnp.exp(big_g[..., -1:, :] - big_g)
    g_end = jnp.exp(big_g[..., -1, :])

    def step(state, inp):
        qg_i, k_end_i, v_i, g_end_i = inp
        o = jnp.einsum('bhlk,bhkv->bhlv', qg_i, state)
        state = state * g_end_i[..., None] + jnp.einsum('bhsk,bhsv->bhkv', k_end_i, v_i)
        return state, o

    state0 = jnp.zeros((b, h, dk, dv), q.dtype)
    _, o_inter = lax.scan(step, state0, (qg, k_end, vc, g_end))
    return from_chunks(o_intra + o_inter)


def ssd_chunked(xs, da, bm, cm):
    b, s, g, hg, p = xs.shape
    n_state = bm.shape[-1]
    c = SSD_CHUNK
    n = s // c
    xc = jnp.swapaxes(xs.reshape(b, n, c, g, hg, p), 0, 1)
    bc = jnp.swapaxes(bm.reshape(b, n, c, g, n_state), 0, 1)
    cc = jnp.swapaxes(cm.reshape(b, n, c, g, n_state), 0, 1)
    acs = jnp.cumsum(jnp.swapaxes(da.reshape(b, n, c, g, hg), 0, 1), axis=2)
    incl = jnp.tril(jnp.ones((c, c), bool))[:, :, None, None]
    diff = acs[:, :, :, None] - acs[:, :, None, :]
    seg = jnp.where(incl, jnp.exp(jnp.where(incl, diff, 0.0)), 0.0)
    cb = jnp.einsum('nblgd,nbsgd->nblsg', cc, bc)
    y_diag = jnp.einsum('nblsg,nblsgh,nbsghp->nblghp', cb, seg, xc)

    def step(state, inp):
        x_i, b_i, c_i, acs_i = inp
        y_off = jnp.einsum('blgd,bghpd,blgh->blghp', c_i, state, jnp.exp(acs_i))
        last = acs_i[:, -1]
        state = (state * jnp.exp(last)[..., None, None]
                 + jnp.einsum('bsgd,bsgh,bsghp->bghpd', b_i, jnp.exp(last[:, None] - acs_i), x_i))
        return state, y_off

    state0 = jnp.zeros((b, g, hg, p, n_state), xs.dtype)
    _, y_off = lax.scan(step, state0, (xc, bc, cc, acs))
    return jnp.swapaxes(y_diag + y_off, 0, 1).reshape(b, s, g, hg, p)


def gdn_branch(qkv_raw, a_raw, b_raw, z_raw, conv_w, a_log, dt_bias, norm_w):
    bsz, s, _ = qkv_raw.shape
    qkv = jax.nn.silu(causal_dwconv(qkv_raw, conv_w))
    q, k, v = jnp.split(qkv, [GDN_KEY_W, 2 * GDN_KEY_W], axis=-1)
    q = l2_normalize(q.reshape(bsz, s, GDN_HEADS, GDN_DK))
    k = l2_normalize(k.reshape(bsz, s, GDN_HEADS, GDN_DK))
    v = v.reshape(bsz, s, GDN_HEADS, GDN_DV)
    beta = jax.nn.sigmoid(b_raw)
    g = -jnp.exp(a_log) * jax.nn.softplus(a_raw + dt_bias)
    o = gated_delta_chunked(q, k, v, g, beta)
    o = rms_norm(o, norm_w) * jax.nn.silu(z_raw.reshape(bsz, s, GDN_HEADS, GDN_DV))
    return o.reshape(bsz, s, GDN_VAL_W)


def hgrn2_branch(q_raw, f_raw, i_raw, g_raw, lb, norm_w):
    bsz, s, _ = q_raw.shape
    shp = (bsz, s, HGRN_HEADS, HGRN_DK)
    q = jax.nn.silu(q_raw).reshape(shp)
    logf = jnp.log(lb + (1.0 - lb) * jax.nn.sigmoid(f_raw)).reshape(shp)
    k = ((1.0 - lb) * jax.nn.sigmoid(-f_raw)).reshape(shp)
    v = i_raw.reshape(bsz, s, HGRN_HEADS, HGRN_DV)
    o = hgrn2_chunked(q, k, v, logf)
    o = rms_norm(o, norm_w) * jax.nn.silu(g_raw.reshape(bsz, s, HGRN_HEADS, HGRN_DV))
    return o.reshape(bsz, s, HGRN_VAL_W)


def ssd_branch(z_raw, xbc_raw, dt_raw, conv_w, conv_b, a_log, dt_bias, d_skip, norm_w):
    bsz, s, _ = xbc_raw.shape
    xbc = jax.nn.silu(causal_dwconv(xbc_raw, conv_w, conv_b))
    xs, bm, cm = jnp.split(xbc, [SSD_INNER, SSD_INNER + SSD_GROUPS * SSD_STATE], axis=-1)
    xs = xs.reshape(bsz, s, SSD_GROUPS, SSD_HEADS_PER_GROUP, SSD_HEAD_DIM)
    bm = bm.reshape(bsz, s, SSD_GROUPS, SSD_STATE)
    cm = cm.reshape(bsz, s, SSD_GROUPS, SSD_STATE)
    dt = jax.nn.softplus(dt_raw + dt_bias).reshape(bsz, s, SSD_GROUPS, SSD_HEADS_PER_GROUP)
    a = -jnp.exp(a_log).reshape(SSD_GROUPS, SSD_HEADS_PER_GROUP)
    y = ssd_chunked(xs * dt[..., None], dt * a, bm, cm)
    y = y + d_skip.reshape(SSD_GROUPS, SSD_HEADS_PER_GROUP)[..., None] * xs
    group_w = SSD_HEADS_PER_GROUP * SSD_HEAD_DIM
    y = y.reshape(bsz, s, SSD_GROUPS, group_w)
    z = z_raw.reshape(bsz, s, SSD_GROUPS, group_w)
    y = rms_norm(y * jax.nn.silu(z), norm_w.reshape(SSD_GROUPS, group_w))
    return y.reshape(bsz, s, SSD_INNER)


def token_mixing(h, lb, w_in, gdn_conv_w, gdn_a_log, gdn_dt_bias, gdn_norm_w, hgrn_norm_w,
                 ssd_conv_w, ssd_conv_b, ssd_a_log, ssd_dt_bias, ssd_d, ssd_norm_w,
                 w_br_a, w_br_b, w_br_c, w_out):
    bsz, s, _ = h.shape
    dtype = h.dtype
    split_at = [int(i) for i in np.cumsum(SPLIT_SIZES)[:-1]]
    parts = jnp.split(h @ w_in, split_at, axis=-1)
    (gdn_qkv, gdn_a, gdn_b, gdn_z, hg_q, hg_f, hg_i, hg_g,
     ssd_z, ssd_xbc, ssd_dt, gate_raw) = parts
    o_a = gdn_branch(_f32(gdn_qkv), _f32(gdn_a), _f32(gdn_b), _f32(gdn_z),
                     _f32(gdn_conv_w), _f32(gdn_a_log), _f32(gdn_dt_bias), _f32(gdn_norm_w))
    o_b = hgrn2_branch(_f32(hg_q), _f32(hg_f), _f32(hg_i), _f32(hg_g), lb, _f32(hgrn_norm_w))
    o_c = ssd_branch(_f32(ssd_z), _f32(ssd_xbc), _f32(ssd_dt), _f32(ssd_conv_w), _f32(ssd_conv_b),
                     _f32(ssd_a_log), _f32(ssd_dt_bias), _f32(ssd_d), _f32(ssd_norm_w))
    gates = jax.nn.sigmoid(gate_raw).reshape(bsz, s, N_BRANCH, D_MODEL)
    merged = (gates[:, :, 0] * (o_a.astype(dtype) @ w_br_a)
              + gates[:, :, 1] * (o_b.astype(dtype) @ w_br_b)
              + gates[:, :, 2] * (o_c.astype(dtype) @ w_br_c))
    return merged @ w_out


def conv_glu_ffn(h, w_up, conv_w, conv_b, w_down):
    u = causal_dwconv(h @ w_up, conv_w, conv_b)
    gate, val = jnp.split(u, 2, axis=-1)
    return (jax.nn.silu(gate) * val) @ w_down


def _log_uniform_dt_bias(key, shape):
    lo, hi = math.log(1e-3), math.log(1e-1)
    dt = jnp.exp(jax.random.uniform(key, shape) * (hi - lo) + lo)
    return dt + jnp.log(-jnp.expm1(-dt))


def setup_inputs(seed: int = 0) -> dict:
    key = jax.random.key(seed)
    ks = jax.random.split(key, 32)
    nrm = jax.random.normal
    d = D_MODEL
    f2 = 2 * FFN_HIDDEN
    gdn_qkv_w = 2 * GDN_KEY_W + GDN_VAL_W
    return {
        "x": nrm(ks[0], (BATCH, SEQ, d), jnp.float32),
        "c": nrm(ks[1], (BATCH, d), jnp.float32),
        "w_ada": nrm(ks[2], (DEPTH, d, 6 * d)) * (0.5 * d ** -0.5),
        "b_ada": 0.02 * nrm(ks[3], (DEPTH, 6 * d)),
        "norm1_w": 1.0 + 0.05 * nrm(ks[4], (DEPTH, d)),
        "w_in": nrm(ks[5], (DEPTH, d, N_IN)) * d ** -0.5,
        "gdn_conv_w": nrm(ks[6], (DEPTH, GDN_CONV, gdn_qkv_w)) * GDN_CONV ** -0.5,
        "gdn_a_log": jnp.log(jax.random.uniform(ks[7], (DEPTH, GDN_HEADS), minval=1.0, maxval=16.0)),
        "gdn_dt_bias": _log_uniform_dt_bias(ks[8], (DEPTH, GDN_HEADS)),
        "gdn_norm_w": 1.0 + 0.05 * nrm(ks[9], (DEPTH, GDN_DV)),
        "hgrn_lb_param": nrm(ks[10], (DEPTH, HGRN_KEY_W)),
        "hgrn_norm_w": 1.0 + 0.05 * nrm(ks[11], (DEPTH, HGRN_DV)),
        "ssd_conv_w": nrm(ks[12], (DEPTH, SSD_CONV, SSD_XBC_W)) * SSD_CONV ** -0.5,
        "ssd_conv_b": 0.02 * nrm(ks[13], (DEPTH, SSD_XBC_W)),
        "ssd_a_log": jnp.log(jax.random.uniform(ks[14], (DEPTH, SSD_HEADS), minval=1.0, maxval=16.0)),
        "ssd_dt_bias": _log_uniform_dt_bias(ks[15], (DEPTH, SSD_HEADS)),
        "ssd_d": 1.0 + 0.05 * nrm(ks[16], (DEPTH, SSD_HEADS)),
        "ssd_norm_w": 1.0 + 0.05 * nrm(ks[17], (DEPTH, SSD_INNER)),
        "w_br_a": nrm(ks[18], (DEPTH, GDN_VAL_W, d)) * GDN_VAL_W ** -0.5,
        "w_br_b": nrm(ks[19], (DEPTH, HGRN_VAL_W, d)) * HGRN_VAL_W ** -0.5,
        "w_br_c": nrm(ks[20], (DEPTH, SSD_INNER, d)) * SSD_INNER ** -0.5,
        "w_out": nrm(ks[21], (DEPTH, d, d)) * d ** -0.5,
        "norm2_w": 1.0 + 0.05 * nrm(ks[22], (DEPTH, d)),
        "ffn_w_up": nrm(ks[23], (DEPTH, d, f2)) * d ** -0.5,
        "ffn_conv_w": nrm(ks[24], (DEPTH, FFN_CONV, f2)) * FFN_CONV ** -0.5,
        "ffn_conv_b": 0.02 * nrm(ks[25], (DEPTH, f2)),
        "ffn_w_down": nrm(ks[26], (DEPTH, FFN_HIDDEN, d)) * FFN_HIDDEN ** -0.5,
        "final_norm_w": 1.0 + 0.05 * nrm(ks[27], (d,)),
    }


def reference(x, c, w_ada, b_ada, norm1_w, w_in, gdn_conv_w, gdn_a_log, gdn_dt_bias, gdn_norm_w,
              hgrn_lb_param, hgrn_norm_w, ssd_conv_w, ssd_conv_b, ssd_a_log, ssd_dt_bias, ssd_d,
              ssd_norm_w, w_br_a, w_br_b, w_br_c, w_out, norm2_w, ffn_w_up, ffn_conv_w, ffn_conv_b,
              ffn_w_down, final_norm_w):
    c_act = jax.nn.silu(c)
    lb_soft = jax.nn.softmax(hgrn_lb_param.astype(jnp.float32), axis=0)
    lower_bounds = jnp.cumsum(lb_soft, axis=0) - lb_soft[0]
    for l in range(DEPTH):
        mod = c_act @ w_ada[l] + b_ada[l]
        shift1, scale1, gate1, shift2, scale2, gate2 = jnp.split(mod, 6, axis=-1)
        h = modulate(rms_norm(x, norm1_w[l]), shift1, scale1)
        mix = token_mixing(h, lower_bounds[l], w_in[l], gdn_conv_w[l], gdn_a_log[l], gdn_dt_bias[l],
                           gdn_norm_w[l], hgrn_norm_w[l], ssd_conv_w[l], ssd_conv_b[l], ssd_a_log[l],
                           ssd_dt_bias[l], ssd_d[l], ssd_norm_w[l], w_br_a[l], w_br_b[l], w_br_c[l],
                           w_out[l])
        x = x + gate1[:, None, :] * mix
        h = modulate(rms_norm(x, norm2_w[l]), shift2, scale2)
        x = x + gate2[:, None, :] * conv_glu_ffn(h, ffn_w_up[l], ffn_conv_w[l], ffn_conv_b[l], ffn_w_down[l])
    return rms_norm(x, final_norm_w)
```

```cpp
#include <hip/hip_runtime.h>
#include <hip/hip_cooperative_groups.h>
#include <cstdio>
#include <cstdint>
namespace cg = cooperative_groups;

#ifndef MK_COOP
#define MK_COOP 1
#endif

#define LAS __attribute__((address_space(3)))
typedef unsigned short bf16;
typedef short bf16x8 __attribute__((ext_vector_type(8)));
typedef float f32x4 __attribute__((ext_vector_type(4)));
typedef unsigned u32x4 __attribute__((ext_vector_type(4)));
typedef unsigned u32x2 __attribute__((ext_vector_type(2)));

constexpr int DM = 1024, SEQ = 4096, BATCH = 16, MTOT = BATCH * SEQ, HB_SEQ = 8, MH = HB_SEQ * SEQ;
constexpr int NIN = 8720, NP = 8960;
constexpr int C_GZ = 1536, C_HQ = 2048, C_HF = 2560, C_HI = 3072, C_HG = 3584, C_SZ = 4096, C_XBC = 4608, C_GATE = 5632, C_SMALL = 8704;
constexpr int FF = 2816, FF2 = 5632, OC = 1536;
constexpr float EPS = 1e-6f;
constexpr size_t W_IN = 0, W_BR = (size_t)NP * 1024, W_OUT = W_BR + 3 * 524288, W_UP = W_OUT + 1048576, W_DN = W_UP + (size_t)FF2 * 1024, W_LAYER = W_DN + (size_t)FF * 1024;
constexpr size_t MiB = 1u << 20;
constexpr size_t WS_MOD = 0, WS_W = 1 * MiB, WS_H = 80 * MiB, WS_SM = 144 * MiB, WS_OCAT = 146 * MiB, WS_ORAW = 242 * MiB, WS_PROJ = 434 * MiB, WS_G = 786 * MiB, WS_END = 994 * MiB;
static_assert(WS_W + 2 * W_LAYER * 2 <= WS_H, "weights fit");
constexpr size_t WS_RAWB = 338 * MiB;
constexpr int LDS_BYTES = 147456 + 256;
constexpr int XB_ST_OFF = 147456;
constexpr size_t WS_BAR = 900 * 1024;
constexpr int NPH = 42;

typedef float f32x2_t __attribute__((ext_vector_type(2)));
typedef __bf16 bf16x2_t __attribute__((ext_vector_type(2)));
__device__ __forceinline__ unsigned pk2(float lo, float hi) { const f32x2_t v = {lo, hi}; const bf16x2_t b = __builtin_convertvector(v, bf16x2_t); return __builtin_bit_cast(unsigned, b); }
__device__ __forceinline__ unsigned f2bf(float f) { return pk2(f, f) & 0xffffu; }
__device__ __forceinline__ unsigned pk1(float f) { return pk2(f, f); }
__device__ __forceinline__ float bf2f(unsigned b) { return __builtin_bit_cast(float, b << 16); }
__device__ __forceinline__ float bflo(unsigned w) { return __builtin_bit_cast(float, w << 16); }
__device__ __forceinline__ float bfhi(unsigned w) { return __builtin_bit_cast(float, w & 0xffff0000u); }
__device__ __forceinline__ float silu_f(float v) { return v * __builtin_amdgcn_rcpf(1.f + __builtin_amdgcn_exp2f(-1.4426950408889634f * v)); }
__device__ __forceinline__ float sigmoid_f(float v) { return __builtin_amdgcn_rcpf(1.f + __builtin_amdgcn_exp2f(-1.4426950408889634f * v)); }
__device__ __forceinline__ float softplus_f(float v) { const float z = __expf(-fabsf(v)); const float l = (z < 0.01f) ? z * (1.f - z * (0.5f - z * (1.f / 3.f))) : __logf(1.f + z); return fmaxf(v, 0.f) + l; }
template <int CTRL> __device__ __forceinline__ float dppf(float v) { return __builtin_bit_cast(float, __builtin_amdgcn_update_dpp(0, __builtin_bit_cast(int, v), CTRL, 0xf, 0xf, true)); }
__device__ __forceinline__ float red16(float v) { v += dppf<0xB1>(v); v += dppf<0x4E>(v); v += dppf<0x141>(v); v += dppf<0x128>(v); return v; }
__device__ __forceinline__ float rdl(float v, int l) { return __builtin_bit_cast(float, __builtin_amdgcn_readlane(__builtin_bit_cast(int, v), l)); }
__device__ __forceinline__ float wave_sum(float v) { v = red16(v); return (rdl(v, 0) + rdl(v, 16)) + (rdl(v, 32) + rdl(v, 48)); }
__device__ __forceinline__ float wave_scan_incl(float v, int lane) {
    v += dppf<0x111>(v); v += dppf<0x112>(v); v += dppf<0x114>(v); v += dppf<0x118>(v);
    const float t0 = rdl(v, 15), t1 = rdl(v, 31), t2 = rdl(v, 47); const int q = lane >> 4;
    return v + (q >= 1 ? t0 : 0.f) + (q >= 2 ? t1 : 0.f) + (q >= 3 ? t2 : 0.f);
}

struct Params { const float* in[28]; float* out; unsigned char* ws; int ph_lo, ph_hi; };
typedef const __attribute__((address_space(4))) Params* KP;
__device__ __forceinline__ int tid_opaque() { int t = threadIdx.x; asm volatile("" : "+v"(t)); return t; }
__device__ __forceinline__ int bid_opaque() { int b = blockIdx.x; asm volatile("" : "+s"(b)); return b; }
__device__ __forceinline__ int grid_opaque() { int g = gridDim.x; asm volatile("" : "+s"(g)); return g; }
__device__ __forceinline__ LAS unsigned char* lds_opaque(LAS unsigned char* l) { asm volatile("" : "+s"(l)); return l; }
__device__ __forceinline__ KP kparams() { KP q = (KP)__builtin_amdgcn_kernarg_segment_ptr(); asm volatile("" : "+s"(q)); return q; }


namespace pg8 {
constexpr int BM = 256, BK = 64, HALF = 128, HTB = HALF * BK * 2, STAGE_BYTES = 8 * HTB, NXCD = 8, WGM = 4;
__device__ __forceinline__ int lds_byte(int r, int c) { const int st = (r >> 4) * 2 + (c >> 5), rr = r & 15, cc = c & 31, ob = rr * 64 + cc * 2; return st * 1024 + (ob ^ (((ob >> 9) & 1) << 5)); }
__device__ __forceinline__ void stage_rc(int b, int& R, int& C) { const int st = b / 1024, sb = b % 1024, swz = sb ^ (((sb >> 9) & 1) << 5); R = (st >> 1) * 16 + swz / 64; C = (st & 1) * 32 + (swz % 64) / 2; }
__device__ __forceinline__ int perm32(int rho) { const int n = rho >> 4, i = rho & 15; return 8 * (i >> 2) + 4 * n + (i & 3); }
struct Unit { int pm, pn; };
struct StaticOrder {
    int nM, nN, nwg, G, c;
    __device__ __forceinline__ void init(int M, int N, int G_, int c_) { nM = M / BM; nN = N / BM; nwg = nM * nN; G = G_; c = c_; }
    __device__ __forceinline__ bool next(int i, Unit& u) const {
        const long L = (long)i * G + c; if (L >= nwg) return false;
        int wgid = (int)L; { const int q = nwg / NXCD, r = nwg % NXCD, xcd = wgid % NXCD, off = wgid / NXCD; wgid = (xcd < r ? xcd * (q + 1) : r * (q + 1) + (xcd - r) * q) + off; }
        const int nig = WGM * nN, gid = wgid / nig, fm = gid * WGM, gsz = (nM - fm) < WGM ? (nM - fm) : WGM;
        u.pm = fm + ((wgid % nig) % gsz); u.pn = (wgid % nig) / gsz; return true;
    }
};
__device__ __forceinline__ unsigned cvt_pk_bf16(float lo, float hi) { return pk2(lo, hi); }

template <int LDC, bool SMALL> struct EpiBf16 {
    static constexpr bool PERM = true;
    __device__ __forceinline__ void operator()(const f32x4 (&acc)[2][2][4][2], const Unit& u, int wr, int wc, int fr, int fq) const {
        KP p = kparams(); unsigned char* ws = p->ws;
        bf16* O = (bf16*)(ws + WS_PROJ);
        const int row0 = u.pm * BM + wr * 64 + fr; const int col0 = u.pn * BM + wc * 32 + 8 * fq;
#pragma unroll
        for (int ai = 0; ai < 2; ++ai)
#pragma unroll
            for (int m = 0; m < 4; ++m) { bf16* rowp = O + (size_t)(row0 + ai * HALF + m * 16) * LDC + col0;
#pragma unroll
                for (int bj = 0; bj < 2; ++bj) { const f32x4 v0 = acc[ai][bj][m][0], v1 = acc[ai][bj][m][1];
                    u32x4 w; w.x = cvt_pk_bf16(v0[0], v0[1]); w.y = cvt_pk_bf16(v0[2], v0[3]); w.z = cvt_pk_bf16(v1[0], v1[1]); w.w = cvt_pk_bf16(v1[2], v1[3]);
                    *(u32x4*)(rowp + bj * HALF) = w; } }
        if (SMALL && u.pn == C_SMALL / 256 && wc == 0 && fq < 2) {
            float* sm = (float*)(ws + WS_SM);
#pragma unroll
            for (int ai = 0; ai < 2; ++ai)
#pragma unroll
                for (int m = 0; m < 4; ++m) { float* q = sm + (size_t)(row0 + ai * HALF + m * 16) * 16 + 8 * fq; *(f32x4*)q = acc[ai][0][m][0]; *(f32x4*)(q + 4) = acc[ai][0][m][1]; }
        }
    }
};
__device__ __forceinline__ void branch_rescale(f32x4 (&acc)[2][2][4][2], const Unit& u, int wr, int wc, int fr, int fq, int which) {
    KP p = kparams();
    const bf16* gate = (const bf16*)(p->ws + WS_PROJ) + C_GATE + which * 1024;
    const int col0 = u.pn * BM + wc * 32 + 4 * fq;
#pragma unroll
    for (int ai = 0; ai < 2; ++ai)
#pragma unroll
        for (int m = 0; m < 4; ++m) { const size_t row = (size_t)(u.pm * BM + ai * HALF + wr * 64 + m * 16 + fr);
#pragma unroll
            for (int bj = 0; bj < 2; ++bj)
#pragma unroll
                for (int n = 0; n < 2; ++n) { const int c = col0 + bj * HALF + n * 16;
                    const u32x2 ga = *(const u32x2*)(gate + row * NP + c), gb = *(const u32x2*)(gate + row * NP + 1024 + c);
                    f32x4 r;
                    r[0] = (1.f + __builtin_amdgcn_exp2f(-1.4426950408889634f * bflo(gb.x))) * __builtin_amdgcn_rcpf(1.f + __builtin_amdgcn_exp2f(-1.4426950408889634f * bflo(ga.x)));
                    r[1] = (1.f + __builtin_amdgcn_exp2f(-1.4426950408889634f * bfhi(gb.x))) * __builtin_amdgcn_rcpf(1.f + __builtin_amdgcn_exp2f(-1.4426950408889634f * bfhi(ga.x)));
                    r[2] = (1.f + __builtin_amdgcn_exp2f(-1.4426950408889634f * bflo(gb.y))) * __builtin_amdgcn_rcpf(1.f + __builtin_amdgcn_exp2f(-1.4426950408889634f * bflo(ga.y)));
                    r[3] = (1.f + __builtin_amdgcn_exp2f(-1.4426950408889634f * bfhi(gb.y))) * __builtin_amdgcn_rcpf(1.f + __builtin_amdgcn_exp2f(-1.4426950408889634f * bfhi(ga.y)));
                    acc[ai][bj][m][n] = acc[ai][bj][m][n] * r; } }
    asm volatile("s_waitcnt vmcnt(0)" ::: "memory");
}
struct EpiBranchFinal {
    static constexpr bool PERM = false;
    __device__ __forceinline__ void operator()(const f32x4 (&acc)[2][2][4][2], const Unit& u, int wr, int wc, int fr, int fq) const {
        KP p = kparams(); unsigned char* ws = p->ws;
        const bf16* gate = (const bf16*)(ws + WS_PROJ) + C_GATE + 2048; bf16* mb = (bf16*)(ws + WS_H);
        const int col0 = u.pn * BM + wc * 32 + 4 * fq;
#pragma unroll
        for (int ai = 0; ai < 2; ++ai)
#pragma unroll
            for (int m = 0; m < 4; ++m) { const size_t row = (size_t)(u.pm * BM + ai * HALF + wr * 64 + m * 16 + fr);
#pragma unroll
                for (int bj = 0; bj < 2; ++bj)
#pragma unroll
                    for (int n = 0; n < 2; ++n) { const int c = col0 + bj * HALF + n * 16;
                        const u32x2 gr = *(const u32x2*)(gate + row * NP + c);
                        f32x4 g; g[0] = sigmoid_f(bflo(gr.x)); g[1] = sigmoid_f(bfhi(gr.x)); g[2] = sigmoid_f(bflo(gr.y)); g[3] = sigmoid_f(bfhi(gr.y));
                        const f32x4 v = acc[ai][bj][m][n] * g; u32x2 w; w.x = cvt_pk_bf16(v[0], v[1]); w.y = cvt_pk_bf16(v[2], v[3]); *(u32x2*)(mb + row * 1024 + c) = w; } }
    }
};
struct EpiUpGlu {
    static constexpr bool PERM = true;
    int layer;
    __device__ __forceinline__ void operator()(const f32x4 (&acc)[2][2][4][2], const Unit& u, int wr, int wc, int fr, int fq) const {
        KP p = kparams(); unsigned char* ws = p->ws;
        bf16* G = (bf16*)(ws + WS_G); bf16* RB = (bf16*)(ws + WS_RAWB);
        const float* cw = p->in[24] + (size_t)layer * 3 * FF2; const float* cb = p->in[25] + (size_t)layer * FF2;
        const int gcol = u.pn * 128 + wc * 32 + 8 * fq;
#pragma unroll
        for (int n = 0; n < 2; ++n) {
            asm volatile("" ::: "memory");
            f32x4 wg[3], wv[3];
#pragma unroll
            for (int k = 0; k < 3; ++k) { wg[k] = *(const f32x4*)(cw + k * FF2 + gcol + 4 * n); wv[k] = *(const f32x4*)(cw + k * FF2 + FF + gcol + 4 * n); }
            const f32x4 bg = *(const f32x4*)(cb + gcol + 4 * n), bv = *(const f32x4*)(cb + FF + gcol + 4 * n);
#pragma unroll
            for (int ai = 0; ai < 2; ++ai)
#pragma unroll
                for (int m = 0; m < 4; ++m) {
                    const int row = u.pm * BM + ai * HALF + wr * 64 + m * 16 + fr;
                    float o[4];
#pragma unroll
                    for (int e = 0; e < 4; ++e) {
                        const float cg = n == 0 ? acc[ai][0][m][0][e] : acc[ai][0][m][1][e], cv = n == 0 ? acc[ai][1][m][0][e] : acc[ai][1][m][1][e];
                        const float pg = m > 0 ? (n == 0 ? acc[ai][0][m > 0 ? m - 1 : 0][0][e] : acc[ai][0][m > 0 ? m - 1 : 0][1][e]) : cg;
                        const float pv = m > 0 ? (n == 0 ? acc[ai][1][m > 0 ? m - 1 : 0][0][e] : acc[ai][1][m > 0 ? m - 1 : 0][1][e]) : cv;
                        const float cg1 = dppf<0x121>(cg), pg1 = dppf<0x121>(pg), cg2 = dppf<0x122>(cg), pg2 = dppf<0x122>(pg);
                        const float cv1 = dppf<0x121>(cv), pv1 = dppf<0x121>(pv), cv2 = dppf<0x122>(cv), pv2 = dppf<0x122>(pv);
                        const float g1 = fr >= 1 ? cg1 : pg1, g2 = fr >= 2 ? cg2 : pg2, v1 = fr >= 1 ? cv1 : pv1, v2 = fr >= 2 ? cv2 : pv2;
                        const float yg = wg[0][e] * g2 + wg[1][e] * g1 + wg[2][e] * cg + bg[e];
                        const float yv = wv[0][e] * v2 + wv[1][e] * v1 + wv[2][e] * cv + bv[e];
                        o[e] = silu_f(yg) * yv;
                    }
                    if (!(m == 0 && fr < 2)) { u32x2 w; w.x = pk2(o[0], o[1]); w.y = pk2(o[2], o[3]); *(u32x2*)(G + (size_t)row * FF + gcol + 4 * n) = w; }
                    int slot = -1, b = row >> 6;
                    if (m == 0 && fr < 2) slot = 2 + fr; else if (m == 3 && fr >= 14) { slot = fr - 14; b += 1; }
                    if (slot >= 0 && b < MH / 64) {
                        const f32x4 g0 = n == 0 ? acc[ai][0][m][0] : acc[ai][0][m][1], v0 = n == 0 ? acc[ai][1][m][0] : acc[ai][1][m][1];
                        bf16* rb = RB + (size_t)(b * 4 + slot) * FF2 + gcol + 4 * n;
                        u32x2 w; w.x = pk2(g0[0], g0[1]); w.y = pk2(g0[2], g0[3]); *(u32x2*)rb = w;
                        w.x = pk2(v0[0], v0[1]); w.y = pk2(v0[2], v0[3]); *(u32x2*)(rb + FF) = w;
                    }
                }
        }
    }
};
template <bool SECOND> struct EpiResid {
    static constexpr bool PERM = false;
    int layer, row_base;
    __device__ __forceinline__ void operator()(const f32x4 (&acc)[2][2][4][2], const Unit& u, int wr, int wc, int fr, int fq) const {
        KP p = kparams();
        float* out = p->out; const float* base = (SECOND || layer != 0) ? (const float*)out : p->in[0];
        const float* gate = (const float*)(p->ws + WS_MOD) + (size_t)layer * 16 * 6144 + (SECOND ? 5120 : 2048);
        const int col0 = u.pn * BM + wc * 32 + 4 * fq;
        const int b = (row_base + u.pm * BM) / SEQ;
        f32x4 gv[2][2];
#pragma unroll
        for (int bj = 0; bj < 2; ++bj)
#pragma unroll
            for (int n = 0; n < 2; ++n) gv[bj][n] = *(const f32x4*)(gate + (size_t)b * 6144 + col0 + bj * HALF + n * 16);
#pragma unroll
        for (int ai = 0; ai < 2; ++ai)
#pragma unroll
            for (int m = 0; m < 4; ++m) { const size_t off = (size_t)(row_base + u.pm * BM + ai * HALF + wr * 64 + m * 16 + fr) * 1024 + col0;
#pragma unroll
                for (int bj = 0; bj < 2; ++bj)
#pragma unroll
                    for (int n = 0; n < 2; ++n) { const f32x4 bs = *(const f32x4*)(base + off + bj * HALF + n * 16); *(f32x4*)(out + off + bj * HALF + n * 16) = bs + gv[bj][n] * acc[ai][bj][m][n]; } }
    }
};

__device__ __forceinline__ void gemm_phase(LAS unsigned char* lds, const bf16* gA, const bf16* gBt, const int nt, const int LDA, const int LDB, const int nN, const int epi, const int layer, const int row_base) {
    StaticOrder S; S.nM = MH / BM; S.nN = nN; S.nwg = S.nM * nN; S.G = grid_opaque(); S.c = bid_opaque();
    const bool PERM = (epi == 0 || epi == 5);
    const int tid = tid_opaque(), wid = __builtin_amdgcn_readfirstlane(tid >> 6), lane = tid & 63, wr = wid >> 2, wc = wid & 3;
    unsigned voffA[2], voffB[2];
#pragma unroll
    for (int i = 0; i < 2; ++i) { int R, C; stage_rc(tid * 16 + i * 8192, R, C); const int Rb = PERM ? ((R & ~31) + perm32(R & 31)) : R;
        voffA[i] = (unsigned)(R * LDA + C) * 2u; voffB[i] = (unsigned)(Rb * LDB + C) * 2u; }
    constexpr size_t kstep = (size_t)(BK * 2);
    const size_t hstepA = (size_t)HALF * LDA * 2, hstepB = (size_t)HALF * LDB * 2;
    const size_t tstepA = 2 * hstepA, tstepB = 2 * hstepB;
    const unsigned ldsw = (unsigned)wid * 1024u;
    const int aoff = lds_byte(wr * 64 + (lane & 15), (lane >> 4) * 8), boff = lds_byte(wc * 32 + (lane & 15), (lane >> 4) * 8);
#define PG8_SA(b, h) (((b) * 2 + (h)) * HTB)
#define PG8_SB(b, h) ((4 + (b) * 2 + (h)) * HTB)
#define PG8_STAGE(bufoff, gbase, voff) do { _Pragma("unroll") for (int _i = 0; _i < 2; ++_i) \
        __builtin_amdgcn_global_load_lds((const unsigned*)((const char*)(gbase) + (voff)[_i]), (LAS unsigned*)(lds + (bufoff) + ldsw + _i * 8192), 16, 0, 0); } while (0)
#define PG8_LDA(dst, b, h) do { _Pragma("unroll") for (int m = 0; m < 4; ++m) _Pragma("unroll") for (int k = 0; k < 2; ++k) dst[m][k] = *(const LAS bf16x8*)(lds + PG8_SA(b, h) + aoff + m * 2048 + k * 1024); } while (0)
#define PG8_LDB(dst, b, h) do { _Pragma("unroll") for (int n = 0; n < 2; ++n) _Pragma("unroll") for (int k = 0; k < 2; ++k) dst[n][k] = *(const LAS bf16x8*)(lds + PG8_SB(b, h) + boff + n * 2048 + k * 1024); } while (0)
#define PG8_MMA(ai, bj, At, Bt) do { __builtin_amdgcn_s_setprio(1); _Pragma("unroll") for (int m = 0; m < 4; ++m) _Pragma("unroll") for (int n = 0; n < 2; ++n) _Pragma("unroll") for (int k = 0; k < 2; ++k) \
        acc[ai][bj][m][n] = __builtin_amdgcn_mfma_f32_16x16x32_bf16(Bt[n][k], At[m][k], acc[ai][bj][m][n], 0, 0, 0); __builtin_amdgcn_s_setprio(0); } while (0)
#define PG8_WAIT_V(n) asm volatile("s_waitcnt vmcnt(" #n ")" ::: "memory")
#define PG8_WAIT_L(n) asm volatile("s_waitcnt lgkmcnt(" #n ")" ::: "memory")
#define PG8_BAR __builtin_amdgcn_s_barrier()
#define PG8_SCHED __builtin_amdgcn_sched_barrier(0)
    Unit cur, nxt; int ui = 0;
    if (!S.next(0, cur)) return;
    f32x4 acc[2][2][4][2];
#pragma unroll
    for (int a = 0; a < 2; ++a)
#pragma unroll
        for (int b = 0; b < 2; ++b)
#pragma unroll
            for (int m = 0; m < 4; ++m)
#pragma unroll
                for (int n = 0; n < 2; ++n) acc[a][b][m][n] = (f32x4){0.f, 0.f, 0.f, 0.f};
    bf16x8 At[4][2], B0[2][2], B1[2][2];
    const char* cA = (const char*)gA + (size_t)cur.pm * tstepA; const char* cB = (const char*)gBt + (size_t)cur.pn * tstepB;
    PG8_STAGE(PG8_SB(0, 0), cB, voffB); PG8_STAGE(PG8_SB(0, 1), cB + hstepB, voffB); PG8_STAGE(PG8_SA(0, 0), cA, voffA); PG8_STAGE(PG8_SA(0, 1), cA + hstepA, voffA);
    if (wr == 1) PG8_BAR;
    PG8_WAIT_V(2); PG8_BAR;
    PG8_STAGE(PG8_SB(1, 0), cB + kstep, voffB); PG8_STAGE(PG8_SA(1, 0), cA + kstep, voffA); PG8_STAGE(PG8_SB(1, 1), cB + hstepB + kstep, voffB);
    PG8_WAIT_V(6); PG8_BAR;
    for (;;) {
        const bool has_next = S.next(ui + 1, nxt);
        const char* nA = has_next ? (const char*)gA + (size_t)nxt.pm * tstepA : cA; const char* nB = has_next ? (const char*)gBt + (size_t)nxt.pn * tstepB : cB;
        for (int t = 0; t < nt; t += 2) {
            if (epi == 1 && (t == 8 || t == 16)) { const int tr_ = tid_opaque(); branch_rescale(acc, cur, wr, wc, tr_ & 15, (tr_ & 63) >> 4, t == 8 ? 0 : 1); }
            const bool last = (t == nt - 2);
            const char* a1 = cA + (size_t)(t + 1) * kstep;
            const char* a2 = last ? nA : cA + (size_t)(t + 2) * kstep; const char* b2 = last ? nB : cB + (size_t)(t + 2) * kstep;
            const char* a3 = a2 + kstep; const char* b3 = b2 + kstep;
            PG8_LDB(B0, 0, 0); PG8_LDB(B1, 0, 1); PG8_SCHED; PG8_LDA(At, 0, 0); PG8_STAGE(PG8_SA(1, 1), a1 + hstepA, voffA);
            PG8_WAIT_V(8); PG8_WAIT_L(0); PG8_BAR; PG8_MMA(0, 0, At, B0); PG8_MMA(0, 1, At, B1); PG8_BAR; PG8_SCHED;
            PG8_LDA(At, 0, 1); PG8_STAGE(PG8_SB(0, 0), b2, voffB); PG8_STAGE(PG8_SB(0, 1), b2 + hstepB, voffB); PG8_STAGE(PG8_SA(0, 0), a2, voffA);
            PG8_WAIT_V(8); PG8_WAIT_L(0); PG8_BAR; PG8_MMA(1, 0, At, B0); PG8_MMA(1, 1, At, B1); PG8_BAR; PG8_SCHED;
            PG8_LDB(B0, 1, 0); PG8_LDB(B1, 1, 1); PG8_SCHED; PG8_LDA(At, 1, 0); PG8_STAGE(PG8_SA(0, 1), a2 + hstepA, voffA);
            PG8_WAIT_V(8); PG8_WAIT_L(0); PG8_BAR; PG8_MMA(0, 0, At, B0); PG8_MMA(0, 1, At, B1); PG8_BAR; PG8_SCHED;
            PG8_LDA(At, 1, 1); PG8_STAGE(PG8_SB(1, 0), b3, voffB); PG8_STAGE(PG8_SB(1, 1), b3 + hstepB, voffB); PG8_STAGE(PG8_SA(1, 0), a3, voffA);
            PG8_WAIT_V(8); PG8_WAIT_L(0); PG8_BAR; PG8_MMA(1, 0, At, B0); PG8_MMA(1, 1, At, B1); PG8_BAR; PG8_SCHED;
        }
        if (wr == 0) PG8_BAR;
        const int te = tid_opaque(), fr = te & 15, fq = (te & 63) >> 4;
        switch (epi) {
        case 0: { EpiBf16<NP, true> E; E(acc, cur, wr, wc, fr, fq); } break;
        case 1: { EpiBranchFinal E; E(acc, cur, wr, wc, fr, fq); } break;
        case 4: { EpiResid<false> E{layer, row_base}; E(acc, cur, wr, wc, fr, fq); } break;
        case 5: { EpiUpGlu E{layer}; E(acc, cur, wr, wc, fr, fq); } break;
        default: { EpiResid<true> E{layer, row_base}; E(acc, cur, wr, wc, fr, fq); } break;
        }
        if (!has_next) break;
#pragma unroll
        for (int a = 0; a < 2; ++a)
#pragma unroll
            for (int b = 0; b < 2; ++b)
#pragma unroll
                for (int m = 0; m < 4; ++m)
#pragma unroll
                    for (int n = 0; n < 2; ++n) acc[a][b][m][n] = (f32x4){0.f, 0.f, 0.f, 0.f};
        cur = nxt; cA = nA; cB = nB; ++ui;
        if (wr == 1) PG8_BAR;
    }
    PG8_WAIT_V(0);
    PG8_BAR;
#undef PG8_SA
#undef PG8_SB
#undef PG8_STAGE
#undef PG8_LDA
#undef PG8_LDB
#undef PG8_MMA
#undef PG8_WAIT_V
#undef PG8_WAIT_L
#undef PG8_BAR
#undef PG8_SCHED
}
}

__device__ __forceinline__ void tr_item(const float* W, int K, int ldw, int src_col0, int nblk, bf16* WT, int dst_row0, LAS float* scr, int item, int lane) {
    const int kb = item / nblk, nb = item % nblk, k0 = 64 * kb, n0 = 32 * nb;
    float wv_[32];
#pragma unroll
    for (int i = 0; i < 32; ++i) { const int kk = 2 * i + (lane >> 5); wv_[i] = W[(size_t)(k0 + kk) * ldw + src_col0 + n0 + (lane & 31)]; }
#pragma unroll
    for (int i = 0; i < 32; ++i) { const int kk = 2 * i + (lane >> 5); scr[kk * 33 + (lane & 31)] = wv_[i]; }
    asm volatile("s_waitcnt lgkmcnt(0)" ::: "memory");
    const int c = lane & 7;
#pragma unroll
    for (int j = 0; j < 4; ++j) { const int n = (lane >> 3) + 8 * j; const LAS float* s = scr + (8 * c) * 33 + n;
        u32x4 o; o.x = pk2(s[0 * 33], s[1 * 33]); o.y = pk2(s[2 * 33], s[3 * 33]); o.z = pk2(s[4 * 33], s[5 * 33]); o.w = pk2(s[6 * 33], s[7 * 33]);
        *(u32x4*)(WT + (size_t)(dst_row0 + n0 + n) * K + k0 + 8 * c) = o; }
    asm volatile("s_waitcnt lgkmcnt(0)" ::: "memory");
}
__device__ __forceinline__ void p0_prologue(KP p, LAS unsigned char* lds) {
    const int tid = tid_opaque(), lane = tid & 63, wave = __builtin_amdgcn_readfirstlane(tid >> 6);
    LAS float* scr = (LAS float*)(lds + wave * 16384);
    const int gw = bid_opaque() * 8 + wave, NGW = grid_opaque() * 8;
    constexpr int I_A = 16 * 48, I_B = 16 * 128, I_C = 16 * 96, I_BR = 8 * 32, I_O = 16 * 32, I_U = 16 * 176, I_D = 44 * 32;
    constexpr int PER_LAYER = I_A + I_B + I_C + 3 * I_BR + I_O + I_U + I_D;
    for (int it = gw; it < 2 * PER_LAYER; it += NGW) {
        KP pp = kparams();
        const int l = it / PER_LAYER; int r = it % PER_LAYER;
        bf16* WL = (bf16*)(pp->ws + WS_W) + (size_t)l * W_LAYER;
        const float* W; int K, ldw, src0 = 0, nblk, dst0 = 0; size_t wo;
        if (r < I_A) { W = pp->in[5] + (size_t)l * 1024 * NIN; K = 1024; ldw = NIN; src0 = 0; nblk = 48; wo = W_IN; dst0 = 0; }
        else if ((r -= I_A) < I_B) { W = pp->in[5] + (size_t)l * 1024 * NIN; K = 1024; ldw = NIN; src0 = 1544; nblk = 128; wo = W_IN; dst0 = 1536; }
        else if ((r -= I_B) < I_C) { W = pp->in[5] + (size_t)l * 1024 * NIN; K = 1024; ldw = NIN; src0 = 5648; nblk = 96; wo = W_IN; dst0 = 5632; }
        else if ((r -= I_C) < I_BR) { W = pp->in[18] + (size_t)l * 524288; K = 1536; ldw = 1024; nblk = 32; wo = W_BR; }
        else if ((r -= I_BR) < I_BR) { W = pp->in[19] + (size_t)l * 524288; K = 1536; ldw = 1024; nblk = 32; wo = W_BR + 512; }
        else if ((r -= I_BR) < I_BR) { W = pp->in[20] + (size_t)l * 524288; K = 1536; ldw = 1024; nblk = 32; wo = W_BR + 1024; }
        else if ((r -= I_BR) < I_O) { W = pp->in[21] + (size_t)l * 1048576; K = 1024; ldw = 1024; nblk = 32; wo = W_OUT; }
        else if ((r -= I_O) < I_U) { const int kb_ = r / 176, c_ = 32 * (r % 176);
            W = pp->in[23] + (size_t)l * 1024 * FF2; K = 1024; ldw = FF2; src0 = c_; nblk = 1; wo = W_UP; r = kb_;
            dst0 = c_ < FF ? 256 * (c_ >> 7) + (c_ & 127) : 256 * ((c_ - FF) >> 7) + 128 + ((c_ - FF) & 127); }
        else { r -= I_U; W = pp->in[26] + (size_t)l * FF * 1024; K = FF; ldw = 1024; nblk = 32; wo = W_DN; }
        tr_item(W, K, ldw, src0, nblk, WL + wo, dst0, scr, r, lane);
    }
    {
        const int gt = bid_opaque() * 512 + tid, NT = grid_opaque() * 512;
        for (int e = gt; e < 2 * 16 * 1024; e += NT) {
            const int l = e >> 14, r = (e >> 10) & 15, k = e & 1023;
            const int src = r < 8 ? 1536 + r : 5640 + (r - 8);
            bf16* WL = (bf16*)(p->ws + WS_W) + (size_t)l * W_LAYER;
            WL[W_IN + (size_t)(C_SMALL + r) * 1024 + k] = (bf16)pk1(p->in[5][(size_t)l * 1024 * NIN + (size_t)k * NIN + src]);
        }
    }
    __syncthreads();
    LAS float* cact = (LAS float*)lds;
    LAS float* part = (LAS float*)(lds + 65536);
    bool loaded = false;
    for (int it = bid_opaque(); it < 192; it += grid_opaque()) {
        if (!loaded) { for (int e = tid; e < 16384; e += 512) cact[e] = silu_f(p->in[1][e]); loaded = true; }
        __syncthreads();
        const int l = it / 96, n0 = (it % 96) * 64;
        const float* W = p->in[2] + (size_t)l * 1024 * 6144 + n0 + lane;
        float acc[16];
#pragma unroll
        for (int b = 0; b < 16; ++b) acc[b] = 0.f;
        for (int k16 = 0; k16 < 8; ++k16) {
            const int kb_ = wave * 128 + k16 * 16;
            float wr_[16];
#pragma unroll
            for (int i = 0; i < 16; ++i) wr_[i] = W[(size_t)(kb_ + i) * 6144];
#pragma unroll
            for (int q = 0; q < 4; ++q)
#pragma unroll
                for (int b = 0; b < 16; ++b) { const f32x4 cv = *(const LAS f32x4*)(cact + b * 1024 + kb_ + 4 * q); acc[b] += cv[0] * wr_[4 * q] + cv[1] * wr_[4 * q + 1] + cv[2] * wr_[4 * q + 2] + cv[3] * wr_[4 * q + 3]; }
        }
#pragma unroll
        for (int b = 0; b < 16; ++b) part[(wave * 16 + b) * 64 + lane] = acc[b];
        __syncthreads();
        for (int e = tid; e < 1024; e += 512) { const int b = e >> 6, j = e & 63; float s = 0.f;
#pragma unroll
            for (int w = 0; w < 8; ++w) s += part[(w * 16 + b) * 64 + j];
            ((float*)(p->ws + WS_MOD))[(size_t)(l * 16 + b) * 6144 + n0 + j] = s + p->in[3][(size_t)l * 6144 + n0 + j]; }
    }
}

__device__ __forceinline__ void norm_mod_phase(const float* src  , int row_base, const float* nw, const float* shift, const float* scale, bf16* dst, const bf16* wsmall  , float* smout  ) {
    const int tid_ = tid_opaque(), lane = tid_ & 63, wave = __builtin_amdgcn_readfirstlane(tid_ >> 6);
    const int gw = bid_opaque() * 8 + wave, NGW = grid_opaque() * 8;
    const int rpw = (MH + NGW - 1) / NGW, r0 = gw * rpw, r1 = r0 + rpw < MH ? r0 + rpw : MH;
    if (r0 >= r1) return;
    f32x4 wm[4], sh[4]; int bcur = -1;
    f32x4 v[4], vn[4];
    { const f32x4* xr = (const f32x4*)(src + (size_t)r0 * 1024) + lane;
#pragma unroll
      for (int j = 0; j < 4; ++j) vn[j] = xr[64 * j]; }
    for (int r = r0; r < r1; ++r) {
#pragma unroll
        for (int j = 0; j < 4; ++j) v[j] = vn[j];
        if (r + 1 < r1) { const f32x4* xr = (const f32x4*)(src + (size_t)(r + 1) * 1024) + lane;
#pragma unroll
            for (int j = 0; j < 4; ++j) vn[j] = xr[64 * j]; }
        const int b = (row_base + r) / SEQ;
        if (b != bcur) { bcur = b;
#pragma unroll
            for (int j = 0; j < 4; ++j) { const int c = 4 * lane + 256 * j;
                wm[j] = *(const f32x4*)(nw + c) * (*(const f32x4*)(scale + (size_t)b * 6144 + c) + 1.f); sh[j] = *(const f32x4*)(shift + (size_t)b * 6144 + c); } }
        float s = 0.f;
#pragma unroll
        for (int j = 0; j < 4; ++j) s += (v[j][0] * v[j][0] + v[j][1] * v[j][1]) + (v[j][2] * v[j][2] + v[j][3] * v[j][3]);
        const float rstd = rsqrtf(wave_sum(s) * (1.f / 1024.f) + EPS);
        u32x2* o8 = (u32x2*)(dst + (size_t)r * 1024) + lane;
#pragma unroll
        for (int j = 0; j < 4; ++j) { const f32x4 y = v[j] * rstd * wm[j] + sh[j]; u32x2 o; o.x = pk2(y[0], y[1]); o.y = pk2(y[2], y[3]); o8[64 * j] = o; }
    }
    if (wsmall != nullptr && rpw == 16) {
        asm volatile("s_waitcnt vmcnt(0)" ::: "memory");
        const int r16 = lane & 15, q4 = lane >> 4;
        const bf16* ap = dst + (size_t)(r0 + r16) * 1024 + q4 * 8; const bf16* bp = wsmall + (size_t)r16 * 1024 + q4 * 8;
        f32x4 acc = (f32x4){0.f, 0.f, 0.f, 0.f};
#pragma unroll 8
        for (int kk = 0; kk < 32; ++kk) {
            const bf16x8 a = *(const bf16x8*)(ap + kk * 32), bb = *(const bf16x8*)(bp + kk * 32);
            acc = __builtin_amdgcn_mfma_f32_16x16x32_bf16(a, bb, acc, 0, 0, 0);
        }
#pragma unroll
        for (int j = 0; j < 4; ++j) smout[(size_t)(r0 + 4 * q4 + j) * 16 + r16] = acc[j];
    }
}

#define LBAR() do { asm volatile("s_waitcnt lgkmcnt(0)" ::: "memory"); __builtin_amdgcn_s_barrier(); asm volatile("" ::: "memory"); } while (0)

constexpr int HG_QS = 0, HG_KS = 17408, HG_QG = 34816, HG_KET = 52224, HG_GEND = 68608, HG_VT = 70656, HG_SB = 89088, HG_END = 123904;
static_assert(HG_END <= LDS_BYTES, "HGRN LDS map");
__device__ __forceinline__ bf16x8 mk_frag(unsigned a, unsigned b, unsigned c, unsigned d) { u32x4 u; u.x = a; u.y = b; u.z = c; u.w = d; return __builtin_bit_cast(bf16x8, u); }
__device__ __forceinline__ void hgrn_unit(KP p, int idx, int layer, LAS unsigned char* L0) {
    LAS unsigned char* L = lds_opaque(L0);
    const int tid = tid_opaque(), lane = tid & 63, wave = __builtin_amdgcn_readfirstlane(tid >> 6);
    const int bl = idx >> 3, h = (idx >> 1) & 3, dvh = idx & 1; const bool act = wave < 4; const int dvt = dvh * 4 + (wave & 3);
    const bf16* P = (const bf16*)(p->ws + WS_PROJ) + (size_t)bl * SEQ * NP;
    bf16* OR = (bf16*)(p->ws + WS_ORAW) + (size_t)bl * SEQ * OC + 512 + h * 128 + dvt * 16;
    const int pk = tid & 127, psub = tid >> 7;
    float lb = 0.f;
    if (layer == 1) { const float* lp = p->in[10]; lb = sigmoid_f(lp[512 + h * 128 + pk] - lp[h * 128 + pk]); }
    const int r16 = lane & 15, q4 = lane >> 4;
    f32x4 S[8];
#pragma unroll
    for (int i = 0; i < 8; ++i) S[i] = (f32x4){0.f, 0.f, 0.f, 0.f};
    { LAS unsigned char* SB = L + HG_SB + wave * 4352; for (int i = lane; i < 1088; i += 64) ((LAS unsigned*)SB)[i] = 0u; }
    unsigned rq[16], rf[16], rv[16];
    unsigned pq[8], pks[8], pqg[8], ke[8]; float gendv = 0.f;
#define HG_LOAD(mcx) do { if ((mcx) < 64) { const bf16* src_ = P + (size_t)((mcx) * 64 + psub * 16) * NP + h * 128 + pk; \
        _Pragma("unroll") for (int i = 0; i < 16; ++i) { rq[i] = src_[(size_t)i * NP + C_HQ]; rf[i] = src_[(size_t)i * NP + C_HF]; } \
        if (act) { const bf16* srv_ = P + (size_t)((mcx) * 64 + q4 * 16) * NP + C_HI + h * 128 + dvt * 16 + r16; \
            _Pragma("unroll") for (int i = 0; i < 16; ++i) rv[i] = srv_[(size_t)i * NP]; } } } while (0)
#define HG_COMPUTE() do { float qv[16], kv[16], G[16]; float run = 0.f; \
        _Pragma("unroll") for (int i = 0; i < 16; ++i) { const float qr = bf2f(rq[i]), fr = bf2f(rf[i]); const float sg = sigmoid_f(fr), f = lb + (1.f - lb) * sg; \
            run += __logf(f); G[i] = run; kv[i] = (1.f - lb) * (1.f - sg); qv[i] = silu_f(qr); } \
        const float Gref = G[7], Gend = G[15]; const float eref = __expf(Gref), c2 = __expf(Gend - Gref); \
        _Pragma("unroll") for (int i = 0; i < 8; ++i) { \
            const float e1a = __expf(G[2 * i] - Gref), r1a = __builtin_amdgcn_rcpf(e1a), e1b = __expf(G[2 * i + 1] - Gref), r1b = __builtin_amdgcn_rcpf(e1b); \
            pq[i] = pk2(qv[2 * i] * e1a, qv[2 * i + 1] * e1b); pks[i] = pk2(kv[2 * i] * r1a, kv[2 * i + 1] * r1b); \
            pqg[i] = pk2(qv[2 * i] * e1a * eref, qv[2 * i + 1] * e1b * eref); ke[i] = pk2(kv[2 * i] * r1a * c2, kv[2 * i + 1] * r1b * c2); } \
        gendv = __expf(Gend); } while (0)
#define HG_WRITE() do { _Pragma("unroll") for (int i = 0; i < 8; ++i) { const int t_ = psub * 16 + 2 * i; \
            *(LAS bf16*)(L + HG_QS + t_ * 272 + pk * 2) = (bf16)(pq[i] & 0xffffu); *(LAS bf16*)(L + HG_QS + (t_ + 1) * 272 + pk * 2) = (bf16)(pq[i] >> 16); \
            *(LAS bf16*)(L + HG_KS + t_ * 272 + pk * 2) = (bf16)(pks[i] & 0xffffu); *(LAS bf16*)(L + HG_KS + (t_ + 1) * 272 + pk * 2) = (bf16)(pks[i] >> 16); \
            *(LAS bf16*)(L + HG_QG + t_ * 272 + pk * 2) = (bf16)(pqg[i] & 0xffffu); *(LAS bf16*)(L + HG_QG + (t_ + 1) * 272 + pk * 2) = (bf16)(pqg[i] >> 16); } \
        LAS u32x4* kd_ = (LAS u32x4*)(L + HG_KET + (psub * 128 + pk) * 32); kd_[0] = (u32x4){ke[0], ke[1], ke[2], ke[3]}; kd_[1] = (u32x4){ke[4], ke[5], ke[6], ke[7]}; \
        *(LAS float*)(L + HG_GEND + (psub * 128 + pk) * 4) = gendv; } while (0)
    HG_LOAD(0);
    if (!act) { HG_COMPUTE(); HG_LOAD(1); }
    for (int mc = 0; mc < 64; ++mc) {
        L = lds_opaque(L0);
        LAS unsigned char* VT = L + HG_VT + wave * 2304;
        LAS unsigned char* SB = L + HG_SB + wave * 4352;
        LBAR();
        if (act) {
            HG_COMPUTE(); HG_WRITE();
            {
                unsigned w[8];
#pragma unroll
                for (int i = 0; i < 8; ++i) w[i] = rv[2 * i] | (rv[2 * i + 1] << 16);
                LAS u32x4* vd = (LAS u32x4*)(VT + r16 * 144 + q4 * 32);
                vd[0] = (u32x4){w[0], w[1], w[2], w[3]}; vd[1] = (u32x4){w[4], w[5], w[6], w[7]};
            }
            HG_LOAD(mc + 1);
        } else {
            HG_WRITE();
        }
        LBAR();
        if (!act) { if (mc + 1 < 64) { HG_COMPUTE(); HG_LOAD(mc + 2); } }
        else
#pragma unroll 1
        for (int sb = 0; sb < 4; ++sb) {
            const int t0 = sb * 16;
            f32x4 sc = (f32x4){0.f, 0.f, 0.f, 0.f};
#pragma unroll
            for (int kk = 0; kk < 4; ++kk) {
                const bf16x8 a = *(const LAS bf16x8*)(L + HG_KS + (t0 + r16) * 272 + kk * 64 + q4 * 16);
                const bf16x8 b = *(const LAS bf16x8*)(L + HG_QS + (t0 + r16) * 272 + kk * 64 + q4 * 16);
                sc = __builtin_amdgcn_mfma_f32_16x16x32_bf16(a, b, sc, 0, 0, 0);
            }
#pragma unroll
            for (int j = 0; j < 4; ++j) if (4 * q4 + j > r16) sc[j] = 0.f;
            const bf16x8 a2 = mk_frag(pk2(sc[0], sc[1]), pk2(sc[2], sc[3]), 0u, 0u);
            const u32x2 vv = *(const LAS u32x2*)(VT + r16 * 144 + (t0 + 4 * q4) * 2);
            const bf16x8 b2 = mk_frag(vv.x, vv.y, 0u, 0u);
            f32x4 o = __builtin_amdgcn_mfma_f32_16x16x32_bf16(a2, b2, (f32x4){0.f, 0.f, 0.f, 0.f}, 0, 0, 0);
#pragma unroll
            for (int kk = 0; kk < 4; ++kk) {
                const bf16x8 a = *(const LAS bf16x8*)(L + HG_QG + (t0 + r16) * 272 + kk * 64 + q4 * 16);
                const bf16x8 b = *(const LAS bf16x8*)(SB + r16 * 272 + kk * 64 + q4 * 16);
                o = __builtin_amdgcn_mfma_f32_16x16x32_bf16(a, b, o, 0, 0, 0);
            }
            bf16* orow = OR + (size_t)(mc * 64 + t0 + 4 * q4) * OC + r16;
#pragma unroll
            for (int j = 0; j < 4; ++j) orow[(size_t)j * OC] = (bf16)pk1(o[j]);
#pragma unroll
            for (int kt = 0; kt < 8; ++kt) {
                const u32x2 ke = *(const LAS u32x2*)(L + HG_KET + (sb * 128 + kt * 16 + r16) * 32 + q4 * 8);
                const f32x4 ge = *(const LAS f32x4*)(L + HG_GEND + (sb * 128 + kt * 16 + 4 * q4) * 4);
                S[kt] = __builtin_amdgcn_mfma_f32_16x16x32_bf16(mk_frag(ke.x, ke.y, 0u, 0u), b2, S[kt] * ge, 0, 0, 0);
                *(LAS u32x2*)(SB + r16 * 272 + (kt * 16 + 4 * q4) * 2) = (u32x2){pk2(S[kt][0], S[kt][1]), pk2(S[kt][2], S[kt][3])};
            }
        }
    }
    LBAR();
}


#undef HG_LOAD
#undef HG_COMPUTE
#undef HG_WRITE
constexpr int SD_CS = 0, SD_BS = 17408, SD_BT = 34816, SD_CBS = 53248  , SD_SC = SD_CBS + 2 * 9216, SD_PRIV = SD_SC + 1024, SD_PRIV_SZ = 8960, SD_END = SD_PRIV + 8 * SD_PRIV_SZ;
static_assert(SD_END <= LDS_BYTES, "SSD LDS map");
__device__ __forceinline__ void ssd_unit(KP p, int idx, int layer, LAS unsigned char* L0) {
    LAS unsigned char* L = lds_opaque(L0);
    const int tid = tid_opaque(), lane = tid & 63, wave = __builtin_amdgcn_readfirstlane(tid >> 6);
    const int r16 = lane & 15, q4 = lane >> 4;
    const int bl = idx >> 3, head = idx & 7, g = head >> 2;
    const int hh = 0, pt = wave & 3; const bool act = wave < 4;
    const bf16* P = (const bf16*)(p->ws + WS_PROJ) + (size_t)bl * SEQ * NP;
    const float* SM = (const float*)(p->ws + WS_SM) + (size_t)bl * SEQ * 16;
    bf16* OR = (bf16*)(p->ws + WS_ORAW) + (size_t)bl * SEQ * OC + 1024 + head * 64 + pt * 16;
    const int pc = tid & 255, phalf = tid >> 8, pn = pc & 127; const bool isB = pc >= 128;
    const int xi = (isB ? 512 : 768) + g * 128 + pn;
    const float* cwp = p->in[12] + (size_t)layer * 4096; const float* cbp = p->in[13] + (size_t)layer * 1024;
    const float cw0 = cwp[xi], cw1 = cwp[1024 + xi], cw2 = cwp[2048 + xi], cw3 = cwp[3072 + xi], cb = cbp[xi];
    const int xp = head * 64 + pt * 16 + r16;
    const float xw0 = cwp[xp], xw1 = cwp[1024 + xp], xw2 = cwp[2048 + xp], xw3 = cwp[3072 + xp], xb_ = cbp[xp];
    const float A_h = -__expf(p->in[14][layer * 8 + head]), dtb = p->in[15][layer * 8 + head], Dh = p->in[16][layer * 8 + head];
    f32x4 H[8];
#pragma unroll
    for (int i = 0; i < 8; ++i) H[i] = (f32x4){0.f, 0.f, 0.f, 0.f};
    { LAS unsigned char* HB = L + SD_PRIV + wave * SD_PRIV_SZ + 4608; for (int i = lane; i < 1088; i += 64) ((LAS unsigned*)HB)[i] = 0u; }
    unsigned rs[35], rx[19];
    {
        const bf16* src = P + (size_t)(phalf * 32) * NP + C_XBC + xi;
#pragma unroll
        for (int i = 0; i < 35; ++i) rs[i] = (phalf * 32 - 3 + i >= 0) ? (unsigned)src[(long)(i - 3) * NP] : 0u;
        const bf16* srx = P + (size_t)(q4 * 16) * NP + C_XBC + xp;
#pragma unroll
        for (int i = 0; i < 19; ++i) rx[i] = (act && q4 * 16 - 3 + i >= 0) ? (unsigned)srx[(long)(i - 3) * NP] : 0u;
    }
    for (int c = 0; c < 64; ++c) {
        L = lds_opaque(L0);
        LAS unsigned char* XT = L + SD_PRIV + wave * SD_PRIV_SZ; LAS unsigned char* XDT = XT + 2304; LAS unsigned char* HB = XT + 4608;
        LAS float* ACS = (LAS float*)(L + SD_SC) + hh * 64; LAS float* DT = (LAS float*)(L + SD_SC) + 128 + hh * 64;
        LBAR();
        {
            float x[35];
#pragma unroll
            for (int i = 0; i < 35; ++i) x[i] = bf2f(rs[i]);
            unsigned pkd[16]; unsigned lo = 0;
            LAS unsigned char* dst = L + (isB ? SD_BS : SD_CS) + (phalf * 32) * 272 + pn * 2;
#pragma unroll
            for (int j = 0; j < 32; ++j) {
                const unsigned b = f2bf(silu_f(cw0 * x[j] + cw1 * x[j + 1] + cw2 * x[j + 2] + cw3 * x[j + 3] + cb));
                *(LAS bf16*)(dst + j * 272) = (bf16)b;
                if (j & 1) pkd[j >> 1] = lo | (b << 16); else lo = b;
            }
            if (isB) { LAS u32x4* bt = (LAS u32x4*)(L + SD_BT + pn * 144 + phalf * 64);
#pragma unroll
                for (int i = 0; i < 4; ++i) bt[i] = (u32x4){pkd[4 * i], pkd[4 * i + 1], pkd[4 * i + 2], pkd[4 * i + 3]}; }
        }
        if (wave == 0) {
            const float dtv = softplus_f(SM[(size_t)(c * 64 + lane) * 16 + 8 + head] + dtb);
            const float v = wave_scan_incl(dtv * A_h, lane);
            ACS[lane] = v; DT[lane] = dtv;
        }
        float xv[16];
        if (act) {
            float x[19];
#pragma unroll
            for (int i = 0; i < 19; ++i) x[i] = bf2f(rx[i]);
#pragma unroll
            for (int j = 0; j < 16; ++j) xv[j] = silu_f(xw0 * x[j] + xw1 * x[j + 1] + xw2 * x[j + 2] + xw3 * x[j + 3] + xb_);
        }
        if (c + 1 < 64) {
            const bf16* src = P + (size_t)((c + 1) * 64 + phalf * 32) * NP + C_XBC + xi;
#pragma unroll
            for (int i = 0; i < 35; ++i) rs[i] = src[(long)(i - 3) * NP];
            if (act) { const bf16* srx = P + (size_t)((c + 1) * 64 + q4 * 16) * NP + C_XBC + xp;
#pragma unroll
                for (int i = 0; i < 19; ++i) rx[i] = srx[(long)(i - 3) * NP]; }
        }
        LBAR();
        if (act) {
            unsigned a[8], b[8];
#pragma unroll
            for (int i = 0; i < 4; ++i) { const f32x4 d = *(const LAS f32x4*)(DT + q4 * 16 + 4 * i);
                a[2 * i] = pk2(xv[4 * i], xv[4 * i + 1]); a[2 * i + 1] = pk2(xv[4 * i + 2], xv[4 * i + 3]);
                b[2 * i] = pk2(xv[4 * i] * d[0], xv[4 * i + 1] * d[1]); b[2 * i + 1] = pk2(xv[4 * i + 2] * d[2], xv[4 * i + 3] * d[3]); }
            LAS u32x4* xd = (LAS u32x4*)(XT + r16 * 144 + q4 * 32); xd[0] = (u32x4){a[0], a[1], a[2], a[3]}; xd[1] = (u32x4){a[4], a[5], a[6], a[7]};
            LAS u32x4* yd = (LAS u32x4*)(XDT + r16 * 144 + q4 * 32); yd[0] = (u32x4){b[0], b[1], b[2], b[3]}; yd[1] = (u32x4){b[4], b[5], b[6], b[7]};
        }
        {
            const int tl = wave & 3;
            const LAS float* AC0 = (const LAS float*)(L + SD_SC);
            const f32x4 al0 = *(const LAS f32x4*)(AC0 + 16 * tl + 4 * q4);
#pragma unroll
            for (int u = 0; u < 2; ++u) { const int ts = 2 * (wave >> 2) + u;
                f32x4 acc = (f32x4){0.f, 0.f, 0.f, 0.f};
#pragma unroll
                for (int kk = 0; kk < 4; ++kk) {
                    const bf16x8 a = *(const LAS bf16x8*)(L + SD_CS + (16 * tl + r16) * 272 + kk * 64 + q4 * 16);
                    const bf16x8 b = *(const LAS bf16x8*)(L + SD_BS + (16 * ts + r16) * 272 + kk * 64 + q4 * 16);
                    acc = __builtin_amdgcn_mfma_f32_16x16x32_bf16(a, b, acc, 0, 0, 0);
                }
                const int sidx = 16 * ts + r16; const float as0 = AC0[sidx];
#pragma unroll
                for (int j = 0; j < 4; ++j) { const int l = 16 * tl + 4 * q4 + j;
                    *(LAS bf16*)(L + SD_CBS + l * 144 + sidx * 2) = (bf16)pk1(sidx <= l ? acc[j] * __expf(fminf(al0[j] - as0, 0.f)) : 0.f); }
            }
        }
        LBAR();
        if (act) {
        const float acs_last = ACS[63];
        const bf16x8 xb0 = *(const LAS bf16x8*)(XDT + r16 * 144 + q4 * 16), xb1 = *(const LAS bf16x8*)(XDT + r16 * 144 + 64 + q4 * 16);
#pragma unroll 1
        for (int tl = 0; tl < 4; ++tl) {
            f32x4 acc = (f32x4){0.f, 0.f, 0.f, 0.f};
#pragma unroll
            for (int kk = 0; kk < 4; ++kk) {
                const bf16x8 a = *(const LAS bf16x8*)(L + SD_CS + (16 * tl + r16) * 272 + kk * 64 + q4 * 16);
                const bf16x8 b = *(const LAS bf16x8*)(HB + r16 * 272 + kk * 64 + q4 * 16);
                acc = __builtin_amdgcn_mfma_f32_16x16x32_bf16(a, b, acc, 0, 0, 0);
            }
            const f32x4 al = *(const LAS f32x4*)(ACS + 16 * tl + 4 * q4);
#pragma unroll
            for (int j = 0; j < 4; ++j) acc[j] *= __expf(al[j]);
            acc = __builtin_amdgcn_mfma_f32_16x16x32_bf16(*(const LAS bf16x8*)(L + SD_CBS + hh * 9216 + (16 * tl + r16) * 144 + q4 * 16), xb0, acc, 0, 0, 0);
            if (tl >= 2) acc = __builtin_amdgcn_mfma_f32_16x16x32_bf16(*(const LAS bf16x8*)(L + SD_CBS + hh * 9216 + (16 * tl + r16) * 144 + 64 + q4 * 16), xb1, acc, 0, 0, 0);
            const u32x2 xs = *(const LAS u32x2*)(XT + r16 * 144 + (16 * tl + 4 * q4) * 2);
            acc[0] += Dh * bflo(xs.x); acc[1] += Dh * bfhi(xs.x); acc[2] += Dh * bflo(xs.y); acc[3] += Dh * bfhi(xs.y);
            bf16* orow = OR + (size_t)(c * 64 + 16 * tl + 4 * q4) * OC + r16;
#pragma unroll
            for (int j = 0; j < 4; ++j) orow[(size_t)j * OC] = (bf16)pk1(acc[j]);
        }
        {
            bf16x8 xe[2];
#pragma unroll
            for (int kk = 0; kk < 2; ++kk) {
                const u32x4 xw = __builtin_bit_cast(u32x4, kk == 0 ? xb0 : xb1);
                const f32x4 s0 = *(const LAS f32x4*)(ACS + kk * 32 + 8 * q4), s1 = *(const LAS f32x4*)(ACS + kk * 32 + 8 * q4 + 4);
                float v[8];
                v[0] = bflo(xw.x); v[1] = bfhi(xw.x); v[2] = bflo(xw.y); v[3] = bfhi(xw.y); v[4] = bflo(xw.z); v[5] = bfhi(xw.z); v[6] = bflo(xw.w); v[7] = bfhi(xw.w);
#pragma unroll
                for (int e = 0; e < 8; ++e) { const float as = e < 4 ? s0[e & 3] : s1[e & 3]; v[e] *= __expf(acs_last - as); }
                xe[kk] = mk_frag(pk2(v[0], v[1]), pk2(v[2], v[3]), pk2(v[4], v[5]), pk2(v[6], v[7]));
            }
            const float eh = __expf(acs_last);
#pragma unroll
            for (int nt = 0; nt < 8; ++nt) {
                H[nt] = H[nt] * eh;
#pragma unroll
                for (int kk = 0; kk < 2; ++kk) {
                    const bf16x8 a = *(const LAS bf16x8*)(L + SD_BT + (16 * nt + r16) * 144 + kk * 64 + q4 * 16);
                    H[nt] = __builtin_amdgcn_mfma_f32_16x16x32_bf16(a, xe[kk], H[nt], 0, 0, 0);
                }
                *(LAS u32x2*)(HB + r16 * 272 + (16 * nt + 4 * q4) * 2) = (u32x2){pk2(H[nt][0], H[nt][1]), pk2(H[nt][2], H[nt][3])};
            }
        }
        }
    }
    LBAR();
}


constexpr int GD_QN = 0, GD_KN = 17408, GD_VN = 34816, GD_MT = 52224, GD_KET = 68608, GD_SC = 87040, GD_PRIV = 88064, GD_PRIV_SZ = 6656, GD_WL = GD_PRIV + 8 * GD_PRIV_SZ, GD_END = GD_WL + 6144;
static_assert(GD_END <= LDS_BYTES, "GDN LDS map");
typedef float f32x2 __attribute__((ext_vector_type(2)));
__device__ __forceinline__ float red8(float v) { v += dppf<0xB1>(v); v += dppf<0x4E>(v); v += dppf<0x141>(v); return v; }
__device__ __forceinline__ float bfel(const u32x4& a, const u32x4& b, int c) { const u32x4& v = (c < 8) ? a : b; const unsigned w = v[(c & 7) >> 1]; return (c & 1) ? bfhi(w) : bflo(w); }
constexpr size_t AUXA_UNIT = 32768, AUXB_UNIT = 40960;
constexpr size_t WS_GE = 920 * 1024;
constexpr int GCNT_WORD = 3648;
constexpr int GCNT_UNUSED = 3584;
__device__ __forceinline__ void gdn1_load_rows(KP p, int u, u32x4 (&xr)[3][4][2]) {
    const int tid0 = tid_opaque(); const int bl = u >> 8, h = (u >> 6) & 3, c = u & 63, t = tid0 >> 3;
    const bf16* Pu = (const bf16*)(p->ws + WS_PROJ) + (size_t)bl * SEQ * NP + h * 128 + (tid0 & 7) * 16;
#pragma unroll
    for (int mat = 0; mat < 3; ++mat)
#pragma unroll
        for (int i = 0; i < 4; ++i) {
            if (c * 64 + t - 3 + i >= 0) { const bf16* src = Pu + (long)(c * 64 + t - 3 + i) * NP + mat * 512; xr[mat][i][0] = *(const u32x4*)src; xr[mat][i][1] = *(const u32x4*)(src + 8); }
            else { xr[mat][i][0] = (u32x4){0u, 0u, 0u, 0u}; xr[mat][i][1] = (u32x4){0u, 0u, 0u, 0u}; }
        }
}
__device__ __forceinline__ void gdn1_unit(KP p, int u, int layer, LAS unsigned char* L0, u32x4 (&xr)[3][4][2], bool load_w, int u_next) {
    LAS unsigned char* L = lds_opaque(L0);
    const int tid0 = tid_opaque(), wave = __builtin_amdgcn_readfirstlane(tid0 >> 6);
    const int bl = u >> 8, h = (u >> 6) & 3, c = u & 63;
    const float sA = __builtin_bit_cast(float, __builtin_amdgcn_readfirstlane(__builtin_bit_cast(int, -__expf(p->in[7][layer * 4 + h])))), sB = __builtin_bit_cast(float, __builtin_amdgcn_readfirstlane(__builtin_bit_cast(int, p->in[8][layer * 4 + h])));
    LBAR();
    if (load_w) {
        const float* cwp = p->in[6] + (size_t)layer * 4 * 1536;
        for (int e = tid0; e < 1536; e += 512) { const int mat = e >> 9, k = (e >> 7) & 3, col = e & 127; *(LAS float*)(L + GD_WL + e * 4) = cwp[k * 1536 + mat * 512 + h * 128 + col]; }
        LBAR();
    }
    {
        LAS float* GC = (LAS float*)(L + GD_SC); LAS float* BETA = GC + 64;
        {
            const int tid = tid_opaque();
            const int t = tid >> 3, seg = tid & 7;
#pragma unroll
            for (int mat = 0; mat < 3; ++mat) {
                float y[16]; float ss = 0.f;
#pragma unroll
                for (int cg = 0; cg < 4; ++cg) {
                    const LAS float* wl = (const LAS float*)(L + GD_WL) + mat * 512 + seg * 16 + 4 * cg;
                    const f32x4 w0 = *(const LAS f32x4*)(wl), w1 = *(const LAS f32x4*)(wl + 128), w2 = *(const LAS f32x4*)(wl + 256), w3 = *(const LAS f32x4*)(wl + 384);
#pragma unroll
                    for (int e = 0; e < 4; ++e) { const int ci = 4 * cg + e;
                        const float v = silu_f(w0[e] * bfel(xr[mat][0][0], xr[mat][0][1], ci) + w1[e] * bfel(xr[mat][1][0], xr[mat][1][1], ci) + w2[e] * bfel(xr[mat][2][0], xr[mat][2][1], ci) + w3[e] * bfel(xr[mat][3][0], xr[mat][3][1], ci));
                        y[ci] = v; ss += v * v; }
                }
                float r = 1.f;
                if (mat < 2) { ss = red8(ss); r = rsqrtf(ss + EPS) * (mat == 0 ? 0.08838834764831845f : 1.f); }
                LAS u32x4* d = (LAS u32x4*)(L + (mat == 0 ? GD_QN : mat == 1 ? GD_KN : GD_VN) + t * 272 + seg * 32);
                d[0] = (u32x4){pk2(y[0] * r, y[1] * r), pk2(y[2] * r, y[3] * r), pk2(y[4] * r, y[5] * r), pk2(y[6] * r, y[7] * r)};
                d[1] = (u32x4){pk2(y[8] * r, y[9] * r), pk2(y[10] * r, y[11] * r), pk2(y[12] * r, y[13] * r), pk2(y[14] * r, y[15] * r)};
            }
        }
        if (wave == 0) {
            const int tid = tid_opaque(), lane = tid & 63, r16 = lane & 15, q4 = lane >> 4; (void)r16; (void)q4; (void)lane;
            KP pp = kparams(); const float* sm = (const float*)(pp->ws + WS_SM) + ((size_t)bl * SEQ + c * 64 + lane) * 16;
            const float v = wave_scan_incl(sA * softplus_f(sm[h] + sB), lane);
            GC[lane] = v; BETA[lane] = sigmoid_f(sm[4 + h]);
        }
        LBAR();
        f32x4 at[2];
        {
            const int tid = tid_opaque(), lane = tid & 63, r16 = lane & 15, q4 = lane >> 4; (void)r16; (void)q4; (void)lane;
            const int tl = wave & 3;
            const f32x4 gl = *(const LAS f32x4*)(GC + 16 * tl + 4 * q4), bl4 = *(const LAS f32x4*)(BETA + 16 * tl + 4 * q4);
#pragma unroll
            for (int u = 0; u < 2; ++u) { const int ts = 2 * (wave >> 2) + u;
                f32x4 kk = (f32x4){0.f, 0.f, 0.f, 0.f}, qk = (f32x4){0.f, 0.f, 0.f, 0.f};
#pragma unroll
                for (int k4 = 0; k4 < 4; ++k4) {
                    const bf16x8 b = *(const LAS bf16x8*)(L + GD_KN + (16 * ts + r16) * 272 + k4 * 64 + q4 * 16);
                    const bf16x8 ak = *(const LAS bf16x8*)(L + GD_KN + (16 * tl + r16) * 272 + k4 * 64 + q4 * 16);
                    const bf16x8 aq = *(const LAS bf16x8*)(L + GD_QN + (16 * tl + r16) * 272 + k4 * 64 + q4 * 16);
                    kk = __builtin_amdgcn_mfma_f32_16x16x32_bf16(ak, b, kk, 0, 0, 0);
                    qk = __builtin_amdgcn_mfma_f32_16x16x32_bf16(aq, b, qk, 0, 0, 0);
                }
                const int sidx = 16 * ts + r16; const float gs = GC[sidx];
                f32x4 m;
#pragma unroll
                for (int j = 0; j < 4; ++j) { const int l = 16 * tl + 4 * q4 + j; const float dec = __expf(fminf(gl[j] - gs, 0.f));
                    m[j] = (sidx < l) ? bl4[j] * kk[j] * dec : 0.f; qk[j] = (sidx <= l) ? qk[j] * dec : 0.f; }
                *(LAS f32x4*)(L + GD_MT + sidx * 256 + (16 * tl + 4 * q4) * 4) = m;
                at[u] = qk;
            }
        }
        LBAR();
        f32x2 acc2[32];
        if (wave < 4) {
            const int tid = tid_opaque(), lane = tid & 63, r16 = lane & 15, q4 = lane >> 4; (void)r16; (void)q4; (void)lane;
            const LAS unsigned char* rb = L + (tid < 128 ? GD_VN : GD_KN) + (tid & 127) * 2;
#pragma unroll
            for (int l4 = 0; l4 < 16; ++l4) {
                const f32x4 b4 = *(const LAS f32x4*)(BETA + 4 * l4); f32x4 g4 = (f32x4){1.f, 1.f, 1.f, 1.f};
                if (tid >= 128) { const f32x4 gg = *(const LAS f32x4*)(GC + 4 * l4); g4 = (f32x4){__expf(gg[0]), __expf(gg[1]), __expf(gg[2]), __expf(gg[3])}; }
                acc2[2 * l4] = (f32x2){bf2f(*(const LAS bf16*)(rb + (4 * l4) * 272)) * b4[0] * g4[0], bf2f(*(const LAS bf16*)(rb + (4 * l4 + 1) * 272)) * b4[1] * g4[1]};
                acc2[2 * l4 + 1] = (f32x2){bf2f(*(const LAS bf16*)(rb + (4 * l4 + 2) * 272)) * b4[2] * g4[2], bf2f(*(const LAS bf16*)(rb + (4 * l4 + 3) * 272)) * b4[3] * g4[3]};
            }
#pragma unroll
            for (int s_ = 0; s_ < 63; ++s_) {
                const float xs = (s_ & 1) ? acc2[s_ >> 1][1] : acc2[s_ >> 1][0]; const f32x2 xs2 = (f32x2){xs, xs};
#pragma unroll
                for (int l4 = ((s_ + 1) >> 2) << 2; l4 < 64; l4 += 4) {
                    const f32x4 m = *(const LAS f32x4*)(L + GD_MT + s_ * 256 + l4 * 4);
                    acc2[l4 >> 1] -= (f32x2){m[0], m[1]} * xs2;
                    acc2[(l4 >> 1) + 1] -= (f32x2){m[2], m[3]} * xs2;
                }
            }
        } else {
            const int tid = tid_opaque(), lane = tid & 63, r16 = lane & 15, q4 = lane >> 4; (void)r16; (void)q4; (void)lane;
            const int tt = tid - 256, t = tt >> 2, sg = tt & 3;
            const float gt = GC[t]; const float eg = __expf(gt), ee = __expf(GC[63] - gt);
            LAS u32x4* qp = (LAS u32x4*)(L + GD_QN + t * 272 + sg * 64);
            const LAS u32x4* kp = (const LAS u32x4*)(L + GD_KN + t * 272 + sg * 64);
#pragma unroll
            for (int i = 0; i < 4; ++i) {
                const u32x4 w = qp[i];
                qp[i] = (u32x4){pk2(bflo(w.x) * eg, bfhi(w.x) * eg), pk2(bflo(w.y) * eg, bfhi(w.y) * eg), pk2(bflo(w.z) * eg, bfhi(w.z) * eg), pk2(bflo(w.w) * eg, bfhi(w.w) * eg)};
                const u32x4 kw = kp[i];
                LAS unsigned char* kd = L + GD_KET + (sg * 32 + i * 8) * 144 + t * 2;
                *(LAS bf16*)(kd + 0 * 144) = (bf16)pk1(bflo(kw.x) * ee); *(LAS bf16*)(kd + 1 * 144) = (bf16)pk1(bfhi(kw.x) * ee);
                *(LAS bf16*)(kd + 2 * 144) = (bf16)pk1(bflo(kw.y) * ee); *(LAS bf16*)(kd + 3 * 144) = (bf16)pk1(bfhi(kw.y) * ee);
                *(LAS bf16*)(kd + 4 * 144) = (bf16)pk1(bflo(kw.z) * ee); *(LAS bf16*)(kd + 5 * 144) = (bf16)pk1(bfhi(kw.z) * ee);
                *(LAS bf16*)(kd + 6 * 144) = (bf16)pk1(bflo(kw.w) * ee); *(LAS bf16*)(kd + 7 * 144) = (bf16)pk1(bfhi(kw.w) * ee);
            }
        }
        LBAR();
        if (wave < 2) {
            const int tid = tid_opaque(), lane = tid & 63, r16 = lane & 15, q4 = lane >> 4; (void)r16; (void)q4; (void)lane;
            LAS u32x2* ud = (LAS u32x2*)(L + GD_KN + tid * 136);
#pragma unroll
            for (int i = 0; i < 16; ++i) ud[i] = (u32x2){pk2(acc2[2 * i][0], acc2[2 * i][1]), pk2(acc2[2 * i + 1][0], acc2[2 * i + 1][1])};
        } else if (wave < 4) {
            const int tid = tid_opaque(), lane = tid & 63, r16 = lane & 15, q4 = lane >> 4; (void)r16; (void)q4; (void)lane;
            LAS unsigned char* wd = L + GD_VN + (tid - 128) * 2;
#pragma unroll
            for (int i = 0; i < 32; ++i) { *(LAS bf16*)(wd + (2 * i) * 272) = (bf16)pk1(acc2[i][0]); *(LAS bf16*)(wd + (2 * i + 1) * 272) = (bf16)pk1(acc2[i][1]); }
        }
        {
            const int tid = tid_opaque(), lane = tid & 63, r16 = lane & 15, q4 = lane >> 4; (void)r16; (void)q4; (void)lane;
            const int tl = wave & 3;
#pragma unroll
            for (int u = 0; u < 2; ++u) { const int ts = 2 * (wave >> 2) + u;
#pragma unroll
                for (int j = 0; j < 4; ++j) *(LAS bf16*)(L + GD_MT + (16 * tl + 4 * q4 + j) * 144 + (16 * ts + r16) * 2) = (bf16)pk1(at[u][j]); }
        }
        LBAR();
        {
            const int tid = tid_opaque();
            KP pp = kparams();
            const __amdgpu_buffer_rsrc_t ra_ = __builtin_amdgcn_make_buffer_rsrc((void*)(pp->ws + WS_H + (size_t)u * AUXA_UNIT), (short)0, (int)AUXA_UNIT, 0x00020000);
            const __amdgpu_buffer_rsrc_t rb_ = __builtin_amdgcn_make_buffer_rsrc((void*)(pp->ws + WS_OCAT + (size_t)u * AUXB_UNIT), (short)0, (int)AUXB_UNIT, 0x00020000);
#pragma unroll
            for (int k = 0; k < 2; ++k) { const int i = tid + 512 * k;
                __builtin_amdgcn_raw_buffer_store_b128(*(const LAS u32x4*)(L + GD_VN + (i >> 4) * 272 + (i & 15) * 16), ra_, i * 16, 0, 16);
                __builtin_amdgcn_raw_buffer_store_b128(*(const LAS u32x4*)(L + GD_QN + (i >> 4) * 272 + (i & 15) * 16), rb_, i * 16, 0, 16);
                __builtin_amdgcn_raw_buffer_store_b128(*(const LAS u32x4*)(L + GD_KET + (i >> 3) * 144 + (i & 7) * 16), rb_, 16384 + i * 16, 0, 16); }
#pragma unroll
            for (int k = 0; k < 4; ++k) { const int i = tid + 512 * k; __builtin_amdgcn_raw_buffer_store_b64(*(const LAS u32x2*)(L + GD_KN + (i >> 4) * 136 + (i & 15) * 8), ra_, 16384 + i * 8, 0, 16); }
            __builtin_amdgcn_raw_buffer_store_b128(*(const LAS u32x4*)(L + GD_MT + (tid >> 3) * 144 + (tid & 7) * 16), rb_, 32768 + tid * 16, 0, 16);
            if (tid == 0) __hip_atomic_store((float*)(pp->ws + WS_GE) + u, __expf(GC[63]), __ATOMIC_RELAXED, __HIP_MEMORY_SCOPE_AGENT);
            asm volatile("s_waitcnt vmcnt(0)" ::: "memory");
            __syncthreads();
            if (tid == 0) (void)__hip_atomic_fetch_add((unsigned*)(pp->ws + WS_BAR) + GCNT_WORD + c, 1u, __ATOMIC_RELAXED, __HIP_MEMORY_SCOPE_AGENT);
        }
    }
    gdn1_load_rows(kparams(), u_next, xr);
}
#define GDN2_ENSURE(cn) do { if ((cn) >= ready_upto) { const int hi_ = ready_upto + 8 < 64 ? ready_upto + 8 : 64; \
        if (tid_opaque() == 0) { unsigned* cnt_ = (unsigned*)(kparams()->ws + WS_BAR) + GCNT_WORD; unsigned sp_ = 0; \
            for (int cc_ = ready_upto; cc_ < hi_; ++cc_) while (__hip_atomic_load(cnt_ + cc_, __ATOMIC_RELAXED, __HIP_MEMORY_SCOPE_AGENT) < want) { __builtin_amdgcn_s_sleep(2); if (++sp_ > (1u << 24)) break; } \
            __builtin_amdgcn_fence(__ATOMIC_ACQUIRE, "agent"); asm volatile("s_waitcnt vmcnt(0)" ::: "memory"); } \
        __syncthreads(); ready_upto = hi_; } } while (0)
__device__ __forceinline__ void gdn2_unit(KP p, int idx, int layer, int pass, LAS unsigned char* L0) {
    const unsigned want = 32u * (unsigned)(pass + 1); int ready_upto = 0;
    LAS unsigned char* L = lds_opaque(L0);
    const int tid0 = tid_opaque(), wave = __builtin_amdgcn_readfirstlane(tid0 >> 6);
    const int bl = idx >> 2, h = idx & 3;
    { LAS unsigned char* SB = L + GD_PRIV + wave * GD_PRIV_SZ + 2304; for (int i = tid0 & 63; i < 1088; i += 64) ((LAS unsigned*)SB)[i] = 0u; }
    f32x4 S[8];
#pragma unroll
    for (int i = 0; i < 8; ++i) S[i] = (f32x4){0.f, 0.f, 0.f, 0.f};
    const size_t u0 = (size_t)(bl * 4 + h) * 64;
    u32x4 rw[2], rq[2], rk[2], ra; u32x2 ru[4]; float rge;
    GDN2_ENSURE(0);
    {
        const unsigned char* A = p->ws + WS_H + u0 * AUXA_UNIT; const unsigned char* B = p->ws + WS_OCAT + u0 * AUXB_UNIT;
#pragma unroll
        for (int k = 0; k < 2; ++k) { const int i = tid0 + 512 * k; rw[k] = ((const u32x4*)A)[i]; rq[k] = ((const u32x4*)B)[i]; rk[k] = ((const u32x4*)(B + 16384))[i]; }
#pragma unroll
        for (int k = 0; k < 4; ++k) ru[k] = ((const u32x2*)(A + 16384))[tid0 + 512 * k];
        ra = ((const u32x4*)(B + 32768))[tid0]; rge = ((const float*)(p->ws + WS_GE))[u0];
    }
    for (int c = 0; c < 64; ++c) {
        L = lds_opaque(L0);
        LAS unsigned char* VNT = L + GD_PRIV + wave * GD_PRIV_SZ; LAS unsigned char* SB = VNT + 2304;
        LBAR();
        const float ge = rge;
        {
            const int tid = tid_opaque();
#pragma unroll
            for (int k = 0; k < 2; ++k) { const int i = tid + 512 * k;
                *(LAS u32x4*)(L + GD_VN + (i >> 4) * 272 + (i & 15) * 16) = rw[k];
                *(LAS u32x4*)(L + GD_QN + (i >> 4) * 272 + (i & 15) * 16) = rq[k];
                *(LAS u32x4*)(L + GD_KET + (i >> 3) * 144 + (i & 7) * 16) = rk[k]; }
#pragma unroll
            for (int k = 0; k < 4; ++k) { const int i = tid + 512 * k; *(LAS u32x2*)(L + GD_KN + (i >> 4) * 136 + (i & 15) * 8) = ru[k]; }
            *(LAS u32x4*)(L + GD_MT + (tid >> 3) * 144 + (tid & 7) * 16) = ra;
        }
        LBAR();
        GDN2_ENSURE(c + 1 < 64 ? c + 1 : 63);
        {
            const int tid = tid_opaque(); KP pp = kparams();
            const size_t un = u0 + (c + 1 < 64 ? c + 1 : 63);
            const unsigned char* A = pp->ws + WS_H + un * AUXA_UNIT; const unsigned char* B = pp->ws + WS_OCAT + un * AUXB_UNIT;
#pragma unroll
            for (int k = 0; k < 2; ++k) { const int i = tid + 512 * k; rw[k] = ((const u32x4*)A)[i]; rq[k] = ((const u32x4*)B)[i]; rk[k] = ((const u32x4*)(B + 16384))[i]; }
#pragma unroll
            for (int k = 0; k < 4; ++k) ru[k] = ((const u32x2*)(A + 16384))[tid + 512 * k];
            ra = ((const u32x4*)(B + 32768))[tid]; rge = ((const float*)(pp->ws + WS_GE))[un];
        }
        {
            const int tid = tid_opaque(), lane = tid & 63, r16 = lane & 15, q4 = lane >> 4; (void)r16; (void)q4; (void)lane;
            KP pp = kparams(); bf16* ORp = (bf16*)(pp->ws + WS_ORAW) + (size_t)bl * SEQ * OC + h * 128 + wave * 16;
            bf16x8 sbf[4];
#pragma unroll
            for (int k4 = 0; k4 < 4; ++k4) sbf[k4] = *(const LAS bf16x8*)(SB + r16 * 272 + k4 * 64 + q4 * 16);
#pragma unroll
            for (int tl = 0; tl < 4; ++tl) {
                f32x4 p1 = (f32x4){0.f, 0.f, 0.f, 0.f};
#pragma unroll
                for (int k4 = 0; k4 < 4; ++k4) p1 = __builtin_amdgcn_mfma_f32_16x16x32_bf16(*(const LAS bf16x8*)(L + GD_VN + (16 * tl + r16) * 272 + k4 * 64 + q4 * 16), sbf[k4], p1, 0, 0, 0);
                const u32x2 uu = *(const LAS u32x2*)(L + GD_KN + (16 * wave + r16) * 136 + (16 * tl + 4 * q4) * 2);
                *(LAS u32x2*)(VNT + r16 * 144 + (16 * tl + 4 * q4) * 2) = (u32x2){pk2(bflo(uu.x) - p1[0], bfhi(uu.x) - p1[1]), pk2(bflo(uu.y) - p1[2], bfhi(uu.y) - p1[3])};
            }
            const bf16x8 vb0 = *(const LAS bf16x8*)(VNT + r16 * 144 + q4 * 16), vb1 = *(const LAS bf16x8*)(VNT + r16 * 144 + 64 + q4 * 16);
#pragma unroll
            for (int tl = 0; tl < 4; ++tl) {
                f32x4 o = (f32x4){0.f, 0.f, 0.f, 0.f};
#pragma unroll
                for (int k4 = 0; k4 < 4; ++k4) o = __builtin_amdgcn_mfma_f32_16x16x32_bf16(*(const LAS bf16x8*)(L + GD_QN + (16 * tl + r16) * 272 + k4 * 64 + q4 * 16), sbf[k4], o, 0, 0, 0);
                o = __builtin_amdgcn_mfma_f32_16x16x32_bf16(*(const LAS bf16x8*)(L + GD_MT + (16 * tl + r16) * 144 + q4 * 16), vb0, o, 0, 0, 0);
                if (tl >= 2) o = __builtin_amdgcn_mfma_f32_16x16x32_bf16(*(const LAS bf16x8*)(L + GD_MT + (16 * tl + r16) * 144 + 64 + q4 * 16), vb1, o, 0, 0, 0);
                bf16* orow = ORp + (size_t)(c * 64 + 16 * tl + 4 * q4) * OC + r16;
#pragma unroll
                for (int j = 0; j < 4; ++j) orow[(size_t)j * OC] = (bf16)pk1(o[j]);
            }
#pragma unroll
            for (int kt = 0; kt < 8; ++kt) {
                S[kt] = S[kt] * ge;
                S[kt] = __builtin_amdgcn_mfma_f32_16x16x32_bf16(*(const LAS bf16x8*)(L + GD_KET + (16 * kt + r16) * 144 + q4 * 16), vb0, S[kt], 0, 0, 0);
                S[kt] = __builtin_amdgcn_mfma_f32_16x16x32_bf16(*(const LAS bf16x8*)(L + GD_KET + (16 * kt + r16) * 144 + 64 + q4 * 16), vb1, S[kt], 0, 0, 0);
                *(LAS u32x2*)(SB + r16 * 272 + (16 * kt + 4 * q4) * 2) = (u32x2){pk2(S[kt][0], S[kt][1]), pk2(S[kt][2], S[kt][3])};
            }
        }
    }
    LBAR();
}

__device__ __forceinline__ void normgate_phase(KP p, int layer) {
    const int tid_ = tid_opaque(), lane = tid_ & 63, wave = __builtin_amdgcn_readfirstlane(tid_ >> 6);
    const bf16* P = (const bf16*)(p->ws + WS_PROJ); const bf16* ORAW = (const bf16*)(p->ws + WS_ORAW); bf16* OCAT = (bf16*)(p->ws + WS_OCAT);
    const int gw = bid_opaque() * 8 + wave, NGW = grid_opaque() * 8;
    const int c4 = 4 * lane;
    const f32x4 wg = *(const f32x4*)(p->in[9] + layer * 128 + (c4 & 127)), wh = *(const f32x4*)(p->in[11] + layer * 128 + (c4 & 127));
    const f32x4 ws0 = *(const f32x4*)(p->in[17] + layer * 512 + c4), ws1 = *(const f32x4*)(p->in[17] + layer * 512 + 256 + c4);
    const int rpw = (MH + NGW - 1) / NGW, r0 = gw * rpw, r1 = r0 + rpw < MH ? r0 + rpw : MH;
    if (r0 >= r1) return;
    u32x2 on[6], zn[6];
    { const bf16* o = ORAW + (size_t)r0 * OC + c4; const bf16* pr = P + (size_t)r0 * NP + c4;
#pragma unroll
      for (int j = 0; j < 6; ++j) on[j] = *(const u32x2*)(o + 256 * j);
      zn[0] = *(const u32x2*)(pr + C_GZ); zn[1] = *(const u32x2*)(pr + C_GZ + 256); zn[2] = *(const u32x2*)(pr + C_HG); zn[3] = *(const u32x2*)(pr + C_HG + 256); zn[4] = *(const u32x2*)(pr + C_SZ); zn[5] = *(const u32x2*)(pr + C_SZ + 256); }
    for (int r = r0; r < r1; ++r) {
        bf16* oc = OCAT + (size_t)r * OC + c4;
        f32x4 v[6]; u32x2 z[6];
#pragma unroll
        for (int j = 0; j < 6; ++j) { v[j] = (f32x4){bflo(on[j].x), bfhi(on[j].x), bflo(on[j].y), bfhi(on[j].y)}; z[j] = zn[j]; }
        if (r + 1 < r1) { const bf16* o = ORAW + (size_t)(r + 1) * OC + c4; const bf16* pr = P + (size_t)(r + 1) * NP + c4;
#pragma unroll
            for (int j = 0; j < 6; ++j) on[j] = *(const u32x2*)(o + 256 * j);
            zn[0] = *(const u32x2*)(pr + C_GZ); zn[1] = *(const u32x2*)(pr + C_GZ + 256); zn[2] = *(const u32x2*)(pr + C_HG); zn[3] = *(const u32x2*)(pr + C_HG + 256); zn[4] = *(const u32x2*)(pr + C_SZ); zn[5] = *(const u32x2*)(pr + C_SZ + 256); }
#pragma unroll
        for (int j = 0; j < 6; ++j) {
            f32x4 g; g[0] = silu_f(bflo(z[j].x)); g[1] = silu_f(bfhi(z[j].x)); g[2] = silu_f(bflo(z[j].y)); g[3] = silu_f(bfhi(z[j].y));
            f32x4 x = v[j]; if (j >= 4) x = x * g;
            float ss = (x[0] * x[0] + x[1] * x[1]) + (x[2] * x[2] + x[3] * x[3]);
            ss = red16(ss);
            const float s0 = rdl(ss, 0), s1 = rdl(ss, 16), s2 = rdl(ss, 32), s3 = rdl(ss, 48);
            float tot, inv;
            if (j >= 4) { tot = (s0 + s1) + (s2 + s3); inv = 1.f / 256.f; } else { tot = lane < 32 ? s0 + s1 : s2 + s3; inv = 1.f / 128.f; }
            const float rstd = rsqrtf(tot * inv + EPS);
            const f32x4 w = j < 2 ? wg : j < 4 ? wh : j == 4 ? ws0 : ws1;
            f32x4 y = x * rstd * w; if (j < 4) y = y * g;
            u32x2 ov; ov.x = pk2(y[0], y[1]); ov.y = pk2(y[2], y[3]);
            *(u32x2*)(oc + 256 * j) = ov;
        }
    }
}

__device__ __forceinline__ void glu_fix_phase(KP p, int layer) {
    const bf16* RB = (const bf16*)(p->ws + WS_RAWB); bf16* G = (bf16*)(p->ws + WS_G);
    const float* cw = p->in[24] + (size_t)layer * 3 * FF2; const float* cbp = p->in[25] + (size_t)layer * FF2;
    const int gt = bid_opaque() * 512 + tid_opaque(), NT = grid_opaque() * 512;
    constexpr int NPAIR = FF / 2;
    for (int idx = gt; idx < (MH / 64) * NPAIR; idx += NT) {
        const int b = idx / NPAIR, c = (idx % NPAIR) * 2;
        unsigned g[4], v[4];
#pragma unroll
        for (int s_ = 0; s_ < 4; ++s_) { g[s_] = *(const unsigned*)(RB + (size_t)(b * 4 + s_) * FF2 + c); v[s_] = *(const unsigned*)(RB + (size_t)(b * 4 + s_) * FF2 + FF + c); }
        if (((b * 64) % SEQ) == 0) { g[0] = 0u; g[1] = 0u; v[0] = 0u; v[1] = 0u; }
        float wg[3][2], wv[3][2];
#pragma unroll
        for (int k = 0; k < 3; ++k) { wg[k][0] = cw[k * FF2 + c]; wg[k][1] = cw[k * FF2 + c + 1]; wv[k][0] = cw[k * FF2 + FF + c]; wv[k][1] = cw[k * FF2 + FF + c + 1]; }
        const float bg0 = cbp[c], bg1 = cbp[c + 1], bv0 = cbp[FF + c], bv1 = cbp[FF + c + 1];
#pragma unroll
        for (int r = 0; r < 2; ++r) {
            const float ga = wg[0][0] * bflo(g[r]) + wg[1][0] * bflo(g[r + 1]) + wg[2][0] * bflo(g[r + 2]) + bg0;
            const float gb = wg[0][1] * bfhi(g[r]) + wg[1][1] * bfhi(g[r + 1]) + wg[2][1] * bfhi(g[r + 2]) + bg1;
            const float va = wv[0][0] * bflo(v[r]) + wv[1][0] * bflo(v[r + 1]) + wv[2][0] * bflo(v[r + 2]) + bv0;
            const float vb = wv[0][1] * bfhi(v[r]) + wv[1][1] * bfhi(v[r + 1]) + wv[2][1] * bfhi(v[r + 2]) + bv1;
            *(unsigned*)(G + (size_t)(b * 64 + r) * FF + c) = pk2(silu_f(ga) * va, silu_f(gb) * vb);
        }
    }
}

__device__ __forceinline__ void final_norm_phase(KP p) {
    const int tid_ = tid_opaque(), lane = tid_ & 63, wave = __builtin_amdgcn_readfirstlane(tid_ >> 6);
    const int gw = bid_opaque() * 8 + wave, NGW = grid_opaque() * 8;
    const float* nw = p->in[27];
    const int rpw = (MTOT + NGW - 1) / NGW, r0 = gw * rpw, r1 = r0 + rpw < MTOT ? r0 + rpw : MTOT;
    if (r0 >= r1) return;
    f32x4 w[4], v[4], vn[4];
#pragma unroll
    for (int j = 0; j < 4; ++j) { w[j] = *(const f32x4*)(nw + 4 * lane + 256 * j); vn[j] = ((const f32x4*)(p->out + (size_t)r0 * 1024) + lane)[64 * j]; }
    for (int r = r0; r < r1; ++r) {
#pragma unroll
        for (int j = 0; j < 4; ++j) v[j] = vn[j];
        if (r + 1 < r1) {
#pragma unroll
            for (int j = 0; j < 4; ++j) vn[j] = ((const f32x4*)(p->out + (size_t)(r + 1) * 1024) + lane)[64 * j]; }
        float s = 0.f;
#pragma unroll
        for (int j = 0; j < 4; ++j) s += (v[j][0] * v[j][0] + v[j][1] * v[j][1]) + (v[j][2] * v[j][2] + v[j][3] * v[j][3]);
        const float rstd = rsqrtf(wave_sum(s) * (1.f / 1024.f) + EPS);
        f32x4* xr = (f32x4*)(p->out + (size_t)r * 1024) + lane;
#pragma unroll
        for (int j = 0; j < 4; ++j) xr[64 * j] = v[j] * rstd * w[j];
    }
}


#define XB_TMO      128
#define XB_XCNT(j)  (256  + 64 * (j))
#define XB_XSUB(j)  (1280 + 64 * (j))
#define XB_XGEN(j)  (2304 + 64 * (j))
#define XB_TOP      3328
#define XB_TOPGEN   3392
#define XCD_BAR_WORDS 3456
#define XB_SPIN_CAP (1u << 20)
__device__ __forceinline__ unsigned xb_ld(unsigned* p)              { return __hip_atomic_load(p, __ATOMIC_RELAXED, __HIP_MEMORY_SCOPE_AGENT); }
__device__ __forceinline__ unsigned xb_add(unsigned* p, unsigned v) { return __hip_atomic_fetch_add(p, v, __ATOMIC_RELAXED, __HIP_MEMORY_SCOPE_AGENT); }
__device__ __forceinline__ unsigned xb_xcc_id() { return (unsigned)__builtin_amdgcn_s_getreg((3 << 11) | 20) & 0xFu; }
#define XB_SPIN(cond, bar) do { unsigned _sp = 0; while (cond) { __builtin_amdgcn_s_sleep(1); \
    if ((++_sp & 255u) == 0u) { if (xb_ld(&(bar)[XB_TMO])) break; if (_sp > XB_SPIN_CAP) { atomicAdd(&(bar)[XB_TMO], 1u); break; } } } } while (0)
struct XcdBarrier { unsigned* bar; unsigned x; volatile LAS unsigned* st; };
__device__ __forceinline__ XcdBarrier xcd_barrier_post(unsigned* bar, volatile LAS unsigned* st) {
    XcdBarrier b; b.bar = bar; b.x = xb_xcc_id(); b.st = st;
    if (threadIdx.x == 0) (void)xb_add(&bar[XB_XCNT(b.x)], 1u);
    return b;
}
__device__ __forceinline__ void xcd_barrier_complete(unsigned* bar, unsigned x, unsigned& nloc, unsigned& nx) {
    const unsigned G = gridDim.x * gridDim.y * gridDim.z;
    unsigned sum, cnt, mine, sp = 0u;
    for (;;) {
        sum = 0u; cnt = 0u; mine = 0u;
#pragma unroll
        for (unsigned j = 0; j < 16; ++j) { const unsigned c = xb_ld(&bar[XB_XCNT(j)]); sum += c; cnt += (c > 0u) ? 1u : 0u; mine = (j == x) ? c : mine; }
        if (sum == G) break;
        __builtin_amdgcn_s_sleep(1);
        if ((++sp & 255u) == 0u) { if (xb_ld(&bar[XB_TMO])) break; if (sp > XB_SPIN_CAP) { atomicAdd(&bar[XB_TMO], 1u); break; } }
    }
    nloc = mine > 0u ? mine : 1u; nx = cnt > 0u ? cnt : 1u;
}
__device__ __forceinline__ void xcd_barrier(const XcdBarrier& b) {
    asm volatile("s_waitcnt vmcnt(0)" ::: "memory");
    __syncthreads();
    if (threadIdx.x == 0) {
        unsigned* bar = b.bar;
        __builtin_amdgcn_s_waitcnt(0);
        unsigned nloc = b.st[0], nx = b.st[1];
        if (nloc == 0u) { xcd_barrier_complete(bar, b.x, nloc, nx); b.st[0] = nloc; b.st[1] = nx; }
        const unsigned old = xb_add(&bar[XB_XSUB(b.x)], 1u);
        const unsigned gen = old / nloc;
        if (old + 1u == (gen + 1u) * nloc) {
            __builtin_amdgcn_fence(__ATOMIC_RELEASE, "agent");
            asm volatile("s_waitcnt vmcnt(0)" ::: "memory");
            const unsigned og = xb_add(&bar[XB_TOP], 1u);
            const unsigned tg = og / nx;
            if (og + 1u == (tg + 1u) * nx) xb_add(&bar[XB_TOPGEN], 1u);
            else XB_SPIN(xb_ld(&bar[XB_TOPGEN]) == tg, bar);
            __builtin_amdgcn_fence(__ATOMIC_ACQUIRE, "agent");
            xb_add(&bar[XB_XGEN(b.x)], 1u);
            asm volatile("s_waitcnt vmcnt(0)" ::: "memory");
        } else {
            XB_SPIN(xb_ld(&bar[XB_XGEN(b.x)]) == gen, bar);
            __builtin_amdgcn_fence(__ATOMIC_ACQUIRE, "agent");
            asm volatile("s_waitcnt vmcnt(0)" ::: "memory");
        }
    }
    __syncthreads();
}

__global__ void __launch_bounds__(512, 2) mk_fwd(Params pv) {
    extern __shared__ __attribute__((aligned(16))) unsigned char lds_raw[];
    LAS unsigned char* lds = (LAS unsigned char*)lds_raw;
    cg::grid_group grid = cg::this_grid();
    const int ph_lo = pv.ph_lo, ph_hi = pv.ph_hi;
    volatile LAS unsigned* xst = (volatile LAS unsigned*)(lds + XB_ST_OFF);
    if (threadIdx.x < 2) xst[threadIdx.x] = 0u;
    __syncthreads();
    (void)xcd_barrier_post((unsigned*)(pv.ws + WS_BAR), xst);

    for (int ph = ph_lo; ph < ph_hi; ++ph) {
        if (ph > ph_lo) { if (ph == ph_lo + 1) grid.sync(); else { XcdBarrier xb_; xb_.bar = (unsigned*)(kparams()->ws + WS_BAR); xb_.x = xb_xcc_id(); xb_.st = (volatile LAS unsigned*)(lds_opaque(lds) + XB_ST_OFF); xcd_barrier(xb_); } }
        KP p = kparams();
        const int G = grid_opaque();
        unsigned char* ws = p->ws;
        if (ph == 0) { p0_prologue(p, lds); continue; }
        if (ph == NPH - 1) { final_norm_phase(p); continue; }
        const int q = ph - 1, layer = q / 20, hb = (q / 10) % 2, sub = q % 10;
        const int row_base = hb * MH;
        const float* mod = (const float*)(ws + WS_MOD) + (size_t)layer * 16 * 6144;
        const bf16* WL = (const bf16*)(ws + WS_W) + (size_t)layer * W_LAYER;
        bf16* HBUF = (bf16*)(ws + WS_H);
        const bf16* gA = nullptr; const bf16* gB = nullptr; int nt = 0, lda = 0, ldb = 0, nN = 0, epi = -1;
        switch (sub) {
        case 0: {
            const float* xin = (layer == 0 ? p->in[0] : p->out);
            norm_mod_phase(xin + (size_t)row_base * 1024, row_base, p->in[4] + layer * 1024, mod + 0, mod + 1024, HBUF, WL + W_IN + (size_t)C_SMALL * 1024, (float*)(ws + WS_SM));
        } break;
        case 1:
            gA = HBUF; gB = WL + W_IN; nt = 16; lda = 1024; ldb = 1024; nN = ((MH + G * 8 - 1) / (G * 8) == 16) ? C_SMALL / 256 : NP / 256; epi = 0; break;
        case 2: {
            const int b = bid_opaque();
            if (b < 64) ssd_unit(p, b, layer, lds);
            else if (b < 128) hgrn_unit(p, b - 64, layer, lds);
            else if (b < 160) gdn2_unit(p, b - 128, layer, layer * 2 + hb, lds);
            else if (G - 160 >= 32 && (G - 160) % 32 == 0) {
                u32x4 xr[3][4][2]; const int st = G - 160; int j = b - 160;
                gdn1_load_rows(p, ((j & 31) << 6) | (j >> 5), xr);
                for (; j < 2048; j += st) { const int jn = j + st < 2048 ? j + st : j; gdn1_unit(p, ((j & 31) << 6) | (j >> 5), layer, lds, xr, j == b - 160, ((jn & 31) << 6) | (jn >> 5)); }
            } else {
                u32x4 xr[3][4][2]; const int st = G - 160;
                for (int j = b - 160; j < 2048; j += st) { gdn1_load_rows(p, ((j & 31) << 6) | (j >> 5), xr); gdn1_unit(p, ((j & 31) << 6) | (j >> 5), layer, lds, xr, true, ((j & 31) << 6) | (j >> 5)); }
            }
        } break;
        case 3:
            normgate_phase(p, layer);
            break;
        case 4:
            gA = (const bf16*)(ws + WS_OCAT); gB = WL + W_BR; nt = 24; lda = OC; ldb = OC; nN = 4; epi = 1; break;
        case 5:
            gA = HBUF; gB = WL + W_OUT; nt = 16; lda = 1024; ldb = 1024; nN = 4; epi = 4; break;
        case 6:
            norm_mod_phase(p->out + (size_t)row_base * 1024, row_base, p->in[22] + layer * 1024, mod + 3072, mod + 4096, HBUF, nullptr, nullptr);
            break;
        case 7:
            gA = HBUF; gB = WL + W_UP; nt = 16; lda = 1024; ldb = 1024; nN = FF2 / 256; epi = 5; break;
        case 8:
            glu_fix_phase(p, layer);
            break;
        default:
            gA = (const bf16*)(ws + WS_G); gB = WL + W_DN; nt = FF / 64; lda = FF; ldb = FF; nN = 4; epi = 6; break;
        }
        if (epi >= 0) pg8::gemm_phase(lds, gA, gB, nt, lda, ldb, nN, epi, layer, row_base);
    }
}

extern "C" void kernel_launch(void* const* d_in, const int* in_sizes, int n_in, void* d_out, int out_size, void* d_ws, size_t ws_size, hipStream_t stream) {
    static int grid = 0;
    if (grid == 0) {
        if (n_in != 28 || out_size != MTOT * DM || ws_size < WS_END) { fprintf(stderr, "kernel_launch: unexpected problem: n_in %d out %d ws %zu (need %zu)\n", n_in, out_size, ws_size, (size_t)WS_END); grid = -1; return; }
        int dev = 0, cus = 0, per_cu = 0;
        hipGetDevice(&dev); hipDeviceGetAttribute(&cus, hipDeviceAttributeMultiprocessorCount, dev);
        hipFuncSetAttribute((const void*)mk_fwd, hipFuncAttributeMaxDynamicSharedMemorySize, LDS_BYTES);
        hipOccupancyMaxActiveBlocksPerMultiprocessor(&per_cu, (const void*)mk_fwd, 512, LDS_BYTES);
        if (per_cu < 1) { fprintf(stderr, "kernel_launch: occupancy query says %d blocks per CU\n", per_cu); per_cu = 1; }
        (void)hipGetLastError();
        grid = cus;
        if (grid < 192) { fprintf(stderr, "kernel_launch: %d CUs: the mixer phase needs at least 192 workgroups\n", grid); grid = -1; return; }
    }
    if (grid < 0) return;
    Params p{};
    for (int i = 0; i < 28; ++i) p.in[i] = (const float*)d_in[i];
    p.out = (float*)d_out; p.ws = (unsigned char*)d_ws;
#if MK_COOP
    p.ph_lo = 0; p.ph_hi = NPH;
    (void)hipMemsetAsync((char*)d_ws + WS_BAR, 0, 16384, stream);
    void* args[] = {&p};
    hipError_t e = hipLaunchCooperativeKernel((const void*)mk_fwd, dim3(grid), dim3(512), args, LDS_BYTES, stream);
    if (e != hipSuccess) fprintf(stderr, "cooperative launch failed: %s (grid %d)\n", hipGetErrorString(e), grid);
#else
    for (int ph = 0; ph < NPH; ++ph) { p.ph_lo = ph; p.ph_hi = ph + 1; hipLaunchKernelGGL(mk_fwd, dim3(grid), dim3(512), LDS_BYTES, stream, p); }
#endif
}
```

```cpp
#include <hip/hip_runtime.h>
#include <hip/hip_cooperative_groups.h>
#include <cstdio>
#include <cstdint>
namespace cg = cooperative_groups;

#ifndef MK_COOP
#define MK_COOP 1
#endif

#define LAS __attribute__((address_space(3)))
typedef unsigned short bf16;
typedef short bf16x8 __attribute__((ext_vector_type(8)));
typedef float f32x4 __attribute__((ext_vector_type(4)));
typedef unsigned u32x4 __attribute__((ext_vector_type(4)));
typedef unsigned u32x2 __attribute__((ext_vector_type(2)));

constexpr int DM = 1024, SEQ = 4096, BATCH = 16, MTOT = BATCH * SEQ, HB_SEQ = 8, MH = HB_SEQ * SEQ;
constexpr int NIN = 8720, NP = 8960;
constexpr int C_GZ = 1536, C_HQ = 2048, C_HF = 2560, C_HI = 3072, C_HG = 3584, C_SZ = 4096, C_XBC = 4608, C_GATE = 5632, C_SMALL = 8704;
constexpr int FF = 2816, FF2 = 5632, OC = 1536;
constexpr float EPS = 1e-6f;
constexpr size_t W_IN = 0, W_BR = (size_t)NP * 1024, W_OUT = W_BR + 3 * 524288, W_UP = W_OUT + 1048576, W_DN = W_UP + (size_t)FF2 * 1024, W_LAYER = W_DN + (size_t)FF * 1024;
constexpr size_t MiB = 1u << 20;
constexpr size_t WS_MOD = 0, WS_W = 1 * MiB, WS_H = 80 * MiB, WS_SM = 144 * MiB, WS_OCAT = 146 * MiB, WS_ORAW = 242 * MiB, WS_PROJ = 434 * MiB, WS_G = 786 * MiB, WS_END = 994 * MiB;
static_assert(WS_W + 2 * W_LAYER * 2 <= WS_H, "weights fit");
constexpr size_t WS_RAWB = 338 * MiB;
constexpr int LDS_BYTES = 147456 + 256;
constexpr int XB_ST_OFF = 147456;
constexpr size_t WS_BAR = 900 * 1024;
constexpr int NPH = 42;

typedef float f32x2_t __attribute__((ext_vector_type(2)));
typedef __bf16 bf16x2_t __attribute__((ext_vector_type(2)));
__device__ __forceinline__ unsigned pk2(float lo, float hi) { const f32x2_t v = {lo, hi}; const bf16x2_t b = __builtin_convertvector(v, bf16x2_t); return __builtin_bit_cast(unsigned, b); }
__device__ __forceinline__ unsigned f2bf(float f) { return pk2(f, f) & 0xffffu; }
__device__ __forceinline__ unsigned pk1(float f) { return pk2(f, f); }
__device__ __forceinline__ float bf2f(unsigned b) { return __builtin_bit_cast(float, b << 16); }
__device__ __forceinline__ float bflo(unsigned w) { return __builtin_bit_cast(float, w << 16); }
__device__ __forceinline__ float bfhi(unsigned w) { return __builtin_bit_cast(float, w & 0xffff0000u); }
__device__ __forceinline__ float silu_f(float v) { return v * __builtin_amdgcn_rcpf(1.f + __builtin_amdgcn_exp2f(-1.4426950408889634f * v)); }
__device__ __forceinline__ float sigmoid_f(float v) { return __builtin_amdgcn_rcpf(1.f + __builtin_amdgcn_exp2f(-1.4426950408889634f * v)); }
__device__ __forceinline__ float softplus_f(float v) { const float z = __expf(-fabsf(v)); const float l = (z < 0.01f) ? z * (1.f - z * (0.5f - z * (1.f / 3.f))) : __logf(1.f + z); return fmaxf(v, 0.f) + l; }
template <int CTRL> __device__ __forceinline__ float dppf(float v) { return __builtin_bit_cast(float, __builtin_amdgcn_update_dpp(0, __builtin_bit_cast(int, v), CTRL, 0xf, 0xf, true)); }
__device__ __forceinline__ float red16(float v) { v += dppf<0xB1>(v); v += dppf<0x4E>(v); v += dppf<0x141>(v); v += dppf<0x128>(v); return v; }
__device__ __forceinline__ float rdl(float v, int l) { return __builtin_bit_cast(float, __builtin_amdgcn_readlane(__builtin_bit_cast(int, v), l)); }
__device__ __forceinline__ float wave_sum(float v) { v = red16(v); return (rdl(v, 0) + rdl(v, 16)) + (rdl(v, 32) + rdl(v, 48)); }
__device__ __forceinline__ float wave_scan_incl(float v, int lane) {
    v += dppf<0x111>(v); v += dppf<0x112>(v); v += dppf<0x114>(v); v += dppf<0x118>(v);
    const float t0 = rdl(v, 15), t1 = rdl(v, 31), t2 = rdl(v, 47); const int q = lane >> 4;
    return v + (q >= 1 ? t0 : 0.f) + (q >= 2 ? t1 : 0.f) + (q >= 3 ? t2 : 0.f);
}

struct Params { const float* in[28]; float* out; unsigned char* ws; int ph_lo, ph_hi; };
typedef const __attribute__((address_space(4))) Params* KP;
__device__ __forceinline__ int tid_opaque() { int t = threadIdx.x; asm volatile("" : "+v"(t)); return t; }
__device__ __forceinline__ int bid_opaque() { int b = blockIdx.x; asm volatile("" : "+s"(b)); return b; }
__device__ __forceinline__ int grid_opaque() { int g = gridDim.x; asm volatile("" : "+s"(g)); return g; }
__device__ __forceinline__ LAS unsigned char* lds_opaque(LAS unsigned char* l) { asm volatile("" : "+s"(l)); return l; }
__device__ __forceinline__ KP kparams() { KP q = (KP)__builtin_amdgcn_kernarg_segment_ptr(); asm volatile("" : "+s"(q)); return q; }


namespace pg8 {
constexpr int BM = 256, BK = 64, HALF = 128, HTB = HALF * BK * 2, STAGE_BYTES = 8 * HTB, NXCD = 8, WGM = 4;
__device__ __forceinline__ int lds_byte(int r, int c) { const int st = (r >> 4) * 2 + (c >> 5), rr = r & 15, cc = c & 31, ob = rr * 64 + cc * 2; return st * 1024 + (ob ^ (((ob >> 9) & 1) << 5)); }
__device__ __forceinline__ void stage_rc(int b, int& R, int& C) { const int st = b / 1024, sb = b % 1024, swz = sb ^ (((sb >> 9) & 1) << 5); R = (st >> 1) * 16 + swz / 64; C = (st & 1) * 32 + (swz % 64) / 2; }
__device__ __forceinline__ int perm32(int rho) { const int n = rho >> 4, i = rho & 15; return 8 * (i >> 2) + 4 * n + (i & 3); }
struct Unit { int pm, pn; };
struct StaticOrder {
    int nM, nN, nwg, G, c;
    __device__ __forceinline__ void init(int M, int N, int G_, int c_) { nM = M / BM; nN = N / BM; nwg = nM * nN; G = G_; c = c_; }
    __device__ __forceinline__ bool next(int i, Unit& u) const {
        const long L = (long)i * G + c; if (L >= nwg) return false;
        int wgid = (int)L; { const int q = nwg / NXCD, r = nwg % NXCD, xcd = wgid % NXCD, off = wgid / NXCD; wgid = (xcd < r ? xcd * (q + 1) : r * (q + 1) + (xcd - r) * q) + off; }
        const int nig = WGM * nN, gid = wgid / nig, fm = gid * WGM, gsz = (nM - fm) < WGM ? (nM - fm) : WGM;
        u.pm = fm + ((wgid % nig) % gsz); u.pn = (wgid % nig) / gsz; return true;
    }
};
__device__ __forceinline__ unsigned cvt_pk_bf16(float lo, float hi) { return pk2(lo, hi); }

template <int LDC, bool SMALL> struct EpiBf16 {
    static constexpr bool PERM = true;
    __device__ __forceinline__ void operator()(const f32x4 (&acc)[2][2][4][2], const Unit& u, int wr, int wc, int fr, int fq) const {
        KP p = kparams(); unsigned char* ws = p->ws;
        bf16* O = (bf16*)(ws + WS_PROJ);
        const int row0 = u.pm * BM + wr * 64 + fr; const int col0 = u.pn * BM + wc * 32 + 8 * fq;
#pragma unroll
        for (int ai = 0; ai < 2; ++ai)
#pragma unroll
            for (int m = 0; m < 4; ++m) { bf16* rowp = O + (size_t)(row0 + ai * HALF + m * 16) * LDC + col0;
#pragma unroll
                for (int bj = 0; bj < 2; ++bj) { const f32x4 v0 = acc[ai][bj][m][0], v1 = acc[ai][bj][m][1];
                    u32x4 w; w.x = cvt_pk_bf16(v0[0], v0[1]); w.y = cvt_pk_bf16(v0[2], v0[3]); w.z = cvt_pk_bf16(v1[0], v1[1]); w.w = cvt_pk_bf16(v1[2], v1[3]);
                    *(u32x4*)(rowp + bj * HALF) = w; } }
        if (SMALL && u.pn == C_SMALL / 256 && wc == 0 && fq < 2) {
            float* sm = (float*)(ws + WS_SM);
#pragma unroll
            for (int ai = 0; ai < 2; ++ai)
#pragma unroll
                for (int m = 0; m < 4; ++m) { float* q = sm + (size_t)(row0 + ai * HALF + m * 16) * 16 + 8 * fq; *(f32x4*)q = acc[ai][0][m][0]; *(f32x4*)(q + 4) = acc[ai][0][m][1]; }
        }
    }
};
__device__ __forceinline__ void branch_rescale(f32x4 (&acc)[2][2][4][2], const Unit& u, int wr, int wc, int fr, int fq, int which) {
    KP p = kparams();
    const bf16* gate = (const bf16*)(p->ws + WS_PROJ) + C_GATE + which * 1024;
    const int col0 = u.pn * BM + wc * 32 + 4 * fq;
#pragma unroll
    for (int ai = 0; ai < 2; ++ai)
#pragma unroll
        for (int mp = 0; mp < 2; ++mp) {
            u32x2 ga[2][2][2], gb[2][2][2];
#pragma unroll
            for (int mm = 0; mm < 2; ++mm) { const size_t row = (size_t)(u.pm * BM + ai * HALF + wr * 64 + (2 * mp + mm) * 16 + fr);
#pragma unroll
                for (int bj = 0; bj < 2; ++bj)
#pragma unroll
                    for (int n = 0; n < 2; ++n) { const int c = col0 + bj * HALF + n * 16; ga[mm][bj][n] = *(const u32x2*)(gate + row * NP + c); gb[mm][bj][n] = *(const u32x2*)(gate + row * NP + 1024 + c); } }
#pragma unroll
            for (int mm = 0; mm < 2; ++mm)
#pragma unroll
                for (int bj = 0; bj < 2; ++bj)
#pragma unroll
                    for (int n = 0; n < 2; ++n) { const u32x2 xa = ga[mm][bj][n], xb = gb[mm][bj][n];
                        f32x4 r;
                        r[0] = (1.f + __builtin_amdgcn_exp2f(-1.4426950408889634f * bflo(xb.x))) * __builtin_amdgcn_rcpf(1.f + __builtin_amdgcn_exp2f(-1.4426950408889634f * bflo(xa.x)));
                        r[1] = (1.f + __builtin_amdgcn_exp2f(-1.4426950408889634f * bfhi(xb.x))) * __builtin_amdgcn_rcpf(1.f + __builtin_amdgcn_exp2f(-1.4426950408889634f * bfhi(xa.x)));
                        r[2] = (1.f + __builtin_amdgcn_exp2f(-1.4426950408889634f * bflo(xb.y))) * __builtin_amdgcn_rcpf(1.f + __builtin_amdgcn_exp2f(-1.4426950408889634f * bflo(xa.y)));
                        r[3] = (1.f + __builtin_amdgcn_exp2f(-1.4426950408889634f * bfhi(xb.y))) * __builtin_amdgcn_rcpf(1.f + __builtin_amdgcn_exp2f(-1.4426950408889634f * bfhi(xa.y)));
                        acc[ai][bj][2 * mp + mm][n] = acc[ai][bj][2 * mp + mm][n] * r; }
        }
    asm volatile("s_waitcnt vmcnt(0)" ::: "memory");
}
struct EpiBranchFinal {
    static constexpr bool PERM = false;
    __device__ __forceinline__ void operator()(const f32x4 (&acc)[2][2][4][2], const Unit& u, int wr, int wc, int fr, int fq) const {
        KP p = kparams(); unsigned char* ws = p->ws;
        const bf16* gate = (const bf16*)(ws + WS_PROJ) + C_GATE + 2048; bf16* mb = (bf16*)(ws + WS_H);
        const int col0 = u.pn * BM + wc * 32 + 4 * fq;
#pragma unroll
        for (int ai = 0; ai < 2; ++ai)
#pragma unroll
            for (int mp = 0; mp < 2; ++mp) {
                u32x2 gr[2][2][2];
#pragma unroll
                for (int mm = 0; mm < 2; ++mm) { const size_t row = (size_t)(u.pm * BM + ai * HALF + wr * 64 + (2 * mp + mm) * 16 + fr);
#pragma unroll
                    for (int bj = 0; bj < 2; ++bj)
#pragma unroll
                        for (int n = 0; n < 2; ++n) gr[mm][bj][n] = *(const u32x2*)(gate + row * NP + col0 + bj * HALF + n * 16); }
#pragma unroll
                for (int mm = 0; mm < 2; ++mm) { const size_t row = (size_t)(u.pm * BM + ai * HALF + wr * 64 + (2 * mp + mm) * 16 + fr);
#pragma unroll
                    for (int bj = 0; bj < 2; ++bj)
#pragma unroll
                        for (int n = 0; n < 2; ++n) { const int c = col0 + bj * HALF + n * 16; const u32x2 x = gr[mm][bj][n];
                            f32x4 g; g[0] = sigmoid_f(bflo(x.x)); g[1] = sigmoid_f(bfhi(x.x)); g[2] = sigmoid_f(bflo(x.y)); g[3] = sigmoid_f(bfhi(x.y));
                            const f32x4 v = acc[ai][bj][2 * mp + mm][n] * g; u32x2 w; w.x = cvt_pk_bf16(v[0], v[1]); w.y = cvt_pk_bf16(v[2], v[3]); *(u32x2*)(mb + row * 1024 + c) = w; } }
            }
    }
};
struct EpiUpGlu {
    static constexpr bool PERM = true;
    int layer;
    __device__ __forceinline__ void operator()(const f32x4 (&acc)[2][2][4][2], const Unit& u, int wr, int wc, int fr, int fq) const {
        KP p = kparams(); unsigned char* ws = p->ws;
        bf16* G = (bf16*)(ws + WS_G); bf16* RB = (bf16*)(ws + WS_RAWB);
        const float* cw = p->in[24] + (size_t)layer * 3 * FF2; const float* cb = p->in[25] + (size_t)layer * FF2;
        const int gcol = u.pn * 128 + wc * 32 + 8 * fq;
#pragma unroll
        for (int n = 0; n < 2; ++n) {
            asm volatile("" ::: "memory");
            f32x4 wg[3], wv[3];
#pragma unroll
            for (int k = 0; k < 3; ++k) { wg[k] = *(const f32x4*)(cw + k * FF2 + gcol + 4 * n); wv[k] = *(const f32x4*)(cw + k * FF2 + FF + gcol + 4 * n); }
            const f32x4 bg = *(const f32x4*)(cb + gcol + 4 * n), bv = *(const f32x4*)(cb + FF + gcol + 4 * n);
#pragma unroll
            for (int ai = 0; ai < 2; ++ai)
#pragma unroll
                for (int m = 0; m < 4; ++m) {
                    const int row = u.pm * BM + ai * HALF + wr * 64 + m * 16 + fr;
                    float o[4];
#pragma unroll
                    for (int e = 0; e < 4; ++e) {
                        const float cg = n == 0 ? acc[ai][0][m][0][e] : acc[ai][0][m][1][e], cv = n == 0 ? acc[ai][1][m][0][e] : acc[ai][1][m][1][e];
                        const float pg = m > 0 ? (n == 0 ? acc[ai][0][m > 0 ? m - 1 : 0][0][e] : acc[ai][0][m > 0 ? m - 1 : 0][1][e]) : cg;
                        const float pv = m > 0 ? (n == 0 ? acc[ai][1][m > 0 ? m - 1 : 0][0][e] : acc[ai][1][m > 0 ? m - 1 : 0][1][e]) : cv;
                        const float cg1 = dppf<0x121>(cg), pg1 = dppf<0x121>(pg), cg2 = dppf<0x122>(cg), pg2 = dppf<0x122>(pg);
                        const float cv1 = dppf<0x121>(cv), pv1 = dppf<0x121>(pv), cv2 = dppf<0x122>(cv), pv2 = dppf<0x122>(pv);
                        const float g1 = fr >= 1 ? cg1 : pg1, g2 = fr >= 2 ? cg2 : pg2, v1 = fr >= 1 ? cv1 : pv1, v2 = fr >= 2 ? cv2 : pv2;
                        const float yg = wg[0][e] * g2 + wg[1][e] * g1 + wg[2][e] * cg + bg[e];
                        const float yv = wv[0][e] * v2 + wv[1][e] * v1 + wv[2][e] * cv + bv[e];
                        o[e] = silu_f(yg) * yv;
                    }
                    if (!(m == 0 && fr < 2)) { u32x2 w; w.x = pk2(o[0], o[1]); w.y = pk2(o[2], o[3]); *(u32x2*)(G + (size_t)row * FF + gcol + 4 * n) = w; }
                    int slot = -1, b = row >> 6;
                    if (m == 0 && fr < 2) slot = 2 + fr; else if (m == 3 && fr >= 14) { slot = fr - 14; b += 1; }
                    if (slot >= 0 && b < MH / 64) {
                        const f32x4 g0 = n == 0 ? acc[ai][0][m][0] : acc[ai][0][m][1], v0 = n == 0 ? acc[ai][1][m][0] : acc[ai][1][m][1];
                        bf16* rb = RB + (size_t)(b * 4 + slot) * FF2 + gcol + 4 * n;
                        u32x2 w; w.x = pk2(g0[0], g0[1]); w.y = pk2(g0[2], g0[3]); *(u32x2*)rb = w;
                        w.x = pk2(v0[0], v0[1]); w.y = pk2(v0[2], v0[3]); *(u32x2*)(rb + FF) = w;
                    }
                }
        }
    }
};
template <bool SECOND> struct EpiResid {
    static constexpr bool PERM = false;
    int layer, row_base;
    __device__ __forceinline__ void operator()(const f32x4 (&acc)[2][2][4][2], const Unit& u, int wr, int wc, int fr, int fq) const {
        KP p = kparams();
        float* out = p->out; const float* base = (SECOND || layer != 0) ? (const float*)out : p->in[0];
        const float* gate = (const float*)(p->ws + WS_MOD) + (size_t)layer * 16 * 6144 + (SECOND ? 5120 : 2048);
        const int col0 = u.pn * BM + wc * 32 + 4 * fq;
        const int b = (row_base + u.pm * BM) / SEQ;
        f32x4 gv[2][2];
#pragma unroll
        for (int bj = 0; bj < 2; ++bj)
#pragma unroll
            for (int n = 0; n < 2; ++n) gv[bj][n] = *(const f32x4*)(gate + (size_t)b * 6144 + col0 + bj * HALF + n * 16);
#pragma unroll
        for (int ai = 0; ai < 2; ++ai)
#pragma unroll
            for (int mp = 0; mp < 2; ++mp) {
                f32x4 bs[2][2][2];
#pragma unroll
                for (int mm = 0; mm < 2; ++mm) { const size_t off = (size_t)(row_base + u.pm * BM + ai * HALF + wr * 64 + (2 * mp + mm) * 16 + fr) * 1024 + col0;
#pragma unroll
                    for (int bj = 0; bj < 2; ++bj)
#pragma unroll
                        for (int n = 0; n < 2; ++n) bs[mm][bj][n] = *(const f32x4*)(base + off + bj * HALF + n * 16); }
#pragma unroll
                for (int mm = 0; mm < 2; ++mm) { const size_t off = (size_t)(row_base + u.pm * BM + ai * HALF + wr * 64 + (2 * mp + mm) * 16 + fr) * 1024 + col0;
#pragma unroll
                    for (int bj = 0; bj < 2; ++bj)
#pragma unroll
                        for (int n = 0; n < 2; ++n) *(f32x4*)(out + off + bj * HALF + n * 16) = bs[mm][bj][n] + gv[bj][n] * acc[ai][bj][2 * mp + mm][n]; }
            }
    }
};

__device__ __forceinline__ void gemm_phase(LAS unsigned char* lds, const bf16* gA, const bf16* gBt, const int nt, const int LDA, const int LDB, const int nN, const int epi, const int layer, const int row_base) {
    StaticOrder S; S.nM = MH / BM; S.nN = nN; S.nwg = S.nM * nN; S.G = grid_opaque(); S.c = bid_opaque();
    const bool PERM = (epi == 0 || epi == 5);
    const int tid = tid_opaque(), wid = __builtin_amdgcn_readfirstlane(tid >> 6), lane = tid & 63, wr = wid >> 2, wc = wid & 3;
    unsigned voffA[2], voffB[2];
#pragma unroll
    for (int i = 0; i < 2; ++i) { int R, C; stage_rc(tid * 16 + i * 8192, R, C); const int Rb = PERM ? ((R & ~31) + perm32(R & 31)) : R;
        voffA[i] = (unsigned)(R * LDA + C) * 2u; voffB[i] = (unsigned)(Rb * LDB + C) * 2u; }
    constexpr size_t kstep = (size_t)(BK * 2);
    const size_t hstepA = (size_t)HALF * LDA * 2, hstepB = (size_t)HALF * LDB * 2;
    const size_t tstepA = 2 * hstepA, tstepB = 2 * hstepB;
    const unsigned ldsw = (unsigned)wid * 1024u;
    const int aoff = lds_byte(wr * 64 + (lane & 15), (lane >> 4) * 8), boff = lds_byte(wc * 32 + (lane & 15), (lane >> 4) * 8);
#define PG8_SA(b, h) (((b) * 2 + (h)) * HTB)
#define PG8_SB(b, h) ((4 + (b) * 2 + (h)) * HTB)
#define PG8_STAGE(bufoff, gbase, voff) do { _Pragma("unroll") for (int _i = 0; _i < 2; ++_i) \
        __builtin_amdgcn_global_load_lds((const unsigned*)((const char*)(gbase) + (voff)[_i]), (LAS unsigned*)(lds + (bufoff) + ldsw + _i * 8192), 16, 0, 0); } while (0)
#define PG8_LDA(dst, b, h) do { _Pragma("unroll") for (int m = 0; m < 4; ++m) _Pragma("unroll") for (int k = 0; k < 2; ++k) dst[m][k] = *(const LAS bf16x8*)(lds + PG8_SA(b, h) + aoff + m * 2048 + k * 1024); } while (0)
#define PG8_LDB(dst, b, h) do { _Pragma("unroll") for (int n = 0; n < 2; ++n) _Pragma("unroll") for (int k = 0; k < 2; ++k) dst[n][k] = *(const LAS bf16x8*)(lds + PG8_SB(b, h) + boff + n * 2048 + k * 1024); } while (0)
#define PG8_MMA(ai, bj, At, Bt) do { __builtin_amdgcn_s_setprio(1); _Pragma("unroll") for (int m = 0; m < 4; ++m) _Pragma("unroll") for (int n = 0; n < 2; ++n) _Pragma("unroll") for (int k = 0; k < 2; ++k) \
        acc[ai][bj][m][n] = __builtin_amdgcn_mfma_f32_16x16x32_bf16(Bt[n][k], At[m][k], acc[ai][bj][m][n], 0, 0, 0); __builtin_amdgcn_s_setprio(0); } while (0)
#define PG8_WAIT_V(n) asm volatile("s_waitcnt vmcnt(" #n ")" ::: "memory")
#define PG8_WAIT_L(n) asm volatile("s_waitcnt lgkmcnt(" #n ")" ::: "memory")
#define PG8_BAR __builtin_amdgcn_s_barrier()
#define PG8_SCHED __builtin_amdgcn_sched_barrier(0)
    Unit cur, nxt; int ui = 0;
    if (!S.next(0, cur)) return;
    f32x4 acc[2][2][4][2];
#pragma unroll
    for (int a = 0; a < 2; ++a)
#pragma unroll
        for (int b = 0; b < 2; ++b)
#pragma unroll
            for (int m = 0; m < 4; ++m)
#pragma unroll
                for (int n = 0; n < 2; ++n) acc[a][b][m][n] = (f32x4){0.f, 0.f, 0.f, 0.f};
    bf16x8 At[4][2], B0[2][2], B1[2][2];
    const char* cA = (const char*)gA + (size_t)cur.pm * tstepA; const char* cB = (const char*)gBt + (size_t)cur.pn * tstepB;
    PG8_STAGE(PG8_SB(0, 0), cB, voffB); PG8_STAGE(PG8_SB(0, 1), cB + hstepB, voffB); PG8_STAGE(PG8_SA(0, 0), cA, voffA); PG8_STAGE(PG8_SA(0, 1), cA + hstepA, voffA);
    if (wr == 1) PG8_BAR;
    PG8_WAIT_V(2); PG8_BAR;
    PG8_STAGE(PG8_SB(1, 0), cB + kstep, voffB); PG8_STAGE(PG8_SA(1, 0), cA + kstep, voffA); PG8_STAGE(PG8_SB(1, 1), cB + hstepB + kstep, voffB);
    PG8_WAIT_V(6); PG8_BAR;
    for (;;) {
        const bool has_next = S.next(ui + 1, nxt);
        const char* nA = has_next ? (const char*)gA + (size_t)nxt.pm * tstepA : cA; const char* nB = has_next ? (const char*)gBt + (size_t)nxt.pn * tstepB : cB;
        for (int t = 0; t < nt; t += 2) {
            if (epi == 1 && (t == 8 || t == 16)) { const int tr_ = tid_opaque(); branch_rescale(acc, cur, wr, wc, tr_ & 15, (tr_ & 63) >> 4, t == 8 ? 0 : 1); }
            const bool last = (t == nt - 2);
            const char* a1 = cA + (size_t)(t + 1) * kstep;
            const char* a2 = last ? nA : cA + (size_t)(t + 2) * kstep; const char* b2 = last ? nB : cB + (size_t)(t + 2) * kstep;
            const char* a3 = a2 + kstep; const char* b3 = b2 + kstep;
            PG8_LDB(B0, 0, 0); PG8_LDB(B1, 0, 1); PG8_SCHED; PG8_LDA(At, 0, 0); PG8_STAGE(PG8_SA(1, 1), a1 + hstepA, voffA);
            PG8_WAIT_V(8); PG8_WAIT_L(0); PG8_BAR; PG8_MMA(0, 0, At, B0); PG8_MMA(0, 1, At, B1); PG8_BAR; PG8_SCHED;
            PG8_LDA(At, 0, 1); PG8_STAGE(PG8_SB(0, 0), b2, voffB); PG8_STAGE(PG8_SB(0, 1), b2 + hstepB, voffB); PG8_STAGE(PG8_SA(0, 0), a2, voffA);
            PG8_WAIT_V(8); PG8_WAIT_L(0); PG8_BAR; PG8_MMA(1, 0, At, B0); PG8_MMA(1, 1, At, B1); PG8_BAR; PG8_SCHED;
            PG8_LDB(B0, 1, 0); PG8_LDB(B1, 1, 1); PG8_SCHED; PG8_LDA(At, 1, 0); PG8_STAGE(PG8_SA(0, 1), a2 + hstepA, voffA);
            PG8_WAIT_V(8); PG8_WAIT_L(0); PG8_BAR; PG8_MMA(0, 0, At, B0); PG8_MMA(0, 1, At, B1); PG8_BAR; PG8_SCHED;
            PG8_LDA(At, 1, 1); PG8_STAGE(PG8_SB(1, 0), b3, voffB); PG8_STAGE(PG8_SB(1, 1), b3 + hstepB, voffB); PG8_STAGE(PG8_SA(1, 0), a3, voffA);
            PG8_WAIT_V(8); PG8_WAIT_L(0); PG8_BAR; PG8_MMA(1, 0, At, B0); PG8_MMA(1, 1, At, B1); PG8_BAR; PG8_SCHED;
        }
        if (wr == 0) PG8_BAR;
        const int te = tid_opaque(), fr = te & 15, fq = (te & 63) >> 4;
        switch (epi) {
        case 0: { EpiBf16<NP, true> E; E(acc, cur, wr, wc, fr, fq); } break;
        case 1: { EpiBranchFinal E; E(acc, cur, wr, wc, fr, fq); } break;
        case 4: { EpiResid<false> E{layer, row_base}; E(acc, cur, wr, wc, fr, fq); } break;
        case 5: { EpiUpGlu E{layer}; E(acc, cur, wr, wc, fr, fq); } break;
        default: { EpiResid<true> E{layer, row_base}; E(acc, cur, wr, wc, fr, fq); } break;
        }
        if (!has_next) break;
#pragma unroll
        for (int a = 0; a < 2; ++a)
#pragma unroll
            for (int b = 0; b < 2; ++b)
#pragma unroll
                for (int m = 0; m < 4; ++m)
#pragma unroll
                    for (int n = 0; n < 2; ++n) acc[a][b][m][n] = (f32x4){0.f, 0.f, 0.f, 0.f};
        cur = nxt; cA = nA; cB = nB; ++ui;
        if (wr == 1) PG8_BAR;
    }
    PG8_WAIT_V(0);
    PG8_BAR;
#undef PG8_SA
#undef PG8_SB
#undef PG8_STAGE
#undef PG8_LDA
#undef PG8_LDB
#undef PG8_MMA
#undef PG8_WAIT_V
#undef PG8_WAIT_L
#undef PG8_BAR
#undef PG8_SCHED
}
}

__device__ __forceinline__ void tr_item(const float* W, int K, int ldw, int src_col0, int nblk, bf16* WT, int dst_row0, LAS float* scr, int item, int lane) {
    const int kb = item / nblk, nb = item % nblk, k0 = 64 * kb, n0 = 32 * nb;
    float wv_[32];
#pragma unroll
    for (int i = 0; i < 32; ++i) { const int kk = 2 * i + (lane >> 5); wv_[i] = W[(size_t)(k0 + kk) * ldw + src_col0 + n0 + (lane & 31)]; }
#pragma unroll
    for (int i = 0; i < 32; ++i) { const int kk = 2 * i + (lane >> 5); scr[kk * 33 + (lane & 31)] = wv_[i]; }
    asm volatile("s_waitcnt lgkmcnt(0)" ::: "memory");
    const int c = lane & 7;
#pragma unroll
    for (int j = 0; j < 4; ++j) { const int n = (lane >> 3) + 8 * j; const LAS float* s = scr + (8 * c) * 33 + n;
        u32x4 o; o.x = pk2(s[0 * 33], s[1 * 33]); o.y = pk2(s[2 * 33], s[3 * 33]); o.z = pk2(s[4 * 33], s[5 * 33]); o.w = pk2(s[6 * 33], s[7 * 33]);
        *(u32x4*)(WT + (size_t)(dst_row0 + n0 + n) * K + k0 + 8 * c) = o; }
    asm volatile("s_waitcnt lgkmcnt(0)" ::: "memory");
}
__device__ __forceinline__ void p0_prologue(KP p, LAS unsigned char* lds) {
    const int tid = tid_opaque(), lane = tid & 63, wave = __builtin_amdgcn_readfirstlane(tid >> 6);
    LAS float* scr = (LAS float*)(lds + wave * 16384);
    const int gw = bid_opaque() * 8 + wave, NGW = grid_opaque() * 8;
    constexpr int I_A = 16 * 48, I_B = 16 * 128, I_C = 16 * 96, I_BR = 8 * 32, I_O = 16 * 32, I_U = 16 * 176, I_D = 44 * 32;
    constexpr int PER_LAYER = I_A + I_B + I_C + 3 * I_BR + I_O + I_U + I_D;
    for (int it = gw; it < 2 * PER_LAYER; it += NGW) {
        KP pp = kparams();
        const int l = it / PER_LAYER; int r = it % PER_LAYER;
        bf16* WL = (bf16*)(pp->ws + WS_W) + (size_t)l * W_LAYER;
        const float* W; int K, ldw, src0 = 0, nblk, dst0 = 0; size_t wo;
        if (r < I_A) { W = pp->in[5] + (size_t)l * 1024 * NIN; K = 1024; ldw = NIN; src0 = 0; nblk = 48; wo = W_IN; dst0 = 0; }
        else if ((r -= I_A) < I_B) { W = pp->in[5] + (size_t)l * 1024 * NIN; K = 1024; ldw = NIN; src0 = 1544; nblk = 128; wo = W_IN; dst0 = 1536; }
        else if ((r -= I_B) < I_C) { W = pp->in[5] + (size_t)l * 1024 * NIN; K = 1024; ldw = NIN; src0 = 5648; nblk = 96; wo = W_IN; dst0 = 5632; }
        else if ((r -= I_C) < I_BR) { W = pp->in[18] + (size_t)l * 524288; K = 1536; ldw = 1024; nblk = 32; wo = W_BR; }
        else if ((r -= I_BR) < I_BR) { W = pp->in[19] + (size_t)l * 524288; K = 1536; ldw = 1024; nblk = 32; wo = W_BR + 512; }
        else if ((r -= I_BR) < I_BR) { W = pp->in[20] + (size_t)l * 524288; K = 1536; ldw = 1024; nblk = 32; wo = W_BR + 1024; }
        else if ((r -= I_BR) < I_O) { W = pp->in[21] + (size_t)l * 1048576; K = 1024; ldw = 1024; nblk = 32; wo = W_OUT; }
        else if ((r -= I_O) < I_U) { const int kb_ = r / 176, c_ = 32 * (r % 176);
            W = pp->in[23] + (size_t)l * 1024 * FF2; K = 1024; ldw = FF2; src0 = c_; nblk = 1; wo = W_UP; r = kb_;
            dst0 = c_ < FF ? 256 * (c_ >> 7) + (c_ & 127) : 256 * ((c_ - FF) >> 7) + 128 + ((c_ - FF) & 127); }
        else { r -= I_U; W = pp->in[26] + (size_t)l * FF * 1024; K = FF; ldw = 1024; nblk = 32; wo = W_DN; }
        tr_item(W, K, ldw, src0, nblk, WL + wo, dst0, scr, r, lane);
    }
    {
        const int gt = bid_opaque() * 512 + tid, NT = grid_opaque() * 512;
        for (int e = gt; e < 2 * 16 * 1024; e += NT) {
            const int l = e >> 14, r = (e >> 10) & 15, k = e & 1023;
            const int src = r < 8 ? 1536 + r : 5640 + (r - 8);
            bf16* WL = (bf16*)(p->ws + WS_W) + (size_t)l * W_LAYER;
            WL[W_IN + (size_t)(C_SMALL + r) * 1024 + k] = (bf16)pk1(p->in[5][(size_t)l * 1024 * NIN + (size_t)k * NIN + src]);
        }
    }
    __syncthreads();
    LAS float* cact = (LAS float*)lds;
    LAS float* part = (LAS float*)(lds + 65536);
    bool loaded = false;
    for (int it = bid_opaque(); it < 192; it += grid_opaque()) {
        if (!loaded) { for (int e = tid; e < 16384; e += 512) cact[e] = silu_f(p->in[1][e]); loaded = true; }
        __syncthreads();
        const int l = it / 96, n0 = (it % 96) * 64;
        const float* W = p->in[2] + (size_t)l * 1024 * 6144 + n0 + lane;
        float acc[16];
#pragma unroll
        for (int b = 0; b < 16; ++b) acc[b] = 0.f;
        for (int k16 = 0; k16 < 8; ++k16) {
            const int kb_ = wave * 128 + k16 * 16;
            float wr_[16];
#pragma unroll
            for (int i = 0; i < 16; ++i) wr_[i] = W[(size_t)(kb_ + i) * 6144];
#pragma unroll
            for (int q = 0; q < 4; ++q)
#pragma unroll
                for (int b = 0; b < 16; ++b) { const f32x4 cv = *(const LAS f32x4*)(cact + b * 1024 + kb_ + 4 * q); acc[b] += cv[0] * wr_[4 * q] + cv[1] * wr_[4 * q + 1] + cv[2] * wr_[4 * q + 2] + cv[3] * wr_[4 * q + 3]; }
        }
#pragma unroll
        for (int b = 0; b < 16; ++b) part[(wave * 16 + b) * 64 + lane] = acc[b];
        __syncthreads();
        for (int e = tid; e < 1024; e += 512) { const int b = e >> 6, j = e & 63; float s = 0.f;
#pragma unroll
            for (int w = 0; w < 8; ++w) s += part[(w * 16 + b) * 64 + j];
            ((float*)(p->ws + WS_MOD))[(size_t)(l * 16 + b) * 6144 + n0 + j] = s + p->in[3][(size_t)l * 6144 + n0 + j]; }
    }
}

__device__ __forceinline__ void norm_mod_phase(const float* src  , int row_base, const float* nw, const float* shift, const float* scale, bf16* dst, const bf16* wsmall  , float* smout  ) {
    const int tid_ = tid_opaque(), lane = tid_ & 63, wave = __builtin_amdgcn_readfirstlane(tid_ >> 6);
    const int gw = bid_opaque() * 8 + wave, NGW = grid_opaque() * 8;
    const int rpw = (MH + NGW - 1) / NGW, r0 = gw * rpw, r1 = r0 + rpw < MH ? r0 + rpw : MH;
    if (r0 >= r1) return;
    f32x4 wm[4], sh[4]; int bcur = -1;
    f32x4 v[4], vn[4];
    { const f32x4* xr = (const f32x4*)(src + (size_t)r0 * 1024) + lane;
#pragma unroll
      for (int j = 0; j < 4; ++j) vn[j] = xr[64 * j]; }
    for (int r = r0; r < r1; ++r) {
#pragma unroll
        for (int j = 0; j < 4; ++j) v[j] = vn[j];
        if (r + 1 < r1) { const f32x4* xr = (const f32x4*)(src + (size_t)(r + 1) * 1024) + lane;
#pragma unroll
            for (int j = 0; j < 4; ++j) vn[j] = xr[64 * j]; }
        const int b = (row_base + r) / SEQ;
        if (b != bcur) { bcur = b;
#pragma unroll
            for (int j = 0; j < 4; ++j) { const int c = 4 * lane + 256 * j;
                wm[j] = *(const f32x4*)(nw + c) * (*(const f32x4*)(scale + (size_t)b * 6144 + c) + 1.f); sh[j] = *(const f32x4*)(shift + (size_t)b * 6144 + c); } }
        float s = 0.f;
#pragma unroll
        for (int j = 0; j < 4; ++j) s += (v[j][0] * v[j][0] + v[j][1] * v[j][1]) + (v[j][2] * v[j][2] + v[j][3] * v[j][3]);
        const float rstd = rsqrtf(wave_sum(s) * (1.f / 1024.f) + EPS);
        u32x2* o8 = (u32x2*)(dst + (size_t)r * 1024) + lane;
#pragma unroll
        for (int j = 0; j < 4; ++j) { const f32x4 y = v[j] * rstd * wm[j] + sh[j]; u32x2 o; o.x = pk2(y[0], y[1]); o.y = pk2(y[2], y[3]); o8[64 * j] = o; }
    }
    if (wsmall != nullptr && rpw == 16) {
        asm volatile("s_waitcnt vmcnt(0)" ::: "memory");
        const int r16 = lane & 15, q4 = lane >> 4;
        const bf16* ap = dst + (size_t)(r0 + r16) * 1024 + q4 * 8; const bf16* bp = wsmall + (size_t)r16 * 1024 + q4 * 8;
        f32x4 acc = (f32x4){0.f, 0.f, 0.f, 0.f};
#pragma unroll 8
        for (int kk = 0; kk < 32; ++kk) {
            const bf16x8 a = *(const bf16x8*)(ap + kk * 32), bb = *(const bf16x8*)(bp + kk * 32);
            acc = __builtin_amdgcn_mfma_f32_16x16x32_bf16(a, bb, acc, 0, 0, 0);
        }
#pragma unroll
        for (int j = 0; j < 4; ++j) smout[(size_t)(r0 + 4 * q4 + j) * 16 + r16] = acc[j];
    }
}

#define LBAR() do { asm volatile("s_waitcnt lgkmcnt(0)" ::: "memory"); __builtin_amdgcn_s_barrier(); asm volatile("" ::: "memory"); } while (0)

constexpr int HG_QS = 0, HG_KS = 17408, HG_QG = 34816, HG_KET = 52224, HG_GEND = 68608, HG_VT = 70656, HG_SB = 89088, HG_END = 123904;
static_assert(HG_END <= LDS_BYTES, "HGRN LDS map");
__device__ __forceinline__ bf16x8 mk_frag(unsigned a, unsigned b, unsigned c, unsigned d) { u32x4 u; u.x = a; u.y = b; u.z = c; u.w = d; return __builtin_bit_cast(bf16x8, u); }
__device__ __forceinline__ void hgrn_unit(KP p, int idx, int layer, LAS unsigned char* L0) {
    LAS unsigned char* L = lds_opaque(L0);
    const int tid = tid_opaque(), lane = tid & 63, wave = __builtin_amdgcn_readfirstlane(tid >> 6);
    const int bl = idx >> 3, h = (idx >> 1) & 3, dvh = idx & 1; const bool act = wave < 4; const int dvt = dvh * 4 + (wave & 3);
    const bf16* P = (const bf16*)(p->ws + WS_PROJ) + (size_t)bl * SEQ * NP;
    bf16* OR = (bf16*)(p->ws + WS_ORAW) + (size_t)bl * SEQ * OC + 512 + h * 128 + dvt * 16;
    const int pk = tid & 127, psub = tid >> 7;
    float lb = 0.f;
    if (layer == 1) { const float* lp = p->in[10]; lb = sigmoid_f(lp[512 + h * 128 + pk] - lp[h * 128 + pk]); }
    const int r16 = lane & 15, q4 = lane >> 4;
    f32x4 S[8];
#pragma unroll
    for (int i = 0; i < 8; ++i) S[i] = (f32x4){0.f, 0.f, 0.f, 0.f};
    { LAS unsigned char* SB = L + HG_SB + wave * 4352; for (int i = lane; i < 1088; i += 64) ((LAS unsigned*)SB)[i] = 0u; }
    unsigned rq[16], rf[16], rv[16];
    unsigned pq[8], pks[8], pqg[8], ke[8]; float gendv = 0.f;
#define HG_LOAD(mcx) do { if ((mcx) < 64) { const bf16* src_ = P + (size_t)((mcx) * 64 + psub * 16) * NP + h * 128 + pk; \
        _Pragma("unroll") for (int i = 0; i < 16; ++i) { rq[i] = src_[(size_t)i * NP + C_HQ]; rf[i] = src_[(size_t)i * NP + C_HF]; } \
        if (act) { const bf16* srv_ = P + (size_t)((mcx) * 64 + q4 * 16) * NP + C_HI + h * 128 + dvt * 16 + r16; \
            _Pragma("unroll") for (int i = 0; i < 16; ++i) rv[i] = srv_[(size_t)i * NP]; } } } while (0)
#define HG_COMPUTE() do { float qv[16], kv[16], G[16]; float run = 0.f; \
        _Pragma("unroll") for (int i = 0; i < 16; ++i) { const float qr = bf2f(rq[i]), fr = bf2f(rf[i]); const float sg = sigmoid_f(fr), f = lb + (1.f - lb) * sg; \
            run += __logf(f); G[i] = run; kv[i] = (1.f - lb) * (1.f - sg); qv[i] = silu_f(qr); } \
        const float Gref = G[7], Gend = G[15]; const float eref = __expf(Gref), c2 = __expf(Gend - Gref); \
        _Pragma("unroll") for (int i = 0; i < 8; ++i) { \
            const float e1a = __expf(G[2 * i] - Gref), r1a = __builtin_amdgcn_rcpf(e1a), e1b = __expf(G[2 * i + 1] - Gref), r1b = __builtin_amdgcn_rcpf(e1b); \
            pq[i] = pk2(qv[2 * i] * e1a, qv[2 * i + 1] * e1b); pks[i] = pk2(kv[2 * i] * r1a, kv[2 * i + 1] * r1b); \
            pqg[i] = pk2(qv[2 * i] * e1a * eref, qv[2 * i + 1] * e1b * eref); ke[i] = pk2(kv[2 * i] * r1a * c2, kv[2 * i + 1] * r1b * c2); } \
        gendv = __expf(Gend); } while (0)
#define HG_WRITE() do { _Pragma("unroll") for (int i = 0; i < 8; ++i) { const int t_ = psub * 16 + 2 * i; \
            *(LAS bf16*)(L + HG_QS + t_ * 272 + pk * 2) = (bf16)(pq[i] & 0xffffu); *(LAS bf16*)(L + HG_QS + (t_ + 1) * 272 + pk * 2) = (bf16)(pq[i] >> 16); \
            *(LAS bf16*)(L + HG_KS + t_ * 272 + pk * 2) = (bf16)(pks[i] & 0xffffu); *(LAS bf16*)(L + HG_KS + (t_ + 1) * 272 + pk * 2) = (bf16)(pks[i] >> 16); \
            *(LAS bf16*)(L + HG_QG + t_ * 272 + pk * 2) = (bf16)(pqg[i] & 0xffffu); *(LAS bf16*)(L + HG_QG + (t_ + 1) * 272 + pk * 2) = (bf16)(pqg[i] >> 16); } \
        LAS u32x4* kd_ = (LAS u32x4*)(L + HG_KET + (psub * 128 + pk) * 32); kd_[0] = (u32x4){ke[0], ke[1], ke[2], ke[3]}; kd_[1] = (u32x4){ke[4], ke[5], ke[6], ke[7]}; \
        *(LAS float*)(L + HG_GEND + (psub * 128 + pk) * 4) = gendv; } while (0)
    HG_LOAD(0);
    if (!act) { HG_COMPUTE(); HG_LOAD(1); }
    for (int mc = 0; mc < 64; ++mc) {
        L = lds_opaque(L0);
        LAS unsigned char* VT = L + HG_VT + wave * 2304;
        LAS unsigned char* SB = L + HG_SB + wave * 4352;
        LBAR();
        if (act) {
            HG_COMPUTE(); HG_WRITE();
            {
                unsigned w[8];
#pragma unroll
                for (int i = 0; i < 8; ++i) w[i] = rv[2 * i] | (rv[2 * i + 1] << 16);
                LAS u32x4* vd = (LAS u32x4*)(VT + r16 * 144 + q4 * 32);
                vd[0] = (u32x4){w[0], w[1], w[2], w[3]}; vd[1] = (u32x4){w[4], w[5], w[6], w[7]};
            }
            HG_LOAD(mc + 1);
        } else {
            HG_WRITE();
        }
        LBAR();
        if (!act) { if (mc + 1 < 64) { HG_COMPUTE(); HG_LOAD(mc + 2); } }
        else
#pragma unroll 1
        for (int sb = 0; sb < 4; ++sb) {
            const int t0 = sb * 16;
            f32x4 sc = (f32x4){0.f, 0.f, 0.f, 0.f};
#pragma unroll
            for (int kk = 0; kk < 4; ++kk) {
                const bf16x8 a = *(const LAS bf16x8*)(L + HG_KS + (t0 + r16) * 272 + kk * 64 + q4 * 16);
                const bf16x8 b = *(const LAS bf16x8*)(L + HG_QS + (t0 + r16) * 272 + kk * 64 + q4 * 16);
                sc = __builtin_amdgcn_mfma_f32_16x16x32_bf16(a, b, sc, 0, 0, 0);
            }
#pragma unroll
            for (int j = 0; j < 4; ++j) if (4 * q4 + j > r16) sc[j] = 0.f;
            const bf16x8 a2 = mk_frag(pk2(sc[0], sc[1]), pk2(sc[2], sc[3]), 0u, 0u);
            const u32x2 vv = *(const LAS u32x2*)(VT + r16 * 144 + (t0 + 4 * q4) * 2);
            const bf16x8 b2 = mk_frag(vv.x, vv.y, 0u, 0u);
            f32x4 o = __builtin_amdgcn_mfma_f32_16x16x32_bf16(a2, b2, (f32x4){0.f, 0.f, 0.f, 0.f}, 0, 0, 0);
#pragma unroll
            for (int kk = 0; kk < 4; ++kk) {
                const bf16x8 a = *(const LAS bf16x8*)(L + HG_QG + (t0 + r16) * 272 + kk * 64 + q4 * 16);
                const bf16x8 b = *(const LAS bf16x8*)(SB + r16 * 272 + kk * 64 + q4 * 16);
                o = __builtin_amdgcn_mfma_f32_16x16x32_bf16(a, b, o, 0, 0, 0);
            }
            bf16* orow = OR + (size_t)(mc * 64 + t0 + 4 * q4) * OC + r16;
#pragma unroll
            for (int j = 0; j < 4; ++j) orow[(size_t)j * OC] = (bf16)pk1(o[j]);
#pragma unroll
            for (int kt = 0; kt < 8; ++kt) {
                const u32x2 ke = *(const LAS u32x2*)(L + HG_KET + (sb * 128 + kt * 16 + r16) * 32 + q4 * 8);
                const f32x4 ge = *(const LAS f32x4*)(L + HG_GEND + (sb * 128 + kt * 16 + 4 * q4) * 4);
                S[kt] = __builtin_amdgcn_mfma_f32_16x16x32_bf16(mk_frag(ke.x, ke.y, 0u, 0u), b2, S[kt] * ge, 0, 0, 0);
                *(LAS u32x2*)(SB + r16 * 272 + (kt * 16 + 4 * q4) * 2) = (u32x2){pk2(S[kt][0], S[kt][1]), pk2(S[kt][2], S[kt][3])};
            }
        }
    }
    LBAR();
}


#undef HG_LOAD
#undef HG_COMPUTE
#undef HG_WRITE
constexpr int SD_CS = 0, SD_BS = 17408, SD_BT = 34816, SD_CBS = 53248  , SD_SC = SD_CBS + 2 * 9216, SD_PRIV = SD_SC + 1024, SD_PRIV_SZ = 8960, SD_END = SD_PRIV + 8 * SD_PRIV_SZ;
static_assert(SD_END <= LDS_BYTES, "SSD LDS map");
__device__ __forceinline__ void ssd_unit(KP p, int idx, int layer, LAS unsigned char* L0) {
    LAS unsigned char* L = lds_opaque(L0);
    const int tid = tid_opaque(), lane = tid & 63, wave = __builtin_amdgcn_readfirstlane(tid >> 6);
    const int r16 = lane & 15, q4 = lane >> 4;
    const int bl = idx >> 3, head = idx & 7, g = head >> 2;
    const int hh = 0, pt = wave & 3; const bool act = wave < 4;
    const bf16* P = (const bf16*)(p->ws + WS_PROJ) + (size_t)bl * SEQ * NP;
    const float* SM = (const float*)(p->ws + WS_SM) + (size_t)bl * SEQ * 16;
    bf16* OR = (bf16*)(p->ws + WS_ORAW) + (size_t)bl * SEQ * OC + 1024 + head * 64 + pt * 16;
    const int pc = tid & 255, phalf = tid >> 8, pn = pc & 127; const bool isB = pc >= 128;
    const int xi = (isB ? 512 : 768) + g * 128 + pn;
    const float* cwp = p->in[12] + (size_t)layer * 4096; const float* cbp = p->in[13] + (size_t)layer * 1024;
    const float cw0 = cwp[xi], cw1 = cwp[1024 + xi], cw2 = cwp[2048 + xi], cw3 = cwp[3072 + xi], cb = cbp[xi];
    const int xp = head * 64 + pt * 16 + r16;
    const float xw0 = cwp[xp], xw1 = cwp[1024 + xp], xw2 = cwp[2048 + xp], xw3 = cwp[3072 + xp], xb_ = cbp[xp];
    const float A_h = -__expf(p->in[14][layer * 8 + head]), dtb = p->in[15][layer * 8 + head], Dh = p->in[16][layer * 8 + head];
    f32x4 H[8];
#pragma unroll
    for (int i = 0; i < 8; ++i) H[i] = (f32x4){0.f, 0.f, 0.f, 0.f};
    { LAS unsigned char* HB = L + SD_PRIV + wave * SD_PRIV_SZ + 4608; for (int i = lane; i < 1088; i += 64) ((LAS unsigned*)HB)[i] = 0u; }
    unsigned rs[35], rx[19];
    {
        const bf16* src = P + (size_t)(phalf * 32) * NP + C_XBC + xi;
#pragma unroll
        for (int i = 0; i < 35; ++i) rs[i] = (phalf * 32 - 3 + i >= 0) ? (unsigned)src[(long)(i - 3) * NP] : 0u;
        const bf16* srx = P + (size_t)(q4 * 16) * NP + C_XBC + xp;
#pragma unroll
        for (int i = 0; i < 19; ++i) rx[i] = (act && q4 * 16 - 3 + i >= 0) ? (unsigned)srx[(long)(i - 3) * NP] : 0u;
    }
    for (int c = 0; c < 64; ++c) {
        L = lds_opaque(L0);
        LAS unsigned char* XT = L + SD_PRIV + wave * SD_PRIV_SZ; LAS unsigned char* XDT = XT + 2304; LAS unsigned char* HB = XT + 4608;
        LAS float* ACS = (LAS float*)(L + SD_SC) + hh * 64; LAS float* DT = (LAS float*)(L + SD_SC) + 128 + hh * 64;
        LBAR();
        {
            float x[35];
#pragma unroll
            for (int i = 0; i < 35; ++i) x[i] = bf2f(rs[i]);
            unsigned pkd[16]; unsigned lo = 0;
            LAS unsigned char* dst = L + (isB ? SD_BS : SD_CS) + (phalf * 32) * 272 + pn * 2;
#pragma unroll
            for (int j = 0; j < 32; ++j) {
                const unsigned b = f2bf(silu_f(cw0 * x[j] + cw1 * x[j + 1] + cw2 * x[j + 2] + cw3 * x[j + 3] + cb));
                *(LAS bf16*)(dst + j * 272) = (bf16)b;
                if (j & 1) pkd[j >> 1] = lo | (b << 16); else lo = b;
            }
            if (isB) { LAS u32x4* bt = (LAS u32x4*)(L + SD_BT + pn * 144 + phalf * 64);
#pragma unroll
                for (int i = 0; i < 4; ++i) bt[i] = (u32x4){pkd[4 * i], pkd[4 * i + 1], pkd[4 * i + 2], pkd[4 * i + 3]}; }
        }
        if (wave == 0) {
            const float dtv = softplus_f(SM[(size_t)(c * 64 + lane) * 16 + 8 + head] + dtb);
            const float v = wave_scan_incl(dtv * A_h, lane);
            ACS[lane] = v; DT[lane] = dtv;
        }
        float xv[16];
        if (act) {
            float x[19];
#pragma unroll
            for (int i = 0; i < 19; ++i) x[i] = bf2f(rx[i]);
#pragma unroll
            for (int j = 0; j < 16; ++j) xv[j] = silu_f(xw0 * x[j] + xw1 * x[j + 1] + xw2 * x[j + 2] + xw3 * x[j + 3] + xb_);
        }
        if (c + 1 < 64) {
            const bf16* src = P + (size_t)((c + 1) * 64 + phalf * 32) * NP + C_XBC + xi;
#pragma unroll
            for (int i = 0; i < 35; ++i) rs[i] = src[(long)(i - 3) * NP];
            if (act) { const bf16* srx = P + (size_t)((c + 1) * 64 + q4 * 16) * NP + C_XBC + xp;
#pragma unroll
                for (int i = 0; i < 19; ++i) rx[i] = srx[(long)(i - 3) * NP]; }
        }
        LBAR();
        if (act) {
            unsigned a[8], b[8];
#pragma unroll
            for (int i = 0; i < 4; ++i) { const f32x4 d = *(const LAS f32x4*)(DT + q4 * 16 + 4 * i);
                a[2 * i] = pk2(xv[4 * i], xv[4 * i + 1]); a[2 * i + 1] = pk2(xv[4 * i + 2], xv[4 * i + 3]);
                b[2 * i] = pk2(xv[4 * i] * d[0], xv[4 * i + 1] * d[1]); b[2 * i + 1] = pk2(xv[4 * i + 2] * d[2], xv[4 * i + 3] * d[3]); }
            LAS u32x4* xd = (LAS u32x4*)(XT + r16 * 144 + q4 * 32); xd[0] = (u32x4){a[0], a[1], a[2], a[3]}; xd[1] = (u32x4){a[4], a[5], a[6], a[7]};
            LAS u32x4* yd = (LAS u32x4*)(XDT + r16 * 144 + q4 * 32); yd[0] = (u32x4){b[0], b[1], b[2], b[3]}; yd[1] = (u32x4){b[4], b[5], b[6], b[7]};
        }
        {
            const int tl = wave & 3;
            const LAS float* AC0 = (const LAS float*)(L + SD_SC);
            const f32x4 al0 = *(const LAS f32x4*)(AC0 + 16 * tl + 4 * q4);
#pragma unroll
            for (int u = 0; u < 2; ++u) { const int ts = 2 * (wave >> 2) + u;
                f32x4 acc = (f32x4){0.f, 0.f, 0.f, 0.f};
#pragma unroll
                for (int kk = 0; kk < 4; ++kk) {
                    const bf16x8 a = *(const LAS bf16x8*)(L + SD_CS + (16 * tl + r16) * 272 + kk * 64 + q4 * 16);
                    const bf16x8 b = *(const LAS bf16x8*)(L + SD_BS + (16 * ts + r16) * 272 + kk * 64 + q4 * 16);
                    acc = __builtin_amdgcn_mfma_f32_16x16x32_bf16(a, b, acc, 0, 0, 0);
                }
                const int sidx = 16 * ts + r16; const float as0 = AC0[sidx];
#pragma unroll
                for (int j = 0; j < 4; ++j) { const int l = 16 * tl + 4 * q4 + j;
                    *(LAS bf16*)(L + SD_CBS + l * 144 + sidx * 2) = (bf16)pk1(sidx <= l ? acc[j] * __expf(fminf(al0[j] - as0, 0.f)) : 0.f); }
            }
        }
        LBAR();
        if (act) {
        const float acs_last = ACS[63];
        const bf16x8 xb0 = *(const LAS bf16x8*)(XDT + r16 * 144 + q4 * 16), xb1 = *(const LAS bf16x8*)(XDT + r16 * 144 + 64 + q4 * 16);
#pragma unroll 1
        for (int tl = 0; tl < 4; ++tl) {
            f32x4 acc = (f32x4){0.f, 0.f, 0.f, 0.f};
#pragma unroll
            for (int kk = 0; kk < 4; ++kk) {
                const bf16x8 a = *(const LAS bf16x8*)(L + SD_CS + (16 * tl + r16) * 272 + kk * 64 + q4 * 16);
                const bf16x8 b = *(const LAS bf16x8*)(HB + r16 * 272 + kk * 64 + q4 * 16);
                acc = __builtin_amdgcn_mfma_f32_16x16x32_bf16(a, b, acc, 0, 0, 0);
            }
            const f32x4 al = *(const LAS f32x4*)(ACS + 16 * tl + 4 * q4);
#pragma unroll
            for (int j = 0; j < 4; ++j) acc[j] *= __expf(al[j]);
            acc = __builtin_amdgcn_mfma_f32_16x16x32_bf16(*(const LAS bf16x8*)(L + SD_CBS + hh * 9216 + (16 * tl + r16) * 144 + q4 * 16), xb0, acc, 0, 0, 0);
            if (tl >= 2) acc = __builtin_amdgcn_mfma_f32_16x16x32_bf16(*(const LAS bf16x8*)(L + SD_CBS + hh * 9216 + (16 * tl + r16) * 144 + 64 + q4 * 16), xb1, acc, 0, 0, 0);
            const u32x2 xs = *(const LAS u32x2*)(XT + r16 * 144 + (16 * tl + 4 * q4) * 2);
            acc[0] += Dh * bflo(xs.x); acc[1] += Dh * bfhi(xs.x); acc[2] += Dh * bflo(xs.y); acc[3] += Dh * bfhi(xs.y);
            bf16* orow = OR + (size_t)(c * 64 + 16 * tl + 4 * q4) * OC + r16;
#pragma unroll
            for (int j = 0; j < 4; ++j) orow[(size_t)j * OC] = (bf16)pk1(acc[j]);
        }
        {
            bf16x8 xe[2];
#pragma unroll
            for (int kk = 0; kk < 2; ++kk) {
                const u32x4 xw = __builtin_bit_cast(u32x4, kk == 0 ? xb0 : xb1);
                const f32x4 s0 = *(const LAS f32x4*)(ACS + kk * 32 + 8 * q4), s1 = *(const LAS f32x4*)(ACS + kk * 32 + 8 * q4 + 4);
                float v[8];
                v[0] = bflo(xw.x); v[1] = bfhi(xw.x); v[2] = bflo(xw.y); v[3] = bfhi(xw.y); v[4] = bflo(xw.z); v[5] = bfhi(xw.z); v[6] = bflo(xw.w); v[7] = bfhi(xw.w);
#pragma unroll
                for (int e = 0; e < 8; ++e) { const float as = e < 4 ? s0[e & 3] : s1[e & 3]; v[e] *= __expf(acs_last - as); }
                xe[kk] = mk_frag(pk2(v[0], v[1]), pk2(v[2], v[3]), pk2(v[4], v[5]), pk2(v[6], v[7]));
            }
            const float eh = __expf(acs_last);
#pragma unroll
            for (int nt = 0; nt < 8; ++nt) {
                H[nt] = H[nt] * eh;
#pragma unroll
                for (int kk = 0; kk < 2; ++kk) {
                    const bf16x8 a = *(const LAS bf16x8*)(L + SD_BT + (16 * nt + r16) * 144 + kk * 64 + q4 * 16);
                    H[nt] = __builtin_amdgcn_mfma_f32_16x16x32_bf16(a, xe[kk], H[nt], 0, 0, 0);
                }
                *(LAS u32x2*)(HB + r16 * 272 + (16 * nt + 4 * q4) * 2) = (u32x2){pk2(H[nt][0], H[nt][1]), pk2(H[nt][2], H[nt][3])};
            }
        }
        }
    }
    LBAR();
}


constexpr int GD_QN = 0, GD_KN = 17408, GD_VN = 34816, GD_MT = 52224, GD_KET = 68608, GD_SC = 87040, GD_PRIV = 88064, GD_PRIV_SZ = 6656, GD_WL = GD_PRIV + 8 * GD_PRIV_SZ, GD_END = GD_WL + 6144;
static_assert(GD_END <= LDS_BYTES, "GDN LDS map");
typedef float f32x2 __attribute__((ext_vector_type(2)));
__device__ __forceinline__ float red8(float v) { v += dppf<0xB1>(v); v += dppf<0x4E>(v); v += dppf<0x141>(v); return v; }
__device__ __forceinline__ float bfel(const u32x4& a, const u32x4& b, int c) { const u32x4& v = (c < 8) ? a : b; const unsigned w = v[(c & 7) >> 1]; return (c & 1) ? bfhi(w) : bflo(w); }
constexpr size_t AUXA_UNIT = 32768, AUXB_UNIT = 40960;
constexpr size_t WS_GE = 920 * 1024;
constexpr int GCNT_WORD = 3648;
constexpr int GCNT_UNUSED = 3584;
__device__ __forceinline__ void gdn1_load_rows(KP p, int u, u32x4 (&xr)[3][4][2]) {
    const int tid0 = tid_opaque(); const int bl = u >> 8, h = (u >> 6) & 3, c = u & 63, t = tid0 >> 3;
    const bf16* Pu = (const bf16*)(p->ws + WS_PROJ) + (size_t)bl * SEQ * NP + h * 128 + (tid0 & 7) * 16;
#pragma unroll
    for (int mat = 0; mat < 3; ++mat)
#pragma unroll
        for (int i = 0; i < 4; ++i) {
            if (c * 64 + t - 3 + i >= 0) { const bf16* src = Pu + (long)(c * 64 + t - 3 + i) * NP + mat * 512; xr[mat][i][0] = *(const u32x4*)src; xr[mat][i][1] = *(const u32x4*)(src + 8); }
            else { xr[mat][i][0] = (u32x4){0u, 0u, 0u, 0u}; xr[mat][i][1] = (u32x4){0u, 0u, 0u, 0u}; }
        }
}
__device__ __forceinline__ void gdn1_unit(KP p, int u, int layer, LAS unsigned char* L0, u32x4 (&xr)[3][4][2], bool load_w, int u_next) {
    LAS unsigned char* L = lds_opaque(L0);
    const int tid0 = tid_opaque(), wave = __builtin_amdgcn_readfirstlane(tid0 >> 6);
    const int bl = u >> 8, h = (u >> 6) & 3, c = u & 63;
    const float sA = __builtin_bit_cast(float, __builtin_amdgcn_readfirstlane(__builtin_bit_cast(int, -__expf(p->in[7][layer * 4 + h])))), sB = __builtin_bit_cast(float, __builtin_amdgcn_readfirstlane(__builtin_bit_cast(int, p->in[8][layer * 4 + h])));
    LBAR();
    if (load_w) {
        const float* cwp = p->in[6] + (size_t)layer * 4 * 1536;
        for (int e = tid0; e < 1536; e += 512) { const int mat = e >> 9, k = (e >> 7) & 3, col = e & 127; *(LAS float*)(L + GD_WL + e * 4) = cwp[k * 1536 + mat * 512 + h * 128 + col]; }
        LBAR();
    }
    {
        LAS float* GC = (LAS float*)(L + GD_SC); LAS float* BETA = GC + 64;
        {
            const int tid = tid_opaque();
            const int t = tid >> 3, seg = tid & 7;
#pragma unroll
            for (int mat = 0; mat < 3; ++mat) {
                float y[16]; float ss = 0.f;
#pragma unroll
                for (int cg = 0; cg < 4; ++cg) {
                    const LAS float* wl = (const LAS float*)(L + GD_WL) + mat * 512 + seg * 16 + 4 * cg;
                    const f32x4 w0 = *(const LAS f32x4*)(wl), w1 = *(const LAS f32x4*)(wl + 128), w2 = *(const LAS f32x4*)(wl + 256), w3 = *(const LAS f32x4*)(wl + 384);
#pragma unroll
                    for (int e = 0; e < 4; ++e) { const int ci = 4 * cg + e;
                        const float v = silu_f(w0[e] * bfel(xr[mat][0][0], xr[mat][0][1], ci) + w1[e] * bfel(xr[mat][1][0], xr[mat][1][1], ci) + w2[e] * bfel(xr[mat][2][0], xr[mat][2][1], ci) + w3[e] * bfel(xr[mat][3][0], xr[mat][3][1], ci));
                        y[ci] = v; ss += v * v; }
                }
                float r = 1.f;
                if (mat < 2) { ss = red8(ss); r = rsqrtf(ss + EPS) * (mat == 0 ? 0.08838834764831845f : 1.f); }
                LAS u32x4* d = (LAS u32x4*)(L + (mat == 0 ? GD_QN : mat == 1 ? GD_KN : GD_VN) + t * 272 + seg * 32);
                d[0] = (u32x4){pk2(y[0] * r, y[1] * r), pk2(y[2] * r, y[3] * r), pk2(y[4] * r, y[5] * r), pk2(y[6] * r, y[7] * r)};
                d[1] = (u32x4){pk2(y[8] * r, y[9] * r), pk2(y[10] * r, y[11] * r), pk2(y[12] * r, y[13] * r), pk2(y[14] * r, y[15] * r)};
            }
        }
        if (wave == 0) {
            const int tid = tid_opaque(), lane = tid & 63, r16 = lane & 15, q4 = lane >> 4; (void)r16; (void)q4; (void)lane;
            KP pp = kparams(); const float* sm = (const float*)(pp->ws + WS_SM) + ((size_t)bl * SEQ + c * 64 + lane) * 16;
            const float v = wave_scan_incl(sA * softplus_f(sm[h] + sB), lane);
            GC[lane] = v; BETA[lane] = sigmoid_f(sm[4 + h]);
        }
        LBAR();
        f32x4 at[2];
        {
            const int tid = tid_opaque(), lane = tid & 63, r16 = lane & 15, q4 = lane >> 4; (void)r16; (void)q4; (void)lane;
            const int tl = wave & 3;
            const f32x4 gl = *(const LAS f32x4*)(GC + 16 * tl + 4 * q4), bl4 = *(const LAS f32x4*)(BETA + 16 * tl + 4 * q4);
#pragma unroll
            for (int u = 0; u < 2; ++u) { const int ts = 2 * (wave >> 2) + u;
                f32x4 kk = (f32x4){0.f, 0.f, 0.f, 0.f}, qk = (f32x4){0.f, 0.f, 0.f, 0.f};
#pragma unroll
                for (int k4 = 0; k4 < 4; ++k4) {
                    const bf16x8 b = *(const LAS bf16x8*)(L + GD_KN + (16 * ts + r16) * 272 + k4 * 64 + q4 * 16);
                    const bf16x8 ak = *(const LAS bf16x8*)(L + GD_KN + (16 * tl + r16) * 272 + k4 * 64 + q4 * 16);
                    const bf16x8 aq = *(const LAS bf16x8*)(L + GD_QN + (16 * tl + r16) * 272 + k4 * 64 + q4 * 16);
                    kk = __builtin_amdgcn_mfma_f32_16x16x32_bf16(ak, b, kk, 0, 0, 0);
                    qk = __builtin_amdgcn_mfma_f32_16x16x32_bf16(aq, b, qk, 0, 0, 0);
                }
                const int sidx = 16 * ts + r16; const float gs = GC[sidx];
                f32x4 m;
#pragma unroll
                for (int j = 0; j < 4; ++j) { const int l = 16 * tl + 4 * q4 + j; const float dec = __expf(fminf(gl[j] - gs, 0.f));
                    m[j] = (sidx < l) ? bl4[j] * kk[j] * dec : 0.f; qk[j] = (sidx <= l) ? qk[j] * dec : 0.f; }
                *(LAS f32x4*)(L + GD_MT + sidx * 256 + (16 * tl + 4 * q4) * 4) = m;
                at[u] = qk;
            }
        }
        LBAR();
        f32x2 acc2[32];
        if (wave < 4) {
            const int tid = tid_opaque(), lane = tid & 63, r16 = lane & 15, q4 = lane >> 4; (void)r16; (void)q4; (void)lane;
            const LAS unsigned char* rb = L + (tid < 128 ? GD_VN : GD_KN) + (tid & 127) * 2;
#pragma unroll
            for (int l4 = 0; l4 < 16; ++l4) {
                const f32x4 b4 = *(const LAS f32x4*)(BETA + 4 * l4); f32x4 g4 = (f32x4){1.f, 1.f, 1.f, 1.f};
                if (tid >= 128) { const f32x4 gg = *(const LAS f32x4*)(GC + 4 * l4); g4 = (f32x4){__expf(gg[0]), __expf(gg[1]), __expf(gg[2]), __expf(gg[3])}; }
                acc2[2 * l4] = (f32x2){bf2f(*(const LAS bf16*)(rb + (4 * l4) * 272)) * b4[0] * g4[0], bf2f(*(const LAS bf16*)(rb + (4 * l4 + 1) * 272)) * b4[1] * g4[1]};
                acc2[2 * l4 + 1] = (f32x2){bf2f(*(const LAS bf16*)(rb + (4 * l4 + 2) * 272)) * b4[2] * g4[2], bf2f(*(const LAS bf16*)(rb + (4 * l4 + 3) * 272)) * b4[3] * g4[3]};
            }
#pragma unroll
            for (int s_ = 0; s_ < 63; ++s_) {
                const float xs = (s_ & 1) ? acc2[s_ >> 1][1] : acc2[s_ >> 1][0]; const f32x2 xs2 = (f32x2){xs, xs};
#pragma unroll
                for (int l4 = ((s_ + 1) >> 2) << 2; l4 < 64; l4 += 4) {
                    const f32x4 m = *(const LAS f32x4*)(L + GD_MT + s_ * 256 + l4 * 4);
                    acc2[l4 >> 1] -= (f32x2){m[0], m[1]} * xs2;
                    acc2[(l4 >> 1) + 1] -= (f32x2){m[2], m[3]} * xs2;
                }
            }
        } else {
            const int tid = tid_opaque(), lane = tid & 63, r16 = lane & 15, q4 = lane >> 4; (void)r16; (void)q4; (void)lane;
            const int tt = tid - 256, t = tt >> 2, sg = tt & 3;
            const float gt = GC[t]; const float eg = __expf(gt), ee = __expf(GC[63] - gt);
            LAS u32x4* qp = (LAS u32x4*)(L + GD_QN + t * 272 + sg * 64);
            const LAS u32x4* kp = (const LAS u32x4*)(L + GD_KN + t * 272 + sg * 64);
#pragma unroll
            for (int i = 0; i < 4; ++i) {
                const u32x4 w = qp[i];
                qp[i] = (u32x4){pk2(bflo(w.x) * eg, bfhi(w.x) * eg), pk2(bflo(w.y) * eg, bfhi(w.y) * eg), pk2(bflo(w.z) * eg, bfhi(w.z) * eg), pk2(bflo(w.w) * eg, bfhi(w.w) * eg)};
                const u32x4 kw = kp[i];
                LAS unsigned char* kd = L + GD_KET + (sg * 32 + i * 8) * 144 + t * 2;
                *(LAS bf16*)(kd + 0 * 144) = (bf16)pk1(bflo(kw.x) * ee); *(LAS bf16*)(kd + 1 * 144) = (bf16)pk1(bfhi(kw.x) * ee);
                *(LAS bf16*)(kd + 2 * 144) = (bf16)pk1(bflo(kw.y) * ee); *(LAS bf16*)(kd + 3 * 144) = (bf16)pk1(bfhi(kw.y) * ee);
                *(LAS bf16*)(kd + 4 * 144) = (bf16)pk1(bflo(kw.z) * ee); *(LAS bf16*)(kd + 5 * 144) = (bf16)pk1(bfhi(kw.z) * ee);
                *(LAS bf16*)(kd + 6 * 144) = (bf16)pk1(bflo(kw.w) * ee); *(LAS bf16*)(kd + 7 * 144) = (bf16)pk1(bfhi(kw.w) * ee);
            }
        }
        LBAR();
        if (wave < 2) {
            const int tid = tid_opaque(), lane = tid & 63, r16 = lane & 15, q4 = lane >> 4; (void)r16; (void)q4; (void)lane;
            LAS u32x2* ud = (LAS u32x2*)(L + GD_KN + tid * 136);
#pragma unroll
            for (int i = 0; i < 16; ++i) ud[i] = (u32x2){pk2(acc2[2 * i][0], acc2[2 * i][1]), pk2(acc2[2 * i + 1][0], acc2[2 * i + 1][1])};
        } else if (wave < 4) {
            const int tid = tid_opaque(), lane = tid & 63, r16 = lane & 15, q4 = lane >> 4; (void)r16; (void)q4; (void)lane;
            LAS unsigned char* wd = L + GD_VN + (tid - 128) * 2;
#pragma unroll
            for (int i = 0; i < 32; ++i) { *(LAS bf16*)(wd + (2 * i) * 272) = (bf16)pk1(acc2[i][0]); *(LAS bf16*)(wd + (2 * i + 1) * 272) = (bf16)pk1(acc2[i][1]); }
        }
        {
            const int tid = tid_opaque(), lane = tid & 63, r16 = lane & 15, q4 = lane >> 4; (void)r16; (void)q4; (void)lane;
            const int tl = wave & 3;
#pragma unroll
            for (int u = 0; u < 2; ++u) { const int ts = 2 * (wave >> 2) + u;
#pragma unroll
                for (int j = 0; j < 4; ++j) *(LAS bf16*)(L + GD_MT + (16 * tl + 4 * q4 + j) * 144 + (16 * ts + r16) * 2) = (bf16)pk1(at[u][j]); }
        }
        LBAR();
        {
            const int tid = tid_opaque();
            KP pp = kparams();
            const __amdgpu_buffer_rsrc_t ra_ = __builtin_amdgcn_make_buffer_rsrc((void*)(pp->ws + WS_H + (size_t)u * AUXA_UNIT), (short)0, (int)AUXA_UNIT, 0x00020000);
            const __amdgpu_buffer_rsrc_t rb_ = __builtin_amdgcn_make_buffer_rsrc((void*)(pp->ws + WS_OCAT + (size_t)u * AUXB_UNIT), (short)0, (int)AUXB_UNIT, 0x00020000);
#pragma unroll
            for (int k = 0; k < 2; ++k) { const int i = tid + 512 * k;
                __builtin_amdgcn_raw_buffer_store_b128(*(const LAS u32x4*)(L + GD_VN + (i >> 4) * 272 + (i & 15) * 16), ra_, i * 16, 0, 16);
                __builtin_amdgcn_raw_buffer_store_b128(*(const LAS u32x4*)(L + GD_QN + (i >> 4) * 272 + (i & 15) * 16), rb_, i * 16, 0, 16);
                __builtin_amdgcn_raw_buffer_store_b128(*(const LAS u32x4*)(L + GD_KET + (i >> 3) * 144 + (i & 7) * 16), rb_, 16384 + i * 16, 0, 16); }
#pragma unroll
            for (int k = 0; k < 4; ++k) { const int i = tid + 512 * k; __builtin_amdgcn_raw_buffer_store_b64(*(const LAS u32x2*)(L + GD_KN + (i >> 4) * 136 + (i & 15) * 8), ra_, 16384 + i * 8, 0, 16); }
            __builtin_amdgcn_raw_buffer_store_b128(*(const LAS u32x4*)(L + GD_MT + (tid >> 3) * 144 + (tid & 7) * 16), rb_, 32768 + tid * 16, 0, 16);
            if (tid == 0) __hip_atomic_store((float*)(pp->ws + WS_GE) + u, __expf(GC[63]), __ATOMIC_RELAXED, __HIP_MEMORY_SCOPE_AGENT);
            asm volatile("s_waitcnt vmcnt(0)" ::: "memory");
            __syncthreads();
            if (tid == 0) (void)__hip_atomic_fetch_add((unsigned*)(pp->ws + WS_BAR) + GCNT_WORD + c, 1u, __ATOMIC_RELAXED, __HIP_MEMORY_SCOPE_AGENT);
        }
    }
    gdn1_load_rows(kparams(), u_next, xr);
}
#define GDN2_ENSURE(cn) do { if ((cn) >= ready_upto) { const int hi_ = ready_upto + 8 < 64 ? ready_upto + 8 : 64; \
        if (tid_opaque() == 0) { unsigned* cnt_ = (unsigned*)(kparams()->ws + WS_BAR) + GCNT_WORD; unsigned sp_ = 0; \
            for (int cc_ = ready_upto; cc_ < hi_; ++cc_) while (__hip_atomic_load(cnt_ + cc_, __ATOMIC_RELAXED, __HIP_MEMORY_SCOPE_AGENT) < want) { __builtin_amdgcn_s_sleep(2); if (++sp_ > (1u << 24)) break; } \
            __builtin_amdgcn_fence(__ATOMIC_ACQUIRE, "agent"); asm volatile("s_waitcnt vmcnt(0)" ::: "memory"); } \
        __syncthreads(); ready_upto = hi_; } } while (0)
__device__ __forceinline__ void gdn2_unit(KP p, int idx, int layer, int pass, LAS unsigned char* L0) {
    const unsigned want = 32u * (unsigned)(pass + 1); int ready_upto = 0;
    LAS unsigned char* L = lds_opaque(L0);
    const int tid0 = tid_opaque(), wave = __builtin_amdgcn_readfirstlane(tid0 >> 6);
    const int bl = idx >> 2, h = idx & 3;
    { LAS unsigned char* SB = L + GD_PRIV + wave * GD_PRIV_SZ + 2304; for (int i = tid0 & 63; i < 1088; i += 64) ((LAS unsigned*)SB)[i] = 0u; }
    f32x4 S[8];
#pragma unroll
    for (int i = 0; i < 8; ++i) S[i] = (f32x4){0.f, 0.f, 0.f, 0.f};
    const size_t u0 = (size_t)(bl * 4 + h) * 64;
    u32x4 rw[2], rq[2], rk[2], ra; u32x2 ru[4]; float rge;
    GDN2_ENSURE(0);
    {
        const unsigned char* A = p->ws + WS_H + u0 * AUXA_UNIT; const unsigned char* B = p->ws + WS_OCAT + u0 * AUXB_UNIT;
#pragma unroll
        for (int k = 0; k < 2; ++k) { const int i = tid0 + 512 * k; rw[k] = ((const u32x4*)A)[i]; rq[k] = ((const u32x4*)B)[i]; rk[k] = ((const u32x4*)(B + 16384))[i]; }
#pragma unroll
        for (int k = 0; k < 4; ++k) ru[k] = ((const u32x2*)(A + 16384))[tid0 + 512 * k];
        ra = ((const u32x4*)(B + 32768))[tid0]; rge = ((const float*)(p->ws + WS_GE))[u0];
    }
    for (int c = 0; c < 64; ++c) {
        L = lds_opaque(L0);
        LAS unsigned char* VNT = L + GD_PRIV + wave * GD_PRIV_SZ; LAS unsigned char* SB = VNT + 2304;
        LBAR();
        const float ge = rge;
        {
            const int tid = tid_opaque();
#pragma unroll
            for (int k = 0; k < 2; ++k) { const int i = tid + 512 * k;
                *(LAS u32x4*)(L + GD_VN + (i >> 4) * 272 + (i & 15) * 16) = rw[k];
                *(LAS u32x4*)(L + GD_QN + (i >> 4) * 272 + (i & 15) * 16) = rq[k];
                *(LAS u32x4*)(L + GD_KET + (i >> 3) * 144 + (i & 7) * 16) = rk[k]; }
#pragma unroll
            for (int k = 0; k < 4; ++k) { const int i = tid + 512 * k; *(LAS u32x2*)(L + GD_KN + (i >> 4) * 136 + (i & 15) * 8) = ru[k]; }
            *(LAS u32x4*)(L + GD_MT + (tid >> 3) * 144 + (tid & 7) * 16) = ra;
        }
        LBAR();
        GDN2_ENSURE(c + 1 < 64 ? c + 1 : 63);
        {
            const int tid = tid_opaque(); KP pp = kparams();
            const size_t un = u0 + (c + 1 < 64 ? c + 1 : 63);
            const unsigned char* A = pp->ws + WS_H + un * AUXA_UNIT; const unsigned char* B = pp->ws + WS_OCAT + un * AUXB_UNIT;
#pragma unroll
            for (int k = 0; k < 2; ++k) { const int i = tid + 512 * k; rw[k] = ((const u32x4*)A)[i]; rq[k] = ((const u32x4*)B)[i]; rk[k] = ((const u32x4*)(B + 16384))[i]; }
#pragma unroll
            for (int k = 0; k < 4; ++k) ru[k] = ((const u32x2*)(A + 16384))[tid + 512 * k];
            ra = ((const u32x4*)(B + 32768))[tid]; rge = ((const float*)(pp->ws + WS_GE))[un];
        }
        {
            const int tid = tid_opaque(), lane = tid & 63, r16 = lane & 15, q4 = lane >> 4; (void)r16; (void)q4; (void)lane;
            KP pp = kparams(); bf16* ORp = (bf16*)(pp->ws + WS_ORAW) + (size_t)bl * SEQ * OC + h * 128 + wave * 16;
            bf16x8 sbf[4];
#pragma unroll
            for (int k4 = 0; k4 < 4; ++k4) sbf[k4] = *(const LAS bf16x8*)(SB + r16 * 272 + k4 * 64 + q4 * 16);
#pragma unroll
            for (int tl = 0; tl < 4; ++tl) {
                f32x4 p1 = (f32x4){0.f, 0.f, 0.f, 0.f};
#pragma unroll
                for (int k4 = 0; k4 < 4; ++k4) p1 = __builtin_amdgcn_mfma_f32_16x16x32_bf16(*(const LAS bf16x8*)(L + GD_VN + (16 * tl + r16) * 272 + k4 * 64 + q4 * 16), sbf[k4], p1, 0, 0, 0);
                const u32x2 uu = *(const LAS u32x2*)(L + GD_KN + (16 * wave + r16) * 136 + (16 * tl + 4 * q4) * 2);
                *(LAS u32x2*)(VNT + r16 * 144 + (16 * tl + 4 * q4) * 2) = (u32x2){pk2(bflo(uu.x) - p1[0], bfhi(uu.x) - p1[1]), pk2(bflo(uu.y) - p1[2], bfhi(uu.y) - p1[3])};
            }
            const bf16x8 vb0 = *(const LAS bf16x8*)(VNT + r16 * 144 + q4 * 16), vb1 = *(const LAS bf16x8*)(VNT + r16 * 144 + 64 + q4 * 16);
#pragma unroll
            for (int tl = 0; tl < 4; ++tl) {
                f32x4 o = (f32x4){0.f, 0.f, 0.f, 0.f};
#pragma unroll
                for (int k4 = 0; k4 < 4; ++k4) o = __builtin_amdgcn_mfma_f32_16x16x32_bf16(*(const LAS bf16x8*)(L + GD_QN + (16 * tl + r16) * 272 + k4 * 64 + q4 * 16), sbf[k4], o, 0, 0, 0);
                o = __builtin_amdgcn_mfma_f32_16x16x32_bf16(*(const LAS bf16x8*)(L + GD_MT + (16 * tl + r16) * 144 + q4 * 16), vb0, o, 0, 0, 0);
                if (tl >= 2) o = __builtin_amdgcn_mfma_f32_16x16x32_bf16(*(const LAS bf16x8*)(L + GD_MT + (16 * tl + r16) * 144 + 64 + q4 * 16), vb1, o, 0, 0, 0);
                bf16* orow = ORp + (size_t)(c * 64 + 16 * tl + 4 * q4) * OC + r16;
#pragma unroll
                for (int j = 0; j < 4; ++j) orow[(size_t)j * OC] = (bf16)pk1(o[j]);
            }
#pragma unroll
            for (int kt = 0; kt < 8; ++kt) {
                S[kt] = S[kt] * ge;
                S[kt] = __builtin_amdgcn_mfma_f32_16x16x32_bf16(*(const LAS bf16x8*)(L + GD_KET + (16 * kt + r16) * 144 + q4 * 16), vb0, S[kt], 0, 0, 0);
                S[kt] = __builtin_amdgcn_mfma_f32_16x16x32_bf16(*(const LAS bf16x8*)(L + GD_KET + (16 * kt + r16) * 144 + 64 + q4 * 16), vb1, S[kt], 0, 0, 0);
                *(LAS u32x2*)(SB + r16 * 272 + (16 * kt + 4 * q4) * 2) = (u32x2){pk2(S[kt][0], S[kt][1]), pk2(S[kt][2], S[kt][3])};
            }
        }
    }
    LBAR();
}

__device__ __forceinline__ void normgate_phase(KP p, int layer) {
    const int tid_ = tid_opaque(), lane = tid_ & 63, wave = __builtin_amdgcn_readfirstlane(tid_ >> 6);
    const bf16* P = (const bf16*)(p->ws + WS_PROJ); const bf16* ORAW = (const bf16*)(p->ws + WS_ORAW); bf16* OCAT = (bf16*)(p->ws + WS_OCAT);
    const int gw = bid_opaque() * 8 + wave, NGW = grid_opaque() * 8;
    const int c4 = 4 * lane;
    const f32x4 wg = *(const f32x4*)(p->in[9] + layer * 128 + (c4 & 127)), wh = *(const f32x4*)(p->in[11] + layer * 128 + (c4 & 127));
    const f32x4 ws0 = *(const f32x4*)(p->in[17] + layer * 512 + c4), ws1 = *(const f32x4*)(p->in[17] + layer * 512 + 256 + c4);
    const int rpw = (MH + NGW - 1) / NGW, r0 = gw * rpw, r1 = r0 + rpw < MH ? r0 + rpw : MH;
    if (r0 >= r1) return;
    u32x2 on[6], zn[6];
    { const bf16* o = ORAW + (size_t)r0 * OC + c4; const bf16* pr = P + (size_t)r0 * NP + c4;
#pragma unroll
      for (int j = 0; j < 6; ++j) on[j] = *(const u32x2*)(o + 256 * j);
      zn[0] = *(const u32x2*)(pr + C_GZ); zn[1] = *(const u32x2*)(pr + C_GZ + 256); zn[2] = *(const u32x2*)(pr + C_HG); zn[3] = *(const u32x2*)(pr + C_HG + 256); zn[4] = *(const u32x2*)(pr + C_SZ); zn[5] = *(const u32x2*)(pr + C_SZ + 256); }
    for (int r = r0; r < r1; ++r) {
        bf16* oc = OCAT + (size_t)r * OC + c4;
        f32x4 v[6]; u32x2 z[6];
#pragma unroll
        for (int j = 0; j < 6; ++j) { v[j] = (f32x4){bflo(on[j].x), bfhi(on[j].x), bflo(on[j].y), bfhi(on[j].y)}; z[j] = zn[j]; }
        if (r + 1 < r1) { const bf16* o = ORAW + (size_t)(r + 1) * OC + c4; const bf16* pr = P + (size_t)(r + 1) * NP + c4;
#pragma unroll
            for (int j = 0; j < 6; ++j) on[j] = *(const u32x2*)(o + 256 * j);
            zn[0] = *(const u32x2*)(pr + C_GZ); zn[1] = *(const u32x2*)(pr + C_GZ + 256); zn[2] = *(const u32x2*)(pr + C_HG); zn[3] = *(const u32x2*)(pr + C_HG + 256); zn[4] = *(const u32x2*)(pr + C_SZ); zn[5] = *(const u32x2*)(pr + C_SZ + 256); }
#pragma unroll
        for (int j = 0; j < 6; ++j) {
            f32x4 g; g[0] = silu_f(bflo(z[j].x)); g[1] = silu_f(bfhi(z[j].x)); g[2] = silu_f(bflo(z[j].y)); g[3] = silu_f(bfhi(z[j].y));
            f32x4 x = v[j]; if (j >= 4) x = x * g;
            float ss = (x[0] * x[0] + x[1] * x[1]) + (x[2] * x[2] + x[3] * x[3]);
            ss = red16(ss);
            const float s0 = rdl(ss, 0), s1 = rdl(ss, 16), s2 = rdl(ss, 32), s3 = rdl(ss, 48);
            float tot, inv;
            if (j >= 4) { tot = (s0 + s1) + (s2 + s3); inv = 1.f / 256.f; } else { tot = lane < 32 ? s0 + s1 : s2 + s3; inv = 1.f / 128.f; }
            const float rstd = rsqrtf(tot * inv + EPS);
            const f32x4 w = j < 2 ? wg : j < 4 ? wh : j == 4 ? ws0 : ws1;
            f32x4 y = x * rstd * w; if (j < 4) y = y * g;
            u32x2 ov; ov.x = pk2(y[0], y[1]); ov.y = pk2(y[2], y[3]);
            *(u32x2*)(oc + 256 * j) = ov;
        }
    }
}

__device__ __forceinline__ void glu_fix_phase(KP p, int layer) {
    const bf16* RB = (const bf16*)(p->ws + WS_RAWB); bf16* G = (bf16*)(p->ws + WS_G);
    const float* cw = p->in[24] + (size_t)layer * 3 * FF2; const float* cbp = p->in[25] + (size_t)layer * FF2;
    const int gt = bid_opaque() * 512 + tid_opaque(), NT = grid_opaque() * 512;
    constexpr int NPAIR = FF / 2;
    for (int idx = gt; idx < (MH / 64) * NPAIR; idx += NT) {
        const int b = idx / NPAIR, c = (idx % NPAIR) * 2;
        unsigned g[4], v[4];
#pragma unroll
        for (int s_ = 0; s_ < 4; ++s_) { g[s_] = *(const unsigned*)(RB + (size_t)(b * 4 + s_) * FF2 + c); v[s_] = *(const unsigned*)(RB + (size_t)(b * 4 + s_) * FF2 + FF + c); }
        if (((b * 64) % SEQ) == 0) { g[0] = 0u; g[1] = 0u; v[0] = 0u; v[1] = 0u; }
        float wg[3][2], wv[3][2];
#pragma unroll
        for (int k = 0; k < 3; ++k) { wg[k][0] = cw[k * FF2 + c]; wg[k][1] = cw[k * FF2 + c + 1]; wv[k][0] = cw[k * FF2 + FF + c]; wv[k][1] = cw[k * FF2 + FF + c + 1]; }
        const float bg0 = cbp[c], bg1 = cbp[c + 1], bv0 = cbp[FF + c], bv1 = cbp[FF + c + 1];
#pragma unroll
        for (int r = 0; r < 2; ++r) {
            const float ga = wg[0][0] * bflo(g[r]) + wg[1][0] * bflo(g[r + 1]) + wg[2][0] * bflo(g[r + 2]) + bg0;
            const float gb = wg[0][1] * bfhi(g[r]) + wg[1][1] * bfhi(g[r + 1]) + wg[2][1] * bfhi(g[r + 2]) + bg1;
            const float va = wv[0][0] * bflo(v[r]) + wv[1][0] * bflo(v[r + 1]) + wv[2][0] * bflo(v[r + 2]) + bv0;
            const float vb = wv[0][1] * bfhi(v[r]) + wv[1][1] * bfhi(v[r + 1]) + wv[2][1] * bfhi(v[r + 2]) + bv1;
            *(unsigned*)(G + (size_t)(b * 64 + r) * FF + c) = pk2(silu_f(ga) * va, silu_f(gb) * vb);
        }
    }
}

__device__ __forceinline__ void final_norm_phase(KP p) {
    const int tid_ = tid_opaque(), lane = tid_ & 63, wave = __builtin_amdgcn_readfirstlane(tid_ >> 6);
    const int gw = bid_opaque() * 8 + wave, NGW = grid_opaque() * 8;
    const float* nw = p->in[27];
    const int rpw = (MTOT + NGW - 1) / NGW, r0 = gw * rpw, r1 = r0 + rpw < MTOT ? r0 + rpw : MTOT;
    if (r0 >= r1) return;
    f32x4 w[4], v[4], vn[4];
#pragma unroll
    for (int j = 0; j < 4; ++j) { w[j] = *(const f32x4*)(nw + 4 * lane + 256 * j); vn[j] = ((const f32x4*)(p->out + (size_t)r0 * 1024) + lane)[64 * j]; }
    for (int r = r0; r < r1; ++r) {
#pragma unroll
        for (int j = 0; j < 4; ++j) v[j] = vn[j];
        if (r + 1 < r1) {
#pragma unroll
            for (int j = 0; j < 4; ++j) vn[j] = ((const f32x4*)(p->out + (size_t)(r + 1) * 1024) + lane)[64 * j]; }
        float s = 0.f;
#pragma unroll
        for (int j = 0; j < 4; ++j) s += (v[j][0] * v[j][0] + v[j][1] * v[j][1]) + (v[j][2] * v[j][2] + v[j][3] * v[j][3]);
        const float rstd = rsqrtf(wave_sum(s) * (1.f / 1024.f) + EPS);
        f32x4* xr = (f32x4*)(p->out + (size_t)r * 1024) + lane;
#pragma unroll
        for (int j = 0; j < 4; ++j) xr[64 * j] = v[j] * rstd * w[j];
    }
}


#define XB_TMO      128
#define XB_XCNT(j)  (256  + 64 * (j))
#define XB_XSUB(j)  (1280 + 64 * (j))
#define XB_XGEN(j)  (2304 + 64 * (j))
#define XB_TOP      3328
#define XB_TOPGEN   3392
#define XCD_BAR_WORDS 3456
#define XB_SPIN_CAP (1u << 20)
__device__ __forceinline__ unsigned xb_ld(unsigned* p)              { return __hip_atomic_load(p, __ATOMIC_RELAXED, __HIP_MEMORY_SCOPE_AGENT); }
__device__ __forceinline__ unsigned xb_add(unsigned* p, unsigned v) { return __hip_atomic_fetch_add(p, v, __ATOMIC_RELAXED, __HIP_MEMORY_SCOPE_AGENT); }
__device__ __forceinline__ unsigned xb_xcc_id() { return (unsigned)__builtin_amdgcn_s_getreg((3 << 11) | 20) & 0xFu; }
#define XB_SPIN(cond, bar) do { unsigned _sp = 0; while (cond) { __builtin_amdgcn_s_sleep(1); \
    if ((++_sp & 255u) == 0u) { if (xb_ld(&(bar)[XB_TMO])) break; if (_sp > XB_SPIN_CAP) { atomicAdd(&(bar)[XB_TMO], 1u); break; } } } } while (0)
struct XcdBarrier { unsigned* bar; unsigned x; volatile LAS unsigned* st; };
__device__ __forceinline__ XcdBarrier xcd_barrier_post(unsigned* bar, volatile LAS unsigned* st) {
    XcdBarrier b; b.bar = bar; b.x = xb_xcc_id(); b.st = st;
    if (threadIdx.x == 0) (void)xb_add(&bar[XB_XCNT(b.x)], 1u);
    return b;
}
__device__ __forceinline__ void xcd_barrier_complete(unsigned* bar, unsigned x, unsigned& nloc, unsigned& nx) {
    const unsigned G = gridDim.x * gridDim.y * gridDim.z;
    unsigned sum, cnt, mine, sp = 0u;
    for (;;) {
        sum = 0u; cnt = 0u; mine = 0u;
#pragma unroll
        for (unsigned j = 0; j < 16; ++j) { const unsigned c = xb_ld(&bar[XB_XCNT(j)]); sum += c; cnt += (c > 0u) ? 1u : 0u; mine = (j == x) ? c : mine; }
        if (sum == G) break;
        __builtin_amdgcn_s_sleep(1);
        if ((++sp & 255u) == 0u) { if (xb_ld(&bar[XB_TMO])) break; if (sp > XB_SPIN_CAP) { atomicAdd(&bar[XB_TMO], 1u); break; } }
    }
    nloc = mine > 0u ? mine : 1u; nx = cnt > 0u ? cnt : 1u;
}
__device__ __forceinline__ void xcd_barrier(const XcdBarrier& b) {
    asm volatile("s_waitcnt vmcnt(0)" ::: "memory");
    __syncthreads();
    if (threadIdx.x == 0) {
        unsigned* bar = b.bar;
        __builtin_amdgcn_s_waitcnt(0);
        unsigned nloc = b.st[0], nx = b.st[1];
        if (nloc == 0u) { xcd_barrier_complete(bar, b.x, nloc, nx); b.st[0] = nloc; b.st[1] = nx; }
        const unsigned old = xb_add(&bar[XB_XSUB(b.x)], 1u);
        const unsigned gen = old / nloc;
        if (old + 1u == (gen + 1u) * nloc) {
            __builtin_amdgcn_fence(__ATOMIC_RELEASE, "agent");
            asm volatile("s_waitcnt vmcnt(0)" ::: "memory");
            const unsigned og = xb_add(&bar[XB_TOP], 1u);
            const unsigned tg = og / nx;
            if (og + 1u == (tg + 1u) * nx) xb_add(&bar[XB_TOPGEN], 1u);
            else XB_SPIN(xb_ld(&bar[XB_TOPGEN]) == tg, bar);
            __builtin_amdgcn_fence(__ATOMIC_ACQUIRE, "agent");
            xb_add(&bar[XB_XGEN(b.x)], 1u);
            asm volatile("s_waitcnt vmcnt(0)" ::: "memory");
        } else {
            XB_SPIN(xb_ld(&bar[XB_XGEN(b.x)]) == gen, bar);
            __builtin_amdgcn_fence(__ATOMIC_ACQUIRE, "agent");
            asm volatile("s_waitcnt vmcnt(0)" ::: "memory");
        }
    }
    __syncthreads();
}

__global__ void __launch_bounds__(512, 2) mk_fwd(Params pv) {
    extern __shared__ __attribute__((aligned(16))) unsigned char lds_raw[];
    LAS unsigned char* lds = (LAS unsigned char*)lds_raw;
    cg::grid_group grid = cg::this_grid();
    const int ph_lo = pv.ph_lo, ph_hi = pv.ph_hi;
    volatile LAS unsigned* xst = (volatile LAS unsigned*)(lds + XB_ST_OFF);
    if (threadIdx.x < 2) xst[threadIdx.x] = 0u;
    __syncthreads();
    (void)xcd_barrier_post((unsigned*)(pv.ws + WS_BAR), xst);

    for (int ph = ph_lo; ph < ph_hi; ++ph) {
        if (ph > ph_lo) { if (ph == ph_lo + 1) grid.sync(); else { XcdBarrier xb_; xb_.bar = (unsigned*)(kparams()->ws + WS_BAR); xb_.x = xb_xcc_id(); xb_.st = (volatile LAS unsigned*)(lds_opaque(lds) + XB_ST_OFF); xcd_barrier(xb_); } }
        KP p = kparams();
        const int G = grid_opaque();
        unsigned char* ws = p->ws;
        if (ph == 0) { p0_prologue(p, lds); continue; }
        if (ph == NPH - 1) { final_norm_phase(p); continue; }
        const int q = ph - 1, layer = q / 20, hb = (q / 10) % 2, sub = q % 10;
        const int row_base = hb * MH;
        const float* mod = (const float*)(ws + WS_MOD) + (size_t)layer * 16 * 6144;
        const bf16* WL = (const bf16*)(ws + WS_W) + (size_t)layer * W_LAYER;
        bf16* HBUF = (bf16*)(ws + WS_H);
        const bf16* gA = nullptr; const bf16* gB = nullptr; int nt = 0, lda = 0, ldb = 0, nN = 0, epi = -1;
        switch (sub) {
        case 0: {
            const float* xin = (layer == 0 ? p->in[0] : p->out);
            norm_mod_phase(xin + (size_t)row_base * 1024, row_base, p->in[4] + layer * 1024, mod + 0, mod + 1024, HBUF, WL + W_IN + (size_t)C_SMALL * 1024, (float*)(ws + WS_SM));
        } break;
        case 1:
            gA = HBUF; gB = WL + W_IN; nt = 16; lda = 1024; ldb = 1024; nN = ((MH + G * 8 - 1) / (G * 8) == 16) ? C_SMALL / 256 : NP / 256; epi = 0; break;
        case 2: {
            const int b = bid_opaque();
            if (b < 64) ssd_unit(p, b, layer, lds);
            else if (b < 128) hgrn_unit(p, b - 64, layer, lds);
            else if (b < 160) gdn2_unit(p, b - 128, layer, layer * 2 + hb, lds);
            else if (G - 160 >= 32 && (G - 160) % 32 == 0) {
                u32x4 xr[3][4][2]; const int st = G - 160; int j = b - 160;
                gdn1_load_rows(p, ((j & 31) << 6) | (j >> 5), xr);
                for (; j < 2048; j += st) { const int jn = j + st < 2048 ? j + st : j; gdn1_unit(p, ((j & 31) << 6) | (j >> 5), layer, lds, xr, j == b - 160, ((jn & 31) << 6) | (jn >> 5)); }
            } else {
                u32x4 xr[3][4][2]; const int st = G - 160;
                for (int j = b - 160; j < 2048; j += st) { gdn1_load_rows(p, ((j & 31) << 6) | (j >> 5), xr); gdn1_unit(p, ((j & 31) << 6) | (j >> 5), layer, lds, xr, true, ((j & 31) << 6) | (j >> 5)); }
            }
        } break;
        case 3:
            normgate_phase(p, layer);
            break;
        case 4:
            gA = (const bf16*)(ws + WS_OCAT); gB = WL + W_BR; nt = 24; lda = OC; ldb = OC; nN = 4; epi = 1; break;
        case 5:
            gA = HBUF; gB = WL + W_OUT; nt = 16; lda = 1024; ldb = 1024; nN = 4; epi = 4; break;
        case 6:
            norm_mod_phase(p->out + (size_t)row_base * 1024, row_base, p->in[22] + layer * 1024, mod + 3072, mod + 4096, HBUF, nullptr, nullptr);
            break;
        case 7:
            gA = HBUF; gB = WL + W_UP; nt = 16; lda = 1024; ldb = 1024; nN = FF2 / 256; epi = 5; break;
        case 8:
            glu_fix_phase(p, layer);
            break;
        default:
            gA = (const bf16*)(ws + WS_G); gB = WL + W_DN; nt = FF / 64; lda = FF; ldb = FF; nN = 4; epi = 6; break;
        }
        if (epi >= 0) pg8::gemm_phase(lds, gA, gB, nt, lda, ldb, nN, epi, layer, row_base);
    }
}

extern "C" void kernel_launch(void* const* d_in, const int* in_sizes, int n_in, void* d_out, int out_size, void* d_ws, size_t ws_size, hipStream_t stream) {
    static int grid = 0;
    if (grid == 0) {
        if (n_in != 28 || out_size != MTOT * DM || ws_size < WS_END) { fprintf(stderr, "kernel_launch: unexpected problem: n_in %d out %d ws %zu (need %zu)\n", n_in, out_size, ws_size, (size_t)WS_END); grid = -1; return; }
        int dev = 0, cus = 0, per_cu = 0;
        hipGetDevice(&dev); hipDeviceGetAttribute(&cus, hipDeviceAttributeMultiprocessorCount, dev);
        hipFuncSetAttribute((const void*)mk_fwd, hipFuncAttributeMaxDynamicSharedMemorySize, LDS_BYTES);
        hipOccupancyMaxActiveBlocksPerMultiprocessor(&per_cu, (const void*)mk_fwd, 512, LDS_BYTES);
        if (per_cu < 1) { fprintf(stderr, "kernel_launch: occupancy query says %d blocks per CU\n", per_cu); per_cu = 1; }
        (void)hipGetLastError();
        grid = cus;
        if (grid < 192) { fprintf(stderr, "kernel_launch: %d CUs: the mixer phase needs at least 192 workgroups\n", grid); grid = -1; return; }
    }
    if (grid < 0) return;
    Params p{};
    for (int i = 0; i < 28; ++i) p.in[i] = (const float*)d_in[i];
    p.out = (float*)d_out; p.ws = (unsigned char*)d_ws;
#if MK_COOP
    p.ph_lo = 0; p.ph_hi = NPH;
    (void)hipMemsetAsync((char*)d_ws + WS_BAR, 0, 16384, stream);
    void* args[] = {&p};
    hipError_t e = hipLaunchCooperativeKernel((const void*)mk_fwd, dim3(grid), dim3(512), args, LDS_BYTES, stream);
    if (e != hipSuccess) fprintf(stderr, "cooperative launch failed: %s (grid %d)\n", hipGetErrorString(e), grid);
#else
    for (int ph = 0; ph < NPH; ++ph) { p.ph_lo = ph; p.ph_hi = ph + 1; hipLaunchKernelGGL(mk_fwd, dim3(grid), dim3(512), LDS_BYTES, stream, p); }
#endif
}
```

```cpp
#include <hip/hip_runtime.h>
#include <hip/hip_cooperative_groups.h>
#include <cstdio>
#include <cstdint>
namespace cg = cooperative_groups;

#ifndef MK_COOP
#define MK_COOP 1
#endif

#define LAS __attribute__((address_space(3)))
typedef unsigned short bf16;
typedef short bf16x8 __attribute__((ext_vector_type(8)));
typedef float f32x4 __attribute__((ext_vector_type(4)));
typedef unsigned u32x4 __attribute__((ext_vector_type(4)));
typedef unsigned u32x2 __attribute__((ext_vector_type(2)));

constexpr int DM = 1024, SEQ = 4096, BATCH = 16, MTOT = BATCH * SEQ, HB_SEQ = 8, MH = HB_SEQ * SEQ;
constexpr int NIN = 8720, NP = 8960;
constexpr int C_GZ = 1536, C_HQ = 2048, C_HF = 2560, C_HI = 3072, C_HG = 3584, C_SZ = 4096, C_XBC = 4608, C_GATE = 5632, C_SMALL = 8704;
constexpr int FF = 2816, FF2 = 5632, OC = 1536;
constexpr float EPS = 1e-6f;
constexpr size_t W_IN = 0, W_BR = (size_t)NP * 1024, W_OUT = W_BR + 3 * 524288, W_UP = W_OUT + 1048576, W_DN = W_UP + (size_t)FF2 * 1024, W_LAYER = W_DN + (size_t)FF * 1024;
constexpr size_t MiB = 1u << 20;
constexpr size_t WS_MOD = 0, WS_W = 1 * MiB, WS_H = 80 * MiB, WS_SM = 144 * MiB, WS_OCAT = 146 * MiB, WS_ORAW = 242 * MiB, WS_PROJ = 434 * MiB, WS_G = 786 * MiB, WS_END = 994 * MiB;
static_assert(WS_W + 2 * W_LAYER * 2 <= WS_H, "weights fit");
constexpr size_t WS_RAWB = 338 * MiB;
constexpr int LDS_BYTES = 147456 + 256;
constexpr int XB_ST_OFF = 147456;
constexpr size_t WS_BAR = 900 * 1024;
constexpr int NPH = 42;

typedef float f32x2_t __attribute__((ext_vector_type(2)));
typedef __bf16 bf16x2_t __attribute__((ext_vector_type(2)));
__device__ __forceinline__ unsigned pk2(float lo, float hi) { const f32x2_t v = {lo, hi}; const bf16x2_t b = __builtin_convertvector(v, bf16x2_t); return __builtin_bit_cast(unsigned, b); }
__device__ __forceinline__ unsigned f2bf(float f) { return pk2(f, f) & 0xffffu; }
__device__ __forceinline__ unsigned pk1(float f) { return pk2(f, f); }
__device__ __forceinline__ float bf2f(unsigned b) { return __builtin_bit_cast(float, b << 16); }
__device__ __forceinline__ float bflo(unsigned w) { return __builtin_bit_cast(float, w << 16); }
__device__ __forceinline__ float bfhi(unsigned w) { return __builtin_bit_cast(float, w & 0xffff0000u); }
__device__ __forceinline__ float silu_f(float v) { return v * __builtin_amdgcn_rcpf(1.f + __builtin_amdgcn_exp2f(-1.4426950408889634f * v)); }
__device__ __forceinline__ float sigmoid_f(float v) { return __builtin_amdgcn_rcpf(1.f + __builtin_amdgcn_exp2f(-1.4426950408889634f * v)); }
__device__ __forceinline__ float softplus_f(float v) { const float z = __expf(-fabsf(v)); const float l = (z < 0.01f) ? z * (1.f - z * (0.5f - z * (1.f / 3.f))) : __logf(1.f + z); return fmaxf(v, 0.f) + l; }
template <int CTRL> __device__ __forceinline__ float dppf(float v) { return __builtin_bit_cast(float, __builtin_amdgcn_update_dpp(0, __builtin_bit_cast(int, v), CTRL, 0xf, 0xf, true)); }
__device__ __forceinline__ float red16(float v) { v += dppf<0xB1>(v); v += dppf<0x4E>(v); v += dppf<0x141>(v); v += dppf<0x128>(v); return v; }
__device__ __forceinline__ float rdl(float v, int l) { return __builtin_bit_cast(float, __builtin_amdgcn_readlane(__builtin_bit_cast(int, v), l)); }
__device__ __forceinline__ float wave_sum(float v) { v = red16(v); return (rdl(v, 0) + rdl(v, 16)) + (rdl(v, 32) + rdl(v, 48)); }
__device__ __forceinline__ float wave_scan_incl(float v, int lane) {
    v += dppf<0x111>(v); v += dppf<0x112>(v); v += dppf<0x114>(v); v += dppf<0x118>(v);
    const float t0 = rdl(v, 15), t1 = rdl(v, 31), t2 = rdl(v, 47); const int q = lane >> 4;
    return v + (q >= 1 ? t0 : 0.f) + (q >= 2 ? t1 : 0.f) + (q >= 3 ? t2 : 0.f);
}

struct Params { const float* in[28]; float* out; unsigned char* ws; int ph_lo, ph_hi; };
typedef const __attribute__((address_space(4))) Params* KP;
__device__ __forceinline__ int tid_opaque() { int t = threadIdx.x; asm volatile("" : "+v"(t)); return t; }
__device__ __forceinline__ int bid_opaque() { int b = blockIdx.x; asm volatile("" : "+s"(b)); return b; }
__device__ __forceinline__ int grid_opaque() { int g = gridDim.x; asm volatile("" : "+s"(g)); return g; }
__device__ __forceinline__ LAS unsigned char* lds_opaque(LAS unsigned char* l) { asm volatile("" : "+s"(l)); return l; }
__device__ __forceinline__ KP kparams() { KP q = (KP)__builtin_amdgcn_kernarg_segment_ptr(); asm volatile("" : "+s"(q)); return q; }


namespace pg8 {
constexpr int BM = 256, BK = 64, HALF = 128, HTB = HALF * BK * 2, STAGE_BYTES = 8 * HTB, NXCD = 8, WGM = 4;
__device__ __forceinline__ int lds_byte(int r, int c) { const int st = (r >> 4) * 2 + (c >> 5), rr = r & 15, cc = c & 31, ob = rr * 64 + cc * 2; return st * 1024 + (ob ^ (((ob >> 9) & 1) << 5)); }
__device__ __forceinline__ void stage_rc(int b, int& R, int& C) { const int st = b / 1024, sb = b % 1024, swz = sb ^ (((sb >> 9) & 1) << 5); R = (st >> 1) * 16 + swz / 64; C = (st & 1) * 32 + (swz % 64) / 2; }
__device__ __forceinline__ int perm32(int rho) { const int n = rho >> 4, i = rho & 15; return 8 * (i >> 2) + 4 * n + (i & 3); }
struct Unit { int pm, pn; };
struct StaticOrder {
    int nM, nN, nwg, G, c;
    __device__ __forceinline__ void init(int M, int N, int G_, int c_) { nM = M / BM; nN = N / BM; nwg = nM * nN; G = G_; c = c_; }
    __device__ __forceinline__ bool next(int i, Unit& u) const {
        const long L = (long)i * G + c; if (L >= nwg) return false;
        int wgid = (int)L; { const int q = nwg / NXCD, r = nwg % NXCD, xcd = wgid % NXCD, off = wgid / NXCD; wgid = (xcd < r ? xcd * (q + 1) : r * (q + 1) + (xcd - r) * q) + off; }
        const int nig = WGM * nN, gid = wgid / nig, fm = gid * WGM, gsz = (nM - fm) < WGM ? (nM - fm) : WGM;
        u.pm = fm + ((wgid % nig) % gsz); u.pn = (wgid % nig) / gsz; return true;
    }
};
__device__ __forceinline__ unsigned cvt_pk_bf16(float lo, float hi) { return pk2(lo, hi); }

template <int LDC, bool SMALL> struct EpiBf16 {
    static constexpr bool PERM = true;
    __device__ __forceinline__ void operator()(const f32x4 (&acc)[2][2][4][2], const Unit& u, int wr, int wc, int fr, int fq) const {
        KP p = kparams(); unsigned char* ws = p->ws;
        bf16* O = (bf16*)(ws + WS_PROJ);
        const int row0 = u.pm * BM + wr * 64 + fr; const int col0 = u.pn * BM + wc * 32 + 8 * fq;
#pragma unroll
        for (int ai = 0; ai < 2; ++ai)
#pragma unroll
            for (int m = 0; m < 4; ++m) { bf16* rowp = O + (size_t)(row0 + ai * HALF + m * 16) * LDC + col0;
#pragma unroll
                for (int bj = 0; bj < 2; ++bj) { const f32x4 v0 = acc[ai][bj][m][0], v1 = acc[ai][bj][m][1];
                    u32x4 w; w.x = cvt_pk_bf16(v0[0], v0[1]); w.y = cvt_pk_bf16(v0[2], v0[3]); w.z = cvt_pk_bf16(v1[0], v1[1]); w.w = cvt_pk_bf16(v1[2], v1[3]);
                    *(u32x4*)(rowp + bj * HALF) = w; } }
        if (SMALL && u.pn == C_SMALL / 256 && wc == 0 && fq < 2) {
            float* sm = (float*)(ws + WS_SM);
#pragma unroll
            for (int ai = 0; ai < 2; ++ai)
#pragma unroll
                for (int m = 0; m < 4; ++m) { float* q = sm + (size_t)(row0 + ai * HALF + m * 16) * 16 + 8 * fq; *(f32x4*)q = acc[ai][0][m][0]; *(f32x4*)(q + 4) = acc[ai][0][m][1]; }
        }
    }
};
__device__ __forceinline__ void branch_rescale(f32x4 (&acc)[2][2][4][2], const Unit& u, int wr, int wc, int fr, int fq, int which) {
    KP p = kparams();
    const bf16* gate = (const bf16*)(p->ws + WS_PROJ) + C_GATE + which * 1024;
    const int col0 = u.pn * BM + wc * 32 + 4 * fq;
#pragma unroll
    for (int ai = 0; ai < 2; ++ai)
#pragma unroll
        for (int mp = 0; mp < 2; ++mp) {
            u32x2 ga[2][2][2], gb[2][2][2];
#pragma unroll
            for (int mm = 0; mm < 2; ++mm) { const size_t row = (size_t)(u.pm * BM + ai * HALF + wr * 64 + (2 * mp + mm) * 16 + fr);
#pragma unroll
                for (int bj = 0; bj < 2; ++bj)
#pragma unroll
                    for (int n = 0; n < 2; ++n) { const int c = col0 + bj * HALF + n * 16; ga[mm][bj][n] = *(const u32x2*)(gate + row * NP + c); gb[mm][bj][n] = *(const u32x2*)(gate + row * NP + 1024 + c); } }
#pragma unroll
            for (int mm = 0; mm < 2; ++mm)
#pragma unroll
                for (int bj = 0; bj < 2; ++bj)
#pragma unroll
                    for (int n = 0; n < 2; ++n) { const u32x2 xa = ga[mm][bj][n], xb = gb[mm][bj][n];
                        f32x4 r;
                        r[0] = (1.f + __builtin_amdgcn_exp2f(-1.4426950408889634f * bflo(xb.x))) * __builtin_amdgcn_rcpf(1.f + __builtin_amdgcn_exp2f(-1.4426950408889634f * bflo(xa.x)));
                        r[1] = (1.f + __builtin_amdgcn_exp2f(-1.4426950408889634f * bfhi(xb.x))) * __builtin_amdgcn_rcpf(1.f + __builtin_amdgcn_exp2f(-1.4426950408889634f * bfhi(xa.x)));
                        r[2] = (1.f + __builtin_amdgcn_exp2f(-1.4426950408889634f * bflo(xb.y))) * __builtin_amdgcn_rcpf(1.f + __builtin_amdgcn_exp2f(-1.4426950408889634f * bflo(xa.y)));
                        r[3] = (1.f + __builtin_amdgcn_exp2f(-1.4426950408889634f * bfhi(xb.y))) * __builtin_amdgcn_rcpf(1.f + __builtin_amdgcn_exp2f(-1.4426950408889634f * bfhi(xa.y)));
                        acc[ai][bj][2 * mp + mm][n] = acc[ai][bj][2 * mp + mm][n] * r; }
        }
    asm volatile("s_waitcnt vmcnt(0)" ::: "memory");
}
struct EpiBranchFinal {
    static constexpr bool PERM = false;
    __device__ __forceinline__ void operator()(const f32x4 (&acc)[2][2][4][2], const Unit& u, int wr, int wc, int fr, int fq) const {
        KP p = kparams(); unsigned char* ws = p->ws;
        const bf16* gate = (const bf16*)(ws + WS_PROJ) + C_GATE + 2048; bf16* mb = (bf16*)(ws + WS_H);
        const int col0 = u.pn * BM + wc * 32 + 4 * fq;
#pragma unroll
        for (int ai = 0; ai < 2; ++ai)
#pragma unroll
            for (int mp = 0; mp < 2; ++mp) {
                u32x2 gr[2][2][2];
#pragma unroll
                for (int mm = 0; mm < 2; ++mm) { const size_t row = (size_t)(u.pm * BM + ai * HALF + wr * 64 + (2 * mp + mm) * 16 + fr);
#pragma unroll
                    for (int bj = 0; bj < 2; ++bj)
#pragma unroll
                        for (int n = 0; n < 2; ++n) gr[mm][bj][n] = *(const u32x2*)(gate + row * NP + col0 + bj * HALF + n * 16); }
#pragma unroll
                for (int mm = 0; mm < 2; ++mm) { const size_t row = (size_t)(u.pm * BM + ai * HALF + wr * 64 + (2 * mp + mm) * 16 + fr);
#pragma unroll
                    for (int bj = 0; bj < 2; ++bj)
#pragma unroll
                        for (int n = 0; n < 2; ++n) { const int c = col0 + bj * HALF + n * 16; const u32x2 x = gr[mm][bj][n];
                            f32x4 g; g[0] = sigmoid_f(bflo(x.x)); g[1] = sigmoid_f(bfhi(x.x)); g[2] = sigmoid_f(bflo(x.y)); g[3] = sigmoid_f(bfhi(x.y));
                            const f32x4 v = acc[ai][bj][2 * mp + mm][n] * g; u32x2 w; w.x = cvt_pk_bf16(v[0], v[1]); w.y = cvt_pk_bf16(v[2], v[3]); *(u32x2*)(mb + row * 1024 + c) = w; } }
            }
    }
};
struct EpiUpGlu {
    static constexpr bool PERM = true;
    int layer;
    __device__ __forceinline__ void operator()(const f32x4 (&acc)[2][2][4][2], const Unit& u, int wr, int wc, int fr, int fq) const {
        KP p = kparams(); unsigned char* ws = p->ws;
        bf16* G = (bf16*)(ws + WS_G); bf16* RB = (bf16*)(ws + WS_RAWB);
        const float* cw = p->in[24] + (size_t)layer * 3 * FF2; const float* cb = p->in[25] + (size_t)layer * FF2;
        const int gcol = u.pn * 128 + wc * 32 + 8 * fq;
#pragma unroll
        for (int n = 0; n < 2; ++n) {
            asm volatile("" ::: "memory");
            f32x4 wg[3], wv[3];
#pragma unroll
            for (int k = 0; k < 3; ++k) { wg[k] = *(const f32x4*)(cw + k * FF2 + gcol + 4 * n); wv[k] = *(const f32x4*)(cw + k * FF2 + FF + gcol + 4 * n); }
            const f32x4 bg = *(const f32x4*)(cb + gcol + 4 * n), bv = *(const f32x4*)(cb + FF + gcol + 4 * n);
#pragma unroll
            for (int ai = 0; ai < 2; ++ai)
#pragma unroll
                for (int m = 0; m < 4; ++m) {
                    const int row = u.pm * BM + ai * HALF + wr * 64 + m * 16 + fr;
                    float o[4];
#pragma unroll
                    for (int e = 0; e < 4; ++e) {
                        const float cg = n == 0 ? acc[ai][0][m][0][e] : acc[ai][0][m][1][e], cv = n == 0 ? acc[ai][1][m][0][e] : acc[ai][1][m][1][e];
                        const float pg = m > 0 ? (n == 0 ? acc[ai][0][m > 0 ? m - 1 : 0][0][e] : acc[ai][0][m > 0 ? m - 1 : 0][1][e]) : cg;
                        const float pv = m > 0 ? (n == 0 ? acc[ai][1][m > 0 ? m - 1 : 0][0][e] : acc[ai][1][m > 0 ? m - 1 : 0][1][e]) : cv;
                        const float cg1 = dppf<0x121>(cg), pg1 = dppf<0x121>(pg), cg2 = dppf<0x122>(cg), pg2 = dppf<0x122>(pg);
                        const float cv1 = dppf<0x121>(cv), pv1 = dppf<0x121>(pv), cv2 = dppf<0x122>(cv), pv2 = dppf<0x122>(pv);
                        const float g1 = fr >= 1 ? cg1 : pg1, g2 = fr >= 2 ? cg2 : pg2, v1 = fr >= 1 ? cv1 : pv1, v2 = fr >= 2 ? cv2 : pv2;
                        const float yg = wg[0][e] * g2 + wg[1][e] * g1 + wg[2][e] * cg + bg[e];
                        const float yv = wv[0][e] * v2 + wv[1][e] * v1 + wv[2][e] * cv + bv[e];
                        o[e] = silu_f(yg) * yv;
                    }
                    if (!(m == 0 && fr < 2)) { u32x2 w; w.x = pk2(o[0], o[1]); w.y = pk2(o[2], o[3]); *(u32x2*)(G + (size_t)row * FF + gcol + 4 * n) = w; }
                    int slot = -1, b = row >> 6;
                    if (m == 0 && fr < 2) slot = 2 + fr; else if (m == 3 && fr >= 14) { slot = fr - 14; b += 1; }
                    if (slot >= 0 && b < MH / 64) {
                        const f32x4 g0 = n == 0 ? acc[ai][0][m][0] : acc[ai][0][m][1], v0 = n == 0 ? acc[ai][1][m][0] : acc[ai][1][m][1];
                        bf16* rb = RB + (size_t)(b * 4 + slot) * FF2 + gcol + 4 * n;
                        u32x2 w; w.x = pk2(g0[0], g0[1]); w.y = pk2(g0[2], g0[3]); *(u32x2*)rb = w;
                        w.x = pk2(v0[0], v0[1]); w.y = pk2(v0[2], v0[3]); *(u32x2*)(rb + FF) = w;
                    }
                }
        }
    }
};
template <bool SECOND> struct EpiResid {
    static constexpr bool PERM = false;
    int layer, row_base;
    __device__ __forceinline__ void operator()(const f32x4 (&acc)[2][2][4][2], const Unit& u, int wr, int wc, int fr, int fq) const {
        KP p = kparams();
        float* out = p->out; const float* base = (SECOND || layer != 0) ? (const float*)out : p->in[0];
        const float* gate = (const float*)(p->ws + WS_MOD) + (size_t)layer * 16 * 6144 + (SECOND ? 5120 : 2048);
        const int col0 = u.pn * BM + wc * 32 + 4 * fq;
        const int b = (row_base + u.pm * BM) / SEQ;
        f32x4 gv[2][2];
#pragma unroll
        for (int bj = 0; bj < 2; ++bj)
#pragma unroll
            for (int n = 0; n < 2; ++n) gv[bj][n] = *(const f32x4*)(gate + (size_t)b * 6144 + col0 + bj * HALF + n * 16);
#pragma unroll
        for (int ai = 0; ai < 2; ++ai)
#pragma unroll
            for (int mp = 0; mp < 2; ++mp) {
                f32x4 bs[2][2][2];
#pragma unroll
                for (int mm = 0; mm < 2; ++mm) { const size_t off = (size_t)(row_base + u.pm * BM + ai * HALF + wr * 64 + (2 * mp + mm) * 16 + fr) * 1024 + col0;
#pragma unroll
                    for (int bj = 0; bj < 2; ++bj)
#pragma unroll
                        for (int n = 0; n < 2; ++n) bs[mm][bj][n] = *(const f32x4*)(base + off + bj * HALF + n * 16); }
#pragma unroll
                for (int mm = 0; mm < 2; ++mm) { const size_t off = (size_t)(row_base + u.pm * BM + ai * HALF + wr * 64 + (2 * mp + mm) * 16 + fr) * 1024 + col0;
#pragma unroll
                    for (int bj = 0; bj < 2; ++bj)
#pragma unroll
                        for (int n = 0; n < 2; ++n) *(f32x4*)(out + off + bj * HALF + n * 16) = bs[mm][bj][n] + gv[bj][n] * acc[ai][bj][2 * mp + mm][n]; }
            }
    }
};

__device__ __forceinline__ void gemm_phase(LAS unsigned char* lds, const bf16* gA, const bf16* gBt, const int nt, const int LDA, const int LDB, const int nN, const int epi, const int layer, const int row_base) {
    StaticOrder S; S.nM = MH / BM; S.nN = nN; S.nwg = S.nM * nN; S.G = grid_opaque(); S.c = bid_opaque();
    const bool PERM = (epi == 0 || epi == 5);
    const int tid = tid_opaque(), wid = __builtin_amdgcn_readfirstlane(tid >> 6), lane = tid & 63, wr = wid >> 2, wc = wid & 3;
    unsigned voffA[2], voffB[2];
#pragma unroll
    for (int i = 0; i < 2; ++i) { int R, C; stage_rc(tid * 16 + i * 8192, R, C); const int Rb = PERM ? ((R & ~31) + perm32(R & 31)) : R;
        voffA[i] = (unsigned)(R * LDA + C) * 2u; voffB[i] = (unsigned)(Rb * LDB + C) * 2u; }
    constexpr size_t kstep = (size_t)(BK * 2);
    const size_t hstepA = (size_t)HALF * LDA * 2, hstepB = (size_t)HALF * LDB * 2;
    const size_t tstepA = 2 * hstepA, tstepB = 2 * hstepB;
    const unsigned ldsw = (unsigned)wid * 1024u;
    const int aoff = lds_byte(wr * 64 + (lane & 15), (lane >> 4) * 8), boff = lds_byte(wc * 32 + (lane & 15), (lane >> 4) * 8);
#define PG8_SA(b, h) (((b) * 2 + (h)) * HTB)
#define PG8_SB(b, h) ((4 + (b) * 2 + (h)) * HTB)
#define PG8_STAGE(bufoff, gbase, voff) do { _Pragma("unroll") for (int _i = 0; _i < 2; ++_i) \
        __builtin_amdgcn_global_load_lds((const unsigned*)((const char*)(gbase) + (voff)[_i]), (LAS unsigned*)(lds + (bufoff) + ldsw + _i * 8192), 16, 0, 0); } while (0)
#define PG8_LDA(dst, b, h) do { _Pragma("unroll") for (int m = 0; m < 4; ++m) _Pragma("unroll") for (int k = 0; k < 2; ++k) dst[m][k] = *(const LAS bf16x8*)(lds + PG8_SA(b, h) + aoff + m * 2048 + k * 1024); } while (0)
#define PG8_LDB(dst, b, h) do { _Pragma("unroll") for (int n = 0; n < 2; ++n) _Pragma("unroll") for (int k = 0; k < 2; ++k) dst[n][k] = *(const LAS bf16x8*)(lds + PG8_SB(b, h) + boff + n * 2048 + k * 1024); } while (0)
#define PG8_MMA(ai, bj, At, Bt) do { __builtin_amdgcn_s_setprio(1); _Pragma("unroll") for (int m = 0; m < 4; ++m) _Pragma("unroll") for (int n = 0; n < 2; ++n) _Pragma("unroll") for (int k = 0; k < 2; ++k) \
        acc[ai][bj][m][n] = __builtin_amdgcn_mfma_f32_16x16x32_bf16(Bt[n][k], At[m][k], acc[ai][bj][m][n], 0, 0, 0); __builtin_amdgcn_s_setprio(0); } while (0)
#define PG8_WAIT_V(n) asm volatile("s_waitcnt vmcnt(" #n ")" ::: "memory")
#define PG8_WAIT_L(n) asm volatile("s_waitcnt lgkmcnt(" #n ")" ::: "memory")
#define PG8_BAR __builtin_amdgcn_s_barrier()
#define PG8_SCHED __builtin_amdgcn_sched_barrier(0)
    Unit cur, nxt; int ui = 0;
    if (!S.next(0, cur)) return;
    f32x4 acc[2][2][4][2];
#pragma unroll
    for (int a = 0; a < 2; ++a)
#pragma unroll
        for (int b = 0; b < 2; ++b)
#pragma unroll
            for (int m = 0; m < 4; ++m)
#pragma unroll
                for (int n = 0; n < 2; ++n) acc[a][b][m][n] = (f32x4){0.f, 0.f, 0.f, 0.f};
    bf16x8 At[4][2], B0[2][2], B1[2][2];
    const char* cA = (const char*)gA + (size_t)cur.pm * tstepA; const char* cB = (const char*)gBt + (size_t)cur.pn * tstepB;
    PG8_STAGE(PG8_SB(0, 0), cB, voffB); PG8_STAGE(PG8_SB(0, 1), cB + hstepB, voffB); PG8_STAGE(PG8_SA(0, 0), cA, voffA); PG8_STAGE(PG8_SA(0, 1), cA + hstepA, voffA);
    if (wr == 1) PG8_BAR;
    PG8_WAIT_V(2); PG8_BAR;
    PG8_STAGE(PG8_SB(1, 0), cB + kstep, voffB); PG8_STAGE(PG8_SA(1, 0), cA + kstep, voffA); PG8_STAGE(PG8_SB(1, 1), cB + hstepB + kstep, voffB);
    PG8_WAIT_V(6); PG8_BAR;
    for (;;) {
        const bool has_next = S.next(ui + 1, nxt);
        const char* nA = has_next ? (const char*)gA + (size_t)nxt.pm * tstepA : cA; const char* nB = has_next ? (const char*)gBt + (size_t)nxt.pn * tstepB : cB;
        for (int t = 0; t < nt; t += 2) {
            if (epi == 1 && (t == 8 || t == 16)) { const int tr_ = tid_opaque(); branch_rescale(acc, cur, wr, wc, tr_ & 15, (tr_ & 63) >> 4, t == 8 ? 0 : 1); }
            const bool last = (t == nt - 2);
            const char* a1 = cA + (size_t)(t + 1) * kstep;
            const char* a2 = last ? nA : cA + (size_t)(t + 2) * kstep; const char* b2 = last ? nB : cB + (size_t)(t + 2) * kstep;
            const char* a3 = a2 + kstep; const char* b3 = b2 + kstep;
            PG8_LDB(B0, 0, 0); PG8_LDB(B1, 0, 1); PG8_SCHED; PG8_LDA(At, 0, 0); PG8_STAGE(PG8_SA(1, 1), a1 + hstepA, voffA);
            PG8_WAIT_V(8); PG8_WAIT_L(0); PG8_BAR; PG8_MMA(0, 0, At, B0); PG8_MMA(0, 1, At, B1); PG8_BAR; PG8_SCHED;
            PG8_LDA(At, 0, 1); PG8_STAGE(PG8_SB(0, 0), b2, voffB); PG8_STAGE(PG8_SB(0, 1), b2 + hstepB, voffB); PG8_STAGE(PG8_SA(0, 0), a2, voffA);
            PG8_WAIT_V(8); PG8_WAIT_L(0); PG8_BAR; PG8_MMA(1, 0, At, B0); PG8_MMA(1, 1, At, B1); PG8_BAR; PG8_SCHED;
            PG8_LDB(B0, 1, 0); PG8_LDB(B1, 1, 1); PG8_SCHED; PG8_LDA(At, 1, 0); PG8_STAGE(PG8_SA(0, 1), a2 + hstepA, voffA);
            PG8_WAIT_V(8); PG8_WAIT_L(0); PG8_BAR; PG8_MMA(0, 0, At, B0); PG8_MMA(0, 1, At, B1); PG8_BAR; PG8_SCHED;
            PG8_LDA(At, 1, 1); PG8_STAGE(PG8_SB(1, 0), b3, voffB); PG8_STAGE(PG8_SB(1, 1), b3 + hstepB, voffB); PG8_STAGE(PG8_SA(1, 0), a3, voffA);
            PG8_WAIT_V(8); PG8_WAIT_L(0); PG8_BAR; PG8_MMA(1, 0, At, B0); PG8_MMA(1, 1, At, B1); PG8_BAR; PG8_SCHED;
        }
        if (wr == 0) PG8_BAR;
        const int te = tid_opaque(), fr = te & 15, fq = (te & 63) >> 4;
        switch (epi) {
        case 0: { EpiBf16<NP, true> E; E(acc, cur, wr, wc, fr, fq); } break;
        case 1: { EpiBranchFinal E; E(acc, cur, wr, wc, fr, fq); } break;
        case 4: { EpiResid<false> E{layer, row_base}; E(acc, cur, wr, wc, fr, fq); } break;
        case 5: { EpiUpGlu E{layer}; E(acc, cur, wr, wc, fr, fq); } break;
        default: { EpiResid<true> E{layer, row_base}; E(acc, cur, wr, wc, fr, fq); } break;
        }
        if (!has_next) break;
#pragma unroll
        for (int a = 0; a < 2; ++a)
#pragma unroll
            for (int b = 0; b < 2; ++b)
#pragma unroll
                for (int m = 0; m < 4; ++m)
#pragma unroll
                    for (int n = 0; n < 2; ++n) acc[a][b][m][n] = (f32x4){0.f, 0.f, 0.f, 0.f};
        cur = nxt; cA = nA; cB = nB; ++ui;
        if (wr == 1) PG8_BAR;
    }
    PG8_WAIT_V(0);
    PG8_BAR;
#undef PG8_SA
#undef PG8_SB
#undef PG8_STAGE
#undef PG8_LDA
#undef PG8_LDB
#undef PG8_MMA
#undef PG8_WAIT_V
#undef PG8_WAIT_L
#undef PG8_BAR
#undef PG8_SCHED
}
}

__device__ __forceinline__ void tr_item(const float* W, int K, int ldw, int src_col0, int nblk, bf16* WT, int dst_row0, LAS float* scr, int item, int lane) {
    const int kb = item / nblk, nb = item % nblk, k0 = 64 * kb, n0 = 32 * nb;
    float wv_[32];
#pragma unroll
    for (int i = 0; i < 32; ++i) { const int kk = 2 * i + (lane >> 5); wv_[i] = W[(size_t)(k0 + kk) * ldw + src_col0 + n0 + (lane & 31)]; }
#pragma unroll
    for (int i = 0; i < 32; ++i) { const int kk = 2 * i + (lane >> 5); scr[kk * 33 + (lane & 31)] = wv_[i]; }
    asm volatile("s_waitcnt lgkmcnt(0)" ::: "memory");
    const int c = lane & 7;
#pragma unroll
    for (int j = 0; j < 4; ++j) { const int n = (lane >> 3) + 8 * j; const LAS float* s = scr + (8 * c) * 33 + n;
        u32x4 o; o.x = pk2(s[0 * 33], s[1 * 33]); o.y = pk2(s[2 * 33], s[3 * 33]); o.z = pk2(s[4 * 33], s[5 * 33]); o.w = pk2(s[6 * 33], s[7 * 33]);
        *(u32x4*)(WT + (size_t)(dst_row0 + n0 + n) * K + k0 + 8 * c) = o; }
    asm volatile("s_waitcnt lgkmcnt(0)" ::: "memory");
}
__device__ __forceinline__ void p0_prologue(KP p, LAS unsigned char* lds) {
    const int tid = tid_opaque(), lane = tid & 63, wave = __builtin_amdgcn_readfirstlane(tid >> 6);
    LAS float* scr = (LAS float*)(lds + wave * 16384);
    const int gw = bid_opaque() * 8 + wave, NGW = grid_opaque() * 8;
    constexpr int I_A = 16 * 48, I_B = 16 * 128, I_C = 16 * 96, I_BR = 8 * 32, I_O = 16 * 32, I_U = 16 * 176, I_D = 44 * 32;
    constexpr int PER_LAYER = I_A + I_B + I_C + 3 * I_BR + I_O + I_U + I_D;
    for (int it = gw; it < 2 * PER_LAYER; it += NGW) {
        KP pp = kparams();
        const int l = it / PER_LAYER; int r = it % PER_LAYER;
        bf16* WL = (bf16*)(pp->ws + WS_W) + (size_t)l * W_LAYER;
        const float* W; int K, ldw, src0 = 0, nblk, dst0 = 0; size_t wo;
        if (r < I_A) { W = pp->in[5] + (size_t)l * 1024 * NIN; K = 1024; ldw = NIN; src0 = 0; nblk = 48; wo = W_IN; dst0 = 0; }
        else if ((r -= I_A) < I_B) { W = pp->in[5] + (size_t)l * 1024 * NIN; K = 1024; ldw = NIN; src0 = 1544; nblk = 128; wo = W_IN; dst0 = 1536; }
        else if ((r -= I_B) < I_C) { W = pp->in[5] + (size_t)l * 1024 * NIN; K = 1024; ldw = NIN; src0 = 5648; nblk = 96; wo = W_IN; dst0 = 5632; }
        else if ((r -= I_C) < I_BR) { W = pp->in[18] + (size_t)l * 524288; K = 1536; ldw = 1024; nblk = 32; wo = W_BR; }
        else if ((r -= I_BR) < I_BR) { W = pp->in[19] + (size_t)l * 524288; K = 1536; ldw = 1024; nblk = 32; wo = W_BR + 512; }
        else if ((r -= I_BR) < I_BR) { W = pp->in[20] + (size_t)l * 524288; K = 1536; ldw = 1024; nblk = 32; wo = W_BR + 1024; }
        else if ((r -= I_BR) < I_O) { W = pp->in[21] + (size_t)l * 1048576; K = 1024; ldw = 1024; nblk = 32; wo = W_OUT; }
        else if ((r -= I_O) < I_U) { const int kb_ = r / 176, c_ = 32 * (r % 176);
            W = pp->in[23] + (size_t)l * 1024 * FF2; K = 1024; ldw = FF2; src0 = c_; nblk = 1; wo = W_UP; r = kb_;
            dst0 = c_ < FF ? 256 * (c_ >> 7) + (c_ & 127) : 256 * ((c_ - FF) >> 7) + 128 + ((c_ - FF) & 127); }
        else { r -= I_U; W = pp->in[26] + (size_t)l * FF * 1024; K = FF; ldw = 1024; nblk = 32; wo = W_DN; }
        tr_item(W, K, ldw, src0, nblk, WL + wo, dst0, scr, r, lane);
    }
    {
        const int gt = bid_opaque() * 512 + tid, NT = grid_opaque() * 512;
        for (int e = gt; e < 2 * 16 * 1024; e += NT) {
            const int l = e >> 14, r = (e >> 10) & 15, k = e & 1023;
            const int src = r < 8 ? 1536 + r : 5640 + (r - 8);
            bf16* WL = (bf16*)(p->ws + WS_W) + (size_t)l * W_LAYER;
            WL[W_IN + (size_t)(C_SMALL + r) * 1024 + k] = (bf16)pk1(p->in[5][(size_t)l * 1024 * NIN + (size_t)k * NIN + src]);
        }
    }
    __syncthreads();
    LAS float* cact = (LAS float*)lds;
    LAS float* part = (LAS float*)(lds + 65536);
    bool loaded = false;
    for (int it = bid_opaque(); it < 192; it += grid_opaque()) {
        if (!loaded) { for (int e = tid; e < 16384; e += 512) cact[e] = silu_f(p->in[1][e]); loaded = true; }
        __syncthreads();
        const int l = it / 96, n0 = (it % 96) * 64;
        const float* W = p->in[2] + (size_t)l * 1024 * 6144 + n0 + lane;
        float acc[16];
#pragma unroll
        for (int b = 0; b < 16; ++b) acc[b] = 0.f;
        for (int k16 = 0; k16 < 8; ++k16) {
            const int kb_ = wave * 128 + k16 * 16;
            float wr_[16];
#pragma unroll
            for (int i = 0; i < 16; ++i) wr_[i] = W[(size_t)(kb_ + i) * 6144];
#pragma unroll
            for (int q = 0; q < 4; ++q)
#pragma unroll
                for (int b = 0; b < 16; ++b) { const f32x4 cv = *(const LAS f32x4*)(cact + b * 1024 + kb_ + 4 * q); acc[b] += cv[0] * wr_[4 * q] + cv[1] * wr_[4 * q + 1] + cv[2] * wr_[4 * q + 2] + cv[3] * wr_[4 * q + 3]; }
        }
#pragma unroll
        for (int b = 0; b < 16; ++b) part[(wave * 16 + b) * 64 + lane] = acc[b];
        __syncthreads();
        for (int e = tid; e < 1024; e += 512) { const int b = e >> 6, j = e & 63; float s = 0.f;
#pragma unroll
            for (int w = 0; w < 8; ++w) s += part[(w * 16 + b) * 64 + j];
            ((float*)(p->ws + WS_MOD))[(size_t)(l * 16 + b) * 6144 + n0 + j] = s + p->in[3][(size_t)l * 6144 + n0 + j]; }
    }
}

__device__ __forceinline__ void norm_mod_phase(const float* src  , int row_base, const float* nw, const float* shift, const float* scale, bf16* dst, const bf16* wsmall  , float* smout  ) {
    const int tid_ = tid_opaque(), lane = tid_ & 63, wave = __builtin_amdgcn_readfirstlane(tid_ >> 6);
    const int gw = bid_opaque() * 8 + wave, NGW = grid_opaque() * 8;
    const int rpw = (MH + NGW - 1) / NGW, r0 = gw * rpw, r1 = r0 + rpw < MH ? r0 + rpw : MH;
    if (r0 >= r1) return;
    f32x4 wm[4], sh[4]; int bcur = -1;
    f32x4 v[4], vn[4];
    { const f32x4* xr = (const f32x4*)(src + (size_t)r0 * 1024) + lane;
#pragma unroll
      for (int j = 0; j < 4; ++j) vn[j] = xr[64 * j]; }
    for (int r = r0; r < r1; ++r) {
#pragma unroll
        for (int j = 0; j < 4; ++j) v[j] = vn[j];
        if (r + 1 < r1) { const f32x4* xr = (const f32x4*)(src + (size_t)(r + 1) * 1024) + lane;
#pragma unroll
            for (int j = 0; j < 4; ++j) vn[j] = xr[64 * j]; }
        const int b = (row_base + r) / SEQ;
        if (b != bcur) { bcur = b;
            f32x4 t0[4], t1[4];
#pragma unroll
            for (int j = 0; j < 4; ++j) { const int c = 4 * lane + 256 * j; t0[j] = *(const f32x4*)(nw + c); t1[j] = *(const f32x4*)(scale + (size_t)b * 6144 + c); sh[j] = *(const f32x4*)(shift + (size_t)b * 6144 + c); }
#pragma unroll
            for (int j = 0; j < 4; ++j) wm[j] = t0[j] * (t1[j] + 1.f); }
        float s = 0.f;
#pragma unroll
        for (int j = 0; j < 4; ++j) s += (v[j][0] * v[j][0] + v[j][1] * v[j][1]) + (v[j][2] * v[j][2] + v[j][3] * v[j][3]);
        const float rstd = rsqrtf(wave_sum(s) * (1.f / 1024.f) + EPS);
        u32x2* o8 = (u32x2*)(dst + (size_t)r * 1024) + lane;
#pragma unroll
        for (int j = 0; j < 4; ++j) { const f32x4 y = v[j] * rstd * wm[j] + sh[j]; u32x2 o; o.x = pk2(y[0], y[1]); o.y = pk2(y[2], y[3]); o8[64 * j] = o; }
    }
    if (wsmall != nullptr && rpw == 16) {
        asm volatile("s_waitcnt vmcnt(0)" ::: "memory");
        const int r16 = lane & 15, q4 = lane >> 4;
        const bf16* ap = dst + (size_t)(r0 + r16) * 1024 + q4 * 8; const bf16* bp = wsmall + (size_t)r16 * 1024 + q4 * 8;
        f32x4 acc = (f32x4){0.f, 0.f, 0.f, 0.f};
#pragma unroll 1
        for (int kb = 0; kb < 4; ++kb) {
            bf16x8 af[8], bfr[8];
#pragma unroll
            for (int i = 0; i < 8; ++i) { af[i] = *(const bf16x8*)(ap + (kb * 8 + i) * 32); bfr[i] = *(const bf16x8*)(bp + (kb * 8 + i) * 32); }
#pragma unroll
            for (int i = 0; i < 8; ++i) acc = __builtin_amdgcn_mfma_f32_16x16x32_bf16(af[i], bfr[i], acc, 0, 0, 0);
        }
#pragma unroll
        for (int j = 0; j < 4; ++j) smout[(size_t)(r0 + 4 * q4 + j) * 16 + r16] = acc[j];
    }
}

#define LBAR() do { asm volatile("s_waitcnt lgkmcnt(0)" ::: "memory"); __builtin_amdgcn_s_barrier(); asm volatile("" ::: "memory"); } while (0)

constexpr int HG_QS = 0, HG_KS = 17408, HG_QG = 34816, HG_KET = 52224, HG_GEND = 68608, HG_VT = 70656, HG_SB = 89088, HG_END = 123904;
static_assert(HG_END <= LDS_BYTES, "HGRN LDS map");
__device__ __forceinline__ bf16x8 mk_frag(unsigned a, unsigned b, unsigned c, unsigned d) { u32x4 u; u.x = a; u.y = b; u.z = c; u.w = d; return __builtin_bit_cast(bf16x8, u); }
__device__ __forceinline__ void hgrn_unit(KP p, int idx, int layer, LAS unsigned char* L0) {
    LAS unsigned char* L = lds_opaque(L0);
    const int tid = tid_opaque(), lane = tid & 63, wave = __builtin_amdgcn_readfirstlane(tid >> 6);
    const int bl = idx >> 3, h = (idx >> 1) & 3, dvh = idx & 1; const bool act = wave < 4; const int dvt = dvh * 4 + (wave & 3);
    const bf16* P = (const bf16*)(p->ws + WS_PROJ) + (size_t)bl * SEQ * NP;
    bf16* OR = (bf16*)(p->ws + WS_ORAW) + (size_t)bl * SEQ * OC + 512 + h * 128 + dvt * 16;
    const int pk = tid & 127, psub = tid >> 7;
    float lb = 0.f;
    if (layer == 1) { const float* lp = p->in[10]; lb = sigmoid_f(lp[512 + h * 128 + pk] - lp[h * 128 + pk]); }
    const int r16 = lane & 15, q4 = lane >> 4;
    f32x4 S[8];
#pragma unroll
    for (int i = 0; i < 8; ++i) S[i] = (f32x4){0.f, 0.f, 0.f, 0.f};
    { LAS unsigned char* SB = L + HG_SB + wave * 4352; for (int i = lane; i < 1088; i += 64) ((LAS unsigned*)SB)[i] = 0u; }
    unsigned rq[16], rf[16], rv[16];
    unsigned pq[8], pks[8], pqg[8], ke[8]; float gendv = 0.f;
#define HG_LOAD(mcx) do { if ((mcx) < 64) { const bf16* src_ = P + (size_t)((mcx) * 64 + psub * 16) * NP + h * 128 + pk; \
        _Pragma("unroll") for (int i = 0; i < 16; ++i) { rq[i] = src_[(size_t)i * NP + C_HQ]; rf[i] = src_[(size_t)i * NP + C_HF]; } \
        if (act) { const bf16* srv_ = P + (size_t)((mcx) * 64 + q4 * 16) * NP + C_HI + h * 128 + dvt * 16 + r16; \
            _Pragma("unroll") for (int i = 0; i < 16; ++i) rv[i] = srv_[(size_t)i * NP]; } } } while (0)
#define HG_COMPUTE() do { float qv[16], kv[16], G[16]; float run = 0.f; \
        _Pragma("unroll") for (int i = 0; i < 16; ++i) { const float qr = bf2f(rq[i]), fr = bf2f(rf[i]); const float sg = sigmoid_f(fr), f = lb + (1.f - lb) * sg; \
            run += __logf(f); G[i] = run; kv[i] = (1.f - lb) * (1.f - sg); qv[i] = silu_f(qr); } \
        const float Gref = G[7], Gend = G[15]; const float eref = __expf(Gref), c2 = __expf(Gend - Gref); \
        _Pragma("unroll") for (int i = 0; i < 8; ++i) { \
            const float e1a = __expf(G[2 * i] - Gref), r1a = __builtin_amdgcn_rcpf(e1a), e1b = __expf(G[2 * i + 1] - Gref), r1b = __builtin_amdgcn_rcpf(e1b); \
            pq[i] = pk2(qv[2 * i] * e1a, qv[2 * i + 1] * e1b); pks[i] = pk2(kv[2 * i] * r1a, kv[2 * i + 1] * r1b); \
            pqg[i] = pk2(qv[2 * i] * e1a * eref, qv[2 * i + 1] * e1b * eref); ke[i] = pk2(kv[2 * i] * r1a * c2, kv[2 * i + 1] * r1b * c2); } \
        gendv = __expf(Gend); } while (0)
#define HG_WRITE() do { _Pragma("unroll") for (int i = 0; i < 8; ++i) { const int t_ = psub * 16 + 2 * i; \
            *(LAS bf16*)(L + HG_QS + t_ * 272 + pk * 2) = (bf16)(pq[i] & 0xffffu); *(LAS bf16*)(L + HG_QS + (t_ + 1) * 272 + pk * 2) = (bf16)(pq[i] >> 16); \
            *(LAS bf16*)(L + HG_KS + t_ * 272 + pk * 2) = (bf16)(pks[i] & 0xffffu); *(LAS bf16*)(L + HG_KS + (t_ + 1) * 272 + pk * 2) = (bf16)(pks[i] >> 16); \
            *(LAS bf16*)(L + HG_QG + t_ * 272 + pk * 2) = (bf16)(pqg[i] & 0xffffu); *(LAS bf16*)(L + HG_QG + (t_ + 1) * 272 + pk * 2) = (bf16)(pqg[i] >> 16); } \
        LAS u32x4* kd_ = (LAS u32x4*)(L + HG_KET + (psub * 128 + pk) * 32); kd_[0] = (u32x4){ke[0], ke[1], ke[2], ke[3]}; kd_[1] = (u32x4){ke[4], ke[5], ke[6], ke[7]}; \
        *(LAS float*)(L + HG_GEND + (psub * 128 + pk) * 4) = gendv; } while (0)
    HG_LOAD(0);
    if (!act) { HG_COMPUTE(); HG_LOAD(1); }
    for (int mc = 0; mc < 64; ++mc) {
        L = lds_opaque(L0);
        LAS unsigned char* VT = L + HG_VT + wave * 2304;
        LAS unsigned char* SB = L + HG_SB + wave * 4352;
        LBAR();
        if (act) {
            HG_COMPUTE(); HG_WRITE();
            {
                unsigned w[8];
#pragma unroll
                for (int i = 0; i < 8; ++i) w[i] = rv[2 * i] | (rv[2 * i + 1] << 16);
                LAS u32x4* vd = (LAS u32x4*)(VT + r16 * 144 + q4 * 32);
                vd[0] = (u32x4){w[0], w[1], w[2], w[3]}; vd[1] = (u32x4){w[4], w[5], w[6], w[7]};
            }
            HG_LOAD(mc + 1);
        } else {
            HG_WRITE();
        }
        LBAR();
        if (!act) { if (mc + 1 < 64) { HG_COMPUTE(); HG_LOAD(mc + 2); } }
        else
#pragma unroll 1
        for (int sb = 0; sb < 4; ++sb) {
            const int t0 = sb * 16;
            f32x4 sc = (f32x4){0.f, 0.f, 0.f, 0.f};
#pragma unroll
            for (int kk = 0; kk < 4; ++kk) {
                const bf16x8 a = *(const LAS bf16x8*)(L + HG_KS + (t0 + r16) * 272 + kk * 64 + q4 * 16);
                const bf16x8 b = *(const LAS bf16x8*)(L + HG_QS + (t0 + r16) * 272 + kk * 64 + q4 * 16);
                sc = __builtin_amdgcn_mfma_f32_16x16x32_bf16(a, b, sc, 0, 0, 0);
            }
#pragma unroll
            for (int j = 0; j < 4; ++j) if (4 * q4 + j > r16) sc[j] = 0.f;
            const bf16x8 a2 = mk_frag(pk2(sc[0], sc[1]), pk2(sc[2], sc[3]), 0u, 0u);
            const u32x2 vv = *(const LAS u32x2*)(VT + r16 * 144 + (t0 + 4 * q4) * 2);
            const bf16x8 b2 = mk_frag(vv.x, vv.y, 0u, 0u);
            f32x4 o = __builtin_amdgcn_mfma_f32_16x16x32_bf16(a2, b2, (f32x4){0.f, 0.f, 0.f, 0.f}, 0, 0, 0);
#pragma unroll
            for (int kk = 0; kk < 4; ++kk) {
                const bf16x8 a = *(const LAS bf16x8*)(L + HG_QG + (t0 + r16) * 272 + kk * 64 + q4 * 16);
                const bf16x8 b = *(const LAS bf16x8*)(SB + r16 * 272 + kk * 64 + q4 * 16);
                o = __builtin_amdgcn_mfma_f32_16x16x32_bf16(a, b, o, 0, 0, 0);
            }
            bf16* orow = OR + (size_t)(mc * 64 + t0 + 4 * q4) * OC + r16;
#pragma unroll
            for (int j = 0; j < 4; ++j) orow[(size_t)j * OC] = (bf16)pk1(o[j]);
#pragma unroll
            for (int kt = 0; kt < 8; ++kt) {
                const u32x2 ke = *(const LAS u32x2*)(L + HG_KET + (sb * 128 + kt * 16 + r16) * 32 + q4 * 8);
                const f32x4 ge = *(const LAS f32x4*)(L + HG_GEND + (sb * 128 + kt * 16 + 4 * q4) * 4);
                S[kt] = __builtin_amdgcn_mfma_f32_16x16x32_bf16(mk_frag(ke.x, ke.y, 0u, 0u), b2, S[kt] * ge, 0, 0, 0);
                *(LAS u32x2*)(SB + r16 * 272 + (kt * 16 + 4 * q4) * 2) = (u32x2){pk2(S[kt][0], S[kt][1]), pk2(S[kt][2], S[kt][3])};
            }
        }
    }
    LBAR();
}


#undef HG_LOAD
#undef HG_COMPUTE
#undef HG_WRITE
constexpr int SD_CS = 0, SD_BS = 17408, SD_BT = 34816, SD_CBS = 53248  , SD_SC = SD_CBS + 2 * 9216, SD_PRIV = SD_SC + 1024, SD_PRIV_SZ = 8960, SD_END = SD_PRIV + 8 * SD_PRIV_SZ;
static_assert(SD_END <= LDS_BYTES, "SSD LDS map");
__device__ __forceinline__ void ssd_unit(KP p, int idx, int layer, LAS unsigned char* L0) {
    LAS unsigned char* L = lds_opaque(L0);
    const int tid = tid_opaque(), lane = tid & 63, wave = __builtin_amdgcn_readfirstlane(tid >> 6);
    const int r16 = lane & 15, q4 = lane >> 4;
    const int bl = idx >> 3, head = idx & 7, g = head >> 2;
    const int hh = 0, pt = wave & 3; const bool act = wave < 4;
    const bf16* P = (const bf16*)(p->ws + WS_PROJ) + (size_t)bl * SEQ * NP;
    const float* SM = (const float*)(p->ws + WS_SM) + (size_t)bl * SEQ * 16;
    bf16* OR = (bf16*)(p->ws + WS_ORAW) + (size_t)bl * SEQ * OC + 1024 + head * 64 + pt * 16;
    const int pc = tid & 255, phalf = tid >> 8, pn = pc & 127; const bool isB = pc >= 128;
    const int xi = (isB ? 512 : 768) + g * 128 + pn;
    const float* cwp = p->in[12] + (size_t)layer * 4096; const float* cbp = p->in[13] + (size_t)layer * 1024;
    const float cw0 = cwp[xi], cw1 = cwp[1024 + xi], cw2 = cwp[2048 + xi], cw3 = cwp[3072 + xi], cb = cbp[xi];
    const int xp = head * 64 + pt * 16 + r16;
    const float xw0 = cwp[xp], xw1 = cwp[1024 + xp], xw2 = cwp[2048 + xp], xw3 = cwp[3072 + xp], xb_ = cbp[xp];
    const float A_h = -__expf(p->in[14][layer * 8 + head]), dtb = p->in[15][layer * 8 + head], Dh = p->in[16][layer * 8 + head];
    f32x4 H[8];
#pragma unroll
    for (int i = 0; i < 8; ++i) H[i] = (f32x4){0.f, 0.f, 0.f, 0.f};
    { LAS unsigned char* HB = L + SD_PRIV + wave * SD_PRIV_SZ + 4608; for (int i = lane; i < 1088; i += 64) ((LAS unsigned*)HB)[i] = 0u; }
    unsigned rs[35], rx[19];
    {
        const bf16* src = P + (size_t)(phalf * 32) * NP + C_XBC + xi;
#pragma unroll
        for (int i = 0; i < 35; ++i) rs[i] = (phalf * 32 - 3 + i >= 0) ? (unsigned)src[(long)(i - 3) * NP] : 0u;
        const bf16* srx = P + (size_t)(q4 * 16) * NP + C_XBC + xp;
#pragma unroll
        for (int i = 0; i < 19; ++i) rx[i] = (act && q4 * 16 - 3 + i >= 0) ? (unsigned)srx[(long)(i - 3) * NP] : 0u;
    }
    for (int c = 0; c < 64; ++c) {
        L = lds_opaque(L0);
        LAS unsigned char* XT = L + SD_PRIV + wave * SD_PRIV_SZ; LAS unsigned char* XDT = XT + 2304; LAS unsigned char* HB = XT + 4608;
        LAS float* ACS = (LAS float*)(L + SD_SC) + hh * 64; LAS float* DT = (LAS float*)(L + SD_SC) + 128 + hh * 64;
        LBAR();
        {
            float x[35];
#pragma unroll
            for (int i = 0; i < 35; ++i) x[i] = bf2f(rs[i]);
            unsigned pkd[16]; unsigned lo = 0;
            LAS unsigned char* dst = L + (isB ? SD_BS : SD_CS) + (phalf * 32) * 272 + pn * 2;
#pragma unroll
            for (int j = 0; j < 32; ++j) {
                const unsigned b = f2bf(silu_f(cw0 * x[j] + cw1 * x[j + 1] + cw2 * x[j + 2] + cw3 * x[j + 3] + cb));
                *(LAS bf16*)(dst + j * 272) = (bf16)b;
                if (j & 1) pkd[j >> 1] = lo | (b << 16); else lo = b;
            }
            if (isB) { LAS u32x4* bt = (LAS u32x4*)(L + SD_BT + pn * 144 + phalf * 64);
#pragma unroll
                for (int i = 0; i < 4; ++i) bt[i] = (u32x4){pkd[4 * i], pkd[4 * i + 1], pkd[4 * i + 2], pkd[4 * i + 3]}; }
        }
        if (wave == 0) {
            const float dtv = softplus_f(SM[(size_t)(c * 64 + lane) * 16 + 8 + head] + dtb);
            const float v = wave_scan_incl(dtv * A_h, lane);
            ACS[lane] = v; DT[lane] = dtv;
        }
        float xv[16];
        if (act) {
            float x[19];
#pragma unroll
            for (int i = 0; i < 19; ++i) x[i] = bf2f(rx[i]);
#pragma unroll
            for (int j = 0; j < 16; ++j) xv[j] = silu_f(xw0 * x[j] + xw1 * x[j + 1] + xw2 * x[j + 2] + xw3 * x[j + 3] + xb_);
        }
        if (c + 1 < 64) {
            const bf16* src = P + (size_t)((c + 1) * 64 + phalf * 32) * NP + C_XBC + xi;
#pragma unroll
            for (int i = 0; i < 35; ++i) rs[i] = src[(long)(i - 3) * NP];
            if (act) { const bf16* srx = P + (size_t)((c + 1) * 64 + q4 * 16) * NP + C_XBC + xp;
#pragma unroll
                for (int i = 0; i < 19; ++i) rx[i] = srx[(long)(i - 3) * NP]; }
        }
        LBAR();
        if (act) {
            unsigned a[8], b[8];
#pragma unroll
            for (int i = 0; i < 4; ++i) { const f32x4 d = *(const LAS f32x4*)(DT + q4 * 16 + 4 * i);
                a[2 * i] = pk2(xv[4 * i], xv[4 * i + 1]); a[2 * i + 1] = pk2(xv[4 * i + 2], xv[4 * i + 3]);
                b[2 * i] = pk2(xv[4 * i] * d[0], xv[4 * i + 1] * d[1]); b[2 * i + 1] = pk2(xv[4 * i + 2] * d[2], xv[4 * i + 3] * d[3]); }
            LAS u32x4* xd = (LAS u32x4*)(XT + r16 * 144 + q4 * 32); xd[0] = (u32x4){a[0], a[1], a[2], a[3]}; xd[1] = (u32x4){a[4], a[5], a[6], a[7]};
            LAS u32x4* yd = (LAS u32x4*)(XDT + r16 * 144 + q4 * 32); yd[0] = (u32x4){b[0], b[1], b[2], b[3]}; yd[1] = (u32x4){b[4], b[5], b[6], b[7]};
        }
        {
            const int tl = wave & 3;
            const LAS float* AC0 = (const LAS float*)(L + SD_SC);
            const f32x4 al0 = *(const LAS f32x4*)(AC0 + 16 * tl + 4 * q4);
#pragma unroll
            for (int u = 0; u < 2; ++u) { const int ts = 2 * (wave >> 2) + u;
                f32x4 acc = (f32x4){0.f, 0.f, 0.f, 0.f};
#pragma unroll
                for (int kk = 0; kk < 4; ++kk) {
                    const bf16x8 a = *(const LAS bf16x8*)(L + SD_CS + (16 * tl + r16) * 272 + kk * 64 + q4 * 16);
                    const bf16x8 b = *(const LAS bf16x8*)(L + SD_BS + (16 * ts + r16) * 272 + kk * 64 + q4 * 16);
                    acc = __builtin_amdgcn_mfma_f32_16x16x32_bf16(a, b, acc, 0, 0, 0);
                }
                const int sidx = 16 * ts + r16; const float as0 = AC0[sidx];
#pragma unroll
                for (int j = 0; j < 4; ++j) { const int l = 16 * tl + 4 * q4 + j;
                    *(LAS bf16*)(L + SD_CBS + l * 144 + sidx * 2) = (bf16)pk1(sidx <= l ? acc[j] * __expf(fminf(al0[j] - as0, 0.f)) : 0.f); }
            }
        }
        LBAR();
        if (act) {
        const float acs_last = ACS[63];
        const bf16x8 xb0 = *(const LAS bf16x8*)(XDT + r16 * 144 + q4 * 16), xb1 = *(const LAS bf16x8*)(XDT + r16 * 144 + 64 + q4 * 16);
#pragma unroll 1
        for (int tl = 0; tl < 4; ++tl) {
            f32x4 acc = (f32x4){0.f, 0.f, 0.f, 0.f};
#pragma unroll
            for (int kk = 0; kk < 4; ++kk) {
                const bf16x8 a = *(const LAS bf16x8*)(L + SD_CS + (16 * tl + r16) * 272 + kk * 64 + q4 * 16);
                const bf16x8 b = *(const LAS bf16x8*)(HB + r16 * 272 + kk * 64 + q4 * 16);
                acc = __builtin_amdgcn_mfma_f32_16x16x32_bf16(a, b, acc, 0, 0, 0);
            }
            const f32x4 al = *(const LAS f32x4*)(ACS + 16 * tl + 4 * q4);
#pragma unroll
            for (int j = 0; j < 4; ++j) acc[j] *= __expf(al[j]);
            acc = __builtin_amdgcn_mfma_f32_16x16x32_bf16(*(const LAS bf16x8*)(L + SD_CBS + hh * 9216 + (16 * tl + r16) * 144 + q4 * 16), xb0, acc, 0, 0, 0);
            if (tl >= 2) acc = __builtin_amdgcn_mfma_f32_16x16x32_bf16(*(const LAS bf16x8*)(L + SD_CBS + hh * 9216 + (16 * tl + r16) * 144 + 64 + q4 * 16), xb1, acc, 0, 0, 0);
            const u32x2 xs = *(const LAS u32x2*)(XT + r16 * 144 + (16 * tl + 4 * q4) * 2);
            acc[0] += Dh * bflo(xs.x); acc[1] += Dh * bfhi(xs.x); acc[2] += Dh * bflo(xs.y); acc[3] += Dh * bfhi(xs.y);
            bf16* orow = OR + (size_t)(c * 64 + 16 * tl + 4 * q4) * OC + r16;
#pragma unroll
            for (int j = 0; j < 4; ++j) orow[(size_t)j * OC] = (bf16)pk1(acc[j]);
        }
        {
            bf16x8 xe[2];
#pragma unroll
            for (int kk = 0; kk < 2; ++kk) {
                const u32x4 xw = __builtin_bit_cast(u32x4, kk == 0 ? xb0 : xb1);
                const f32x4 s0 = *(const LAS f32x4*)(ACS + kk * 32 + 8 * q4), s1 = *(const LAS f32x4*)(ACS + kk * 32 + 8 * q4 + 4);
                float v[8];
                v[0] = bflo(xw.x); v[1] = bfhi(xw.x); v[2] = bflo(xw.y); v[3] = bfhi(xw.y); v[4] = bflo(xw.z); v[5] = bfhi(xw.z); v[6] = bflo(xw.w); v[7] = bfhi(xw.w);
#pragma unroll
                for (int e = 0; e < 8; ++e) { const float as = e < 4 ? s0[e & 3] : s1[e & 3]; v[e] *= __expf(acs_last - as); }
                xe[kk] = mk_frag(pk2(v[0], v[1]), pk2(v[2], v[3]), pk2(v[4], v[5]), pk2(v[6], v[7]));
            }
            const float eh = __expf(acs_last);
#pragma unroll
            for (int nt = 0; nt < 8; ++nt) {
                H[nt] = H[nt] * eh;
#pragma unroll
                for (int kk = 0; kk < 2; ++kk) {
                    const bf16x8 a = *(const LAS bf16x8*)(L + SD_BT + (16 * nt + r16) * 144 + kk * 64 + q4 * 16);
                    H[nt] = __builtin_amdgcn_mfma_f32_16x16x32_bf16(a, xe[kk], H[nt], 0, 0, 0);
                }
                *(LAS u32x2*)(HB + r16 * 272 + (16 * nt + 4 * q4) * 2) = (u32x2){pk2(H[nt][0], H[nt][1]), pk2(H[nt][2], H[nt][3])};
            }
        }
        }
    }
    LBAR();
}


constexpr int GD_QN = 0, GD_KN = 17408, GD_VN = 34816, GD_MT = 52224, GD_KET = 68608, GD_SC = 87040, GD_PRIV = 88064, GD_PRIV_SZ = 6656, GD_WL = GD_PRIV + 8 * GD_PRIV_SZ, GD_END = GD_WL + 6144;
static_assert(GD_END <= LDS_BYTES, "GDN LDS map");
typedef float f32x2 __attribute__((ext_vector_type(2)));
__device__ __forceinline__ float red8(float v) { v += dppf<0xB1>(v); v += dppf<0x4E>(v); v += dppf<0x141>(v); return v; }
__device__ __forceinline__ float bfel(const u32x4& a, const u32x4& b, int c) { const u32x4& v = (c < 8) ? a : b; const unsigned w = v[(c & 7) >> 1]; return (c & 1) ? bfhi(w) : bflo(w); }
constexpr size_t AUXA_UNIT = 32768, AUXB_UNIT = 40960;
constexpr size_t WS_GE = 920 * 1024;
constexpr int GCNT_WORD = 3648;
constexpr int GCNT_UNUSED = 3584;
__device__ __forceinline__ void gdn1_load_rows(KP p, int u, u32x4 (&xr)[3][4][2]) {
    const int tid0 = tid_opaque(); const int bl = u >> 8, h = (u >> 6) & 3, c = u & 63, t = tid0 >> 3;
    const bf16* Pu = (const bf16*)(p->ws + WS_PROJ) + (size_t)bl * SEQ * NP + h * 128 + (tid0 & 7) * 16;
#pragma unroll
    for (int mat = 0; mat < 3; ++mat)
#pragma unroll
        for (int i = 0; i < 4; ++i) {
            if (c * 64 + t - 3 + i >= 0) { const bf16* src = Pu + (long)(c * 64 + t - 3 + i) * NP + mat * 512; xr[mat][i][0] = *(const u32x4*)src; xr[mat][i][1] = *(const u32x4*)(src + 8); }
            else { xr[mat][i][0] = (u32x4){0u, 0u, 0u, 0u}; xr[mat][i][1] = (u32x4){0u, 0u, 0u, 0u}; }
        }
}
__device__ __forceinline__ void gdn1_unit(KP p, int u, int layer, LAS unsigned char* L0, u32x4 (&xr)[3][4][2], bool load_w, int u_next) {
    LAS unsigned char* L = lds_opaque(L0);
    const int tid0 = tid_opaque(), wave = __builtin_amdgcn_readfirstlane(tid0 >> 6);
    const int bl = u >> 8, h = (u >> 6) & 3, c = u & 63;
    const float sA = __builtin_bit_cast(float, __builtin_amdgcn_readfirstlane(__builtin_bit_cast(int, -__expf(p->in[7][layer * 4 + h])))), sB = __builtin_bit_cast(float, __builtin_amdgcn_readfirstlane(__builtin_bit_cast(int, p->in[8][layer * 4 + h])));
    LBAR();
    if (load_w) {
        const float* cwp = p->in[6] + (size_t)layer * 4 * 1536;
        for (int e = tid0; e < 1536; e += 512) { const int mat = e >> 9, k = (e >> 7) & 3, col = e & 127; *(LAS float*)(L + GD_WL + e * 4) = cwp[k * 1536 + mat * 512 + h * 128 + col]; }
        LBAR();
    }
    {
        LAS float* GC = (LAS float*)(L + GD_SC); LAS float* BETA = GC + 64;
        {
            const int tid = tid_opaque();
            const int t = tid >> 3, seg = tid & 7;
#pragma unroll
            for (int mat = 0; mat < 3; ++mat) {
                float y[16]; float ss = 0.f;
#pragma unroll
                for (int cg = 0; cg < 4; ++cg) {
                    const LAS float* wl = (const LAS float*)(L + GD_WL) + mat * 512 + seg * 16 + 4 * cg;
                    const f32x4 w0 = *(const LAS f32x4*)(wl), w1 = *(const LAS f32x4*)(wl + 128), w2 = *(const LAS f32x4*)(wl + 256), w3 = *(const LAS f32x4*)(wl + 384);
#pragma unroll
                    for (int e = 0; e < 4; ++e) { const int ci = 4 * cg + e;
                        const float v = silu_f(w0[e] * bfel(xr[mat][0][0], xr[mat][0][1], ci) + w1[e] * bfel(xr[mat][1][0], xr[mat][1][1], ci) + w2[e] * bfel(xr[mat][2][0], xr[mat][2][1], ci) + w3[e] * bfel(xr[mat][3][0], xr[mat][3][1], ci));
                        y[ci] = v; ss += v * v; }
                }
                float r = 1.f;
                if (mat < 2) { ss = red8(ss); r = rsqrtf(ss + EPS) * (mat == 0 ? 0.08838834764831845f : 1.f); }
                LAS u32x4* d = (LAS u32x4*)(L + (mat == 0 ? GD_QN : mat == 1 ? GD_KN : GD_VN) + t * 272 + seg * 32);
                d[0] = (u32x4){pk2(y[0] * r, y[1] * r), pk2(y[2] * r, y[3] * r), pk2(y[4] * r, y[5] * r), pk2(y[6] * r, y[7] * r)};
                d[1] = (u32x4){pk2(y[8] * r, y[9] * r), pk2(y[10] * r, y[11] * r), pk2(y[12] * r, y[13] * r), pk2(y[14] * r, y[15] * r)};
            }
        }
        if (wave == 0) {
            const int tid = tid_opaque(), lane = tid & 63, r16 = lane & 15, q4 = lane >> 4; (void)r16; (void)q4; (void)lane;
            KP pp = kparams(); const float* sm = (const float*)(pp->ws + WS_SM) + ((size_t)bl * SEQ + c * 64 + lane) * 16;
            const float v = wave_scan_incl(sA * softplus_f(sm[h] + sB), lane);
            GC[lane] = v; BETA[lane] = sigmoid_f(sm[4 + h]);
        }
        LBAR();
        f32x4 at[2];
        {
            const int tid = tid_opaque(), lane = tid & 63, r16 = lane & 15, q4 = lane >> 4; (void)r16; (void)q4; (void)lane;
            const int tl = wave & 3;
            const f32x4 gl = *(const LAS f32x4*)(GC + 16 * tl + 4 * q4), bl4 = *(const LAS f32x4*)(BETA + 16 * tl + 4 * q4);
#pragma unroll
            for (int u = 0; u < 2; ++u) { const int ts = 2 * (wave >> 2) + u;
                f32x4 kk = (f32x4){0.f, 0.f, 0.f, 0.f}, qk = (f32x4){0.f, 0.f, 0.f, 0.f};
#pragma unroll
                for (int k4 = 0; k4 < 4; ++k4) {
                    const bf16x8 b = *(const LAS bf16x8*)(L + GD_KN + (16 * ts + r16) * 272 + k4 * 64 + q4 * 16);
                    const bf16x8 ak = *(const LAS bf16x8*)(L + GD_KN + (16 * tl + r16) * 272 + k4 * 64 + q4 * 16);
                    const bf16x8 aq = *(const LAS bf16x8*)(L + GD_QN + (16 * tl + r16) * 272 + k4 * 64 + q4 * 16);
                    kk = __builtin_amdgcn_mfma_f32_16x16x32_bf16(ak, b, kk, 0, 0, 0);
                    qk = __builtin_amdgcn_mfma_f32_16x16x32_bf16(aq, b, qk, 0, 0, 0);
                }
                const int sidx = 16 * ts + r16; const float gs = GC[sidx];
                f32x4 m;
#pragma unroll
                for (int j = 0; j < 4; ++j) { const int l = 16 * tl + 4 * q4 + j; const float dec = __expf(fminf(gl[j] - gs, 0.f));
                    m[j] = (sidx < l) ? bl4[j] * kk[j] * dec : 0.f; qk[j] = (sidx <= l) ? qk[j] * dec : 0.f; }
                *(LAS f32x4*)(L + GD_MT + sidx * 256 + (16 * tl + 4 * q4) * 4) = m;
                at[u] = qk;
            }
        }
        LBAR();
        f32x2 acc2[32];
        if (wave < 4) {
            const int tid = tid_opaque(), lane = tid & 63, r16 = lane & 15, q4 = lane >> 4; (void)r16; (void)q4; (void)lane;
            const LAS unsigned char* rb = L + (tid < 128 ? GD_VN : GD_KN) + (tid & 127) * 2;
#pragma unroll
            for (int l4 = 0; l4 < 16; ++l4) {
                const f32x4 b4 = *(const LAS f32x4*)(BETA + 4 * l4); f32x4 g4 = (f32x4){1.f, 1.f, 1.f, 1.f};
                if (tid >= 128) { const f32x4 gg = *(const LAS f32x4*)(GC + 4 * l4); g4 = (f32x4){__expf(gg[0]), __expf(gg[1]), __expf(gg[2]), __expf(gg[3])}; }
                acc2[2 * l4] = (f32x2){bf2f(*(const LAS bf16*)(rb + (4 * l4) * 272)) * b4[0] * g4[0], bf2f(*(const LAS bf16*)(rb + (4 * l4 + 1) * 272)) * b4[1] * g4[1]};
                acc2[2 * l4 + 1] = (f32x2){bf2f(*(const LAS bf16*)(rb + (4 * l4 + 2) * 272)) * b4[2] * g4[2], bf2f(*(const LAS bf16*)(rb + (4 * l4 + 3) * 272)) * b4[3] * g4[3]};
            }
#pragma unroll
            for (int s_ = 0; s_ < 63; ++s_) {
                const float xs = (s_ & 1) ? acc2[s_ >> 1][1] : acc2[s_ >> 1][0]; const f32x2 xs2 = (f32x2){xs, xs};
#pragma unroll
                for (int l4 = ((s_ + 1) >> 2) << 2; l4 < 64; l4 += 4) {
                    const f32x4 m = *(const LAS f32x4*)(L + GD_MT + s_ * 256 + l4 * 4);
                    acc2[l4 >> 1] -= (f32x2){m[0], m[1]} * xs2;
                    acc2[(l4 >> 1) + 1] -= (f32x2){m[2], m[3]} * xs2;
                }
            }
        } else {
            const int tid = tid_opaque(), lane = tid & 63, r16 = lane & 15, q4 = lane >> 4; (void)r16; (void)q4; (void)lane;
            const int tt = tid - 256, t = tt >> 2, sg = tt & 3;
            const float gt = GC[t]; const float eg = __expf(gt), ee = __expf(GC[63] - gt);
            LAS u32x4* qp = (LAS u32x4*)(L + GD_QN + t * 272 + sg * 64);
            const LAS u32x4* kp = (const LAS u32x4*)(L + GD_KN + t * 272 + sg * 64);
#pragma unroll
            for (int i = 0; i < 4; ++i) {
                const u32x4 w = qp[i];
                qp[i] = (u32x4){pk2(bflo(w.x) * eg, bfhi(w.x) * eg), pk2(bflo(w.y) * eg, bfhi(w.y) * eg), pk2(bflo(w.z) * eg, bfhi(w.z) * eg), pk2(bflo(w.w) * eg, bfhi(w.w) * eg)};
                const u32x4 kw = kp[i];
                LAS unsigned char* kd = L + GD_KET + (sg * 32 + i * 8) * 144 + t * 2;
                *(LAS bf16*)(kd + 0 * 144) = (bf16)pk1(bflo(kw.x) * ee); *(LAS bf16*)(kd + 1 * 144) = (bf16)pk1(bfhi(kw.x) * ee);
                *(LAS bf16*)(kd + 2 * 144) = (bf16)pk1(bflo(kw.y) * ee); *(LAS bf16*)(kd + 3 * 144) = (bf16)pk1(bfhi(kw.y) * ee);
                *(LAS bf16*)(kd + 4 * 144) = (bf16)pk1(bflo(kw.z) * ee); *(LAS bf16*)(kd + 5 * 144) = (bf16)pk1(bfhi(kw.z) * ee);
                *(LAS bf16*)(kd + 6 * 144) = (bf16)pk1(bflo(kw.w) * ee); *(LAS bf16*)(kd + 7 * 144) = (bf16)pk1(bfhi(kw.w) * ee);
            }
        }
        LBAR();
        if (wave < 2) {
            const int tid = tid_opaque(), lane = tid & 63, r16 = lane & 15, q4 = lane >> 4; (void)r16; (void)q4; (void)lane;
            LAS u32x2* ud = (LAS u32x2*)(L + GD_KN + tid * 136);
#pragma unroll
            for (int i = 0; i < 16; ++i) ud[i] = (u32x2){pk2(acc2[2 * i][0], acc2[2 * i][1]), pk2(acc2[2 * i + 1][0], acc2[2 * i + 1][1])};
        } else if (wave < 4) {
            const int tid = tid_opaque(), lane = tid & 63, r16 = lane & 15, q4 = lane >> 4; (void)r16; (void)q4; (void)lane;
            LAS unsigned char* wd = L + GD_VN + (tid - 128) * 2;
#pragma unroll
            for (int i = 0; i < 32; ++i) { *(LAS bf16*)(wd + (2 * i) * 272) = (bf16)pk1(acc2[i][0]); *(LAS bf16*)(wd + (2 * i + 1) * 272) = (bf16)pk1(acc2[i][1]); }
        }
        {
            const int tid = tid_opaque(), lane = tid & 63, r16 = lane & 15, q4 = lane >> 4; (void)r16; (void)q4; (void)lane;
            const int tl = wave & 3;
#pragma unroll
            for (int u = 0; u < 2; ++u) { const int ts = 2 * (wave >> 2) + u;
#pragma unroll
                for (int j = 0; j < 4; ++j) *(LAS bf16*)(L + GD_MT + (16 * tl + 4 * q4 + j) * 144 + (16 * ts + r16) * 2) = (bf16)pk1(at[u][j]); }
        }
        LBAR();
        {
            const int tid = tid_opaque();
            KP pp = kparams();
            const __amdgpu_buffer_rsrc_t ra_ = __builtin_amdgcn_make_buffer_rsrc((void*)(pp->ws + WS_H + (size_t)u * AUXA_UNIT), (short)0, (int)AUXA_UNIT, 0x00020000);
            const __amdgpu_buffer_rsrc_t rb_ = __builtin_amdgcn_make_buffer_rsrc((void*)(pp->ws + WS_OCAT + (size_t)u * AUXB_UNIT), (short)0, (int)AUXB_UNIT, 0x00020000);
#pragma unroll
            for (int k = 0; k < 2; ++k) { const int i = tid + 512 * k;
                __builtin_amdgcn_raw_buffer_store_b128(*(const LAS u32x4*)(L + GD_VN + (i >> 4) * 272 + (i & 15) * 16), ra_, i * 16, 0, 16);
                __builtin_amdgcn_raw_buffer_store_b128(*(const LAS u32x4*)(L + GD_QN + (i >> 4) * 272 + (i & 15) * 16), rb_, i * 16, 0, 16);
                __builtin_amdgcn_raw_buffer_store_b128(*(const LAS u32x4*)(L + GD_KET + (i >> 3) * 144 + (i & 7) * 16), rb_, 16384 + i * 16, 0, 16); }
#pragma unroll
            for (int k = 0; k < 4; ++k) { const int i = tid + 512 * k; __builtin_amdgcn_raw_buffer_store_b64(*(const LAS u32x2*)(L + GD_KN + (i >> 4) * 136 + (i & 15) * 8), ra_, 16384 + i * 8, 0, 16); }
            __builtin_amdgcn_raw_buffer_store_b128(*(const LAS u32x4*)(L + GD_MT + (tid >> 3) * 144 + (tid & 7) * 16), rb_, 32768 + tid * 16, 0, 16);
            if (tid == 0) __hip_atomic_store((float*)(pp->ws + WS_GE) + u, __expf(GC[63]), __ATOMIC_RELAXED, __HIP_MEMORY_SCOPE_AGENT);
            asm volatile("s_waitcnt vmcnt(0)" ::: "memory");
            __syncthreads();
            if (tid == 0) (void)__hip_atomic_fetch_add((unsigned*)(pp->ws + WS_BAR) + GCNT_WORD + c, 1u, __ATOMIC_RELAXED, __HIP_MEMORY_SCOPE_AGENT);
        }
    }
    gdn1_load_rows(kparams(), u_next, xr);
}
#define GDN2_ENSURE(cn) do { if ((cn) >= ready_upto) { const int hi_ = ready_upto + 8 < 64 ? ready_upto + 8 : 64; \
        if (tid_opaque() == 0) { unsigned* cnt_ = (unsigned*)(kparams()->ws + WS_BAR) + GCNT_WORD; unsigned sp_ = 0; \
            for (int cc_ = ready_upto; cc_ < hi_; ++cc_) while (__hip_atomic_load(cnt_ + cc_, __ATOMIC_RELAXED, __HIP_MEMORY_SCOPE_AGENT) < want) { __builtin_amdgcn_s_sleep(2); if (++sp_ > (1u << 24)) break; } \
            __builtin_amdgcn_fence(__ATOMIC_ACQUIRE, "agent"); asm volatile("s_waitcnt vmcnt(0)" ::: "memory"); } \
        __syncthreads(); ready_upto = hi_; } } while (0)
__device__ __forceinline__ void gdn2_unit(KP p, int idx, int layer, int pass, LAS unsigned char* L0) {
    const unsigned want = 32u * (unsigned)(pass + 1); int ready_upto = 0;
    LAS unsigned char* L = lds_opaque(L0);
    const int tid0 = tid_opaque(), wave = __builtin_amdgcn_readfirstlane(tid0 >> 6);
    const int bl = idx >> 2, h = idx & 3;
    { LAS unsigned char* SB = L + GD_PRIV + wave * GD_PRIV_SZ + 2304; for (int i = tid0 & 63; i < 1088; i += 64) ((LAS unsigned*)SB)[i] = 0u; }
    f32x4 S[8];
#pragma unroll
    for (int i = 0; i < 8; ++i) S[i] = (f32x4){0.f, 0.f, 0.f, 0.f};
    const size_t u0 = (size_t)(bl * 4 + h) * 64;
    u32x4 rw[2], rq[2], rk[2], ra; u32x2 ru[4]; float rge;
    GDN2_ENSURE(0);
    {
        const unsigned char* A = p->ws + WS_H + u0 * AUXA_UNIT; const unsigned char* B = p->ws + WS_OCAT + u0 * AUXB_UNIT;
#pragma unroll
        for (int k = 0; k < 2; ++k) { const int i = tid0 + 512 * k; rw[k] = ((const u32x4*)A)[i]; rq[k] = ((const u32x4*)B)[i]; rk[k] = ((const u32x4*)(B + 16384))[i]; }
#pragma unroll
        for (int k = 0; k < 4; ++k) ru[k] = ((const u32x2*)(A + 16384))[tid0 + 512 * k];
        ra = ((const u32x4*)(B + 32768))[tid0]; rge = ((const float*)(p->ws + WS_GE))[u0];
    }
    for (int c = 0; c < 64; ++c) {
        L = lds_opaque(L0);
        LAS unsigned char* VNT = L + GD_PRIV + wave * GD_PRIV_SZ; LAS unsigned char* SB = VNT + 2304;
        LBAR();
        const float ge = rge;
        {
            const int tid = tid_opaque();
#pragma unroll
            for (int k = 0; k < 2; ++k) { const int i = tid + 512 * k;
                *(LAS u32x4*)(L + GD_VN + (i >> 4) * 272 + (i & 15) * 16) = rw[k];
                *(LAS u32x4*)(L + GD_QN + (i >> 4) * 272 + (i & 15) * 16) = rq[k];
                *(LAS u32x4*)(L + GD_KET + (i >> 3) * 144 + (i & 7) * 16) = rk[k]; }
#pragma unroll
            for (int k = 0; k < 4; ++k) { const int i = tid + 512 * k; *(LAS u32x2*)(L + GD_KN + (i >> 4) * 136 + (i & 15) * 8) = ru[k]; }
            *(LAS u32x4*)(L + GD_MT + (tid >> 3) * 144 + (tid & 7) * 16) = ra;
        }
        LBAR();
        GDN2_ENSURE(c + 1 < 64 ? c + 1 : 63);
        {
            const int tid = tid_opaque(); KP pp = kparams();
            const size_t un = u0 + (c + 1 < 64 ? c + 1 : 63);
            const unsigned char* A = pp->ws + WS_H + un * AUXA_UNIT; const unsigned char* B = pp->ws + WS_OCAT + un * AUXB_UNIT;
#pragma unroll
            for (int k = 0; k < 2; ++k) { const int i = tid + 512 * k; rw[k] = ((const u32x4*)A)[i]; rq[k] = ((const u32x4*)B)[i]; rk[k] = ((const u32x4*)(B + 16384))[i]; }
#pragma unroll
            for (int k = 0; k < 4; ++k) ru[k] = ((const u32x2*)(A + 16384))[tid + 512 * k];
            ra = ((const u32x4*)(B + 32768))[tid]; rge = ((const float*)(pp->ws + WS_GE))[un];
        }
        {
            const int tid = tid_opaque(), lane = tid & 63, r16 = lane & 15, q4 = lane >> 4; (void)r16; (void)q4; (void)lane;
            KP pp = kparams(); bf16* ORp = (bf16*)(pp->ws + WS_ORAW) + (size_t)bl * SEQ * OC + h * 128 + wave * 16;
            bf16x8 sbf[4];
#pragma unroll
            for (int k4 = 0; k4 < 4; ++k4) sbf[k4] = *(const LAS bf16x8*)(SB + r16 * 272 + k4 * 64 + q4 * 16);
#pragma unroll
            for (int tl = 0; tl < 4; ++tl) {
                f32x4 p1 = (f32x4){0.f, 0.f, 0.f, 0.f};
#pragma unroll
                for (int k4 = 0; k4 < 4; ++k4) p1 = __builtin_amdgcn_mfma_f32_16x16x32_bf16(*(const LAS bf16x8*)(L + GD_VN + (16 * tl + r16) * 272 + k4 * 64 + q4 * 16), sbf[k4], p1, 0, 0, 0);
                const u32x2 uu = *(const LAS u32x2*)(L + GD_KN + (16 * wave + r16) * 136 + (16 * tl + 4 * q4) * 2);
                *(LAS u32x2*)(VNT + r16 * 144 + (16 * tl + 4 * q4) * 2) = (u32x2){pk2(bflo(uu.x) - p1[0], bfhi(uu.x) - p1[1]), pk2(bflo(uu.y) - p1[2], bfhi(uu.y) - p1[3])};
            }
            const bf16x8 vb0 = *(const LAS bf16x8*)(VNT + r16 * 144 + q4 * 16), vb1 = *(const LAS bf16x8*)(VNT + r16 * 144 + 64 + q4 * 16);
#pragma unroll
            for (int tl = 0; tl < 4; ++tl) {
                f32x4 o = (f32x4){0.f, 0.f, 0.f, 0.f};
#pragma unroll
                for (int k4 = 0; k4 < 4; ++k4) o = __builtin_amdgcn_mfma_f32_16x16x32_bf16(*(const LAS bf16x8*)(L + GD_QN + (16 * tl + r16) * 272 + k4 * 64 + q4 * 16), sbf[k4], o, 0, 0, 0);
                o = __builtin_amdgcn_mfma_f32_16x16x32_bf16(*(const LAS bf16x8*)(L + GD_MT + (16 * tl + r16) * 144 + q4 * 16), vb0, o, 0, 0, 0);
                if (tl >= 2) o = __builtin_amdgcn_mfma_f32_16x16x32_bf16(*(const LAS bf16x8*)(L + GD_MT + (16 * tl + r16) * 144 + 64 + q4 * 16), vb1, o, 0, 0, 0);
                bf16* orow = ORp + (size_t)(c * 64 + 16 * tl + 4 * q4) * OC + r16;
#pragma unroll
                for (int j = 0; j < 4; ++j) orow[(size_t)j * OC] = (bf16)pk1(o[j]);
            }
#pragma unroll
            for (int kt = 0; kt < 8; ++kt) {
                S[kt] = S[kt] * ge;
                S[kt] = __builtin_amdgcn_mfma_f32_16x16x32_bf16(*(const LAS bf16x8*)(L + GD_KET + (16 * kt + r16) * 144 + q4 * 16), vb0, S[kt], 0, 0, 0);
                S[kt] = __builtin_amdgcn_mfma_f32_16x16x32_bf16(*(const LAS bf16x8*)(L + GD_KET + (16 * kt + r16) * 144 + 64 + q4 * 16), vb1, S[kt], 0, 0, 0);
                *(LAS u32x2*)(SB + r16 * 272 + (16 * kt + 4 * q4) * 2) = (u32x2){pk2(S[kt][0], S[kt][1]), pk2(S[kt][2], S[kt][3])};
            }
        }
    }
    LBAR();
}

__device__ __forceinline__ void normgate_phase(KP p, int layer) {
    const int tid_ = tid_opaque(), lane = tid_ & 63, wave = __builtin_amdgcn_readfirstlane(tid_ >> 6);
    const bf16* P = (const bf16*)(p->ws + WS_PROJ); const bf16* ORAW = (const bf16*)(p->ws + WS_ORAW); bf16* OCAT = (bf16*)(p->ws + WS_OCAT);
    const int gw = bid_opaque() * 8 + wave, NGW = grid_opaque() * 8;
    const int c4 = 4 * lane;
    const f32x4 wg = *(const f32x4*)(p->in[9] + layer * 128 + (c4 & 127)), wh = *(const f32x4*)(p->in[11] + layer * 128 + (c4 & 127));
    const f32x4 ws0 = *(const f32x4*)(p->in[17] + layer * 512 + c4), ws1 = *(const f32x4*)(p->in[17] + layer * 512 + 256 + c4);
    const int rpw = (MH + NGW - 1) / NGW, r0 = gw * rpw, r1 = r0 + rpw < MH ? r0 + rpw : MH;
    if (r0 >= r1) return;
    u32x2 on[6], zn[6];
    { const bf16* o = ORAW + (size_t)r0 * OC + c4; const bf16* pr = P + (size_t)r0 * NP + c4;
#pragma unroll
      for (int j = 0; j < 6; ++j) on[j] = *(const u32x2*)(o + 256 * j);
      zn[0] = *(const u32x2*)(pr + C_GZ); zn[1] = *(const u32x2*)(pr + C_GZ + 256); zn[2] = *(const u32x2*)(pr + C_HG); zn[3] = *(const u32x2*)(pr + C_HG + 256); zn[4] = *(const u32x2*)(pr + C_SZ); zn[5] = *(const u32x2*)(pr + C_SZ + 256); }
    for (int r = r0; r < r1; ++r) {
        bf16* oc = OCAT + (size_t)r * OC + c4;
        f32x4 v[6]; u32x2 z[6];
#pragma unroll
        for (int j = 0; j < 6; ++j) { v[j] = (f32x4){bflo(on[j].x), bfhi(on[j].x), bflo(on[j].y), bfhi(on[j].y)}; z[j] = zn[j]; }
        if (r + 1 < r1) { const bf16* o = ORAW + (size_t)(r + 1) * OC + c4; const bf16* pr = P + (size_t)(r + 1) * NP + c4;
#pragma unroll
            for (int j = 0; j < 6; ++j) on[j] = *(const u32x2*)(o + 256 * j);
            zn[0] = *(const u32x2*)(pr + C_GZ); zn[1] = *(const u32x2*)(pr + C_GZ + 256); zn[2] = *(const u32x2*)(pr + C_HG); zn[3] = *(const u32x2*)(pr + C_HG + 256); zn[4] = *(const u32x2*)(pr + C_SZ); zn[5] = *(const u32x2*)(pr + C_SZ + 256); }
#pragma unroll
        for (int j = 0; j < 6; ++j) {
            f32x4 g; g[0] = silu_f(bflo(z[j].x)); g[1] = silu_f(bfhi(z[j].x)); g[2] = silu_f(bflo(z[j].y)); g[3] = silu_f(bfhi(z[j].y));
            f32x4 x = v[j]; if (j >= 4) x = x * g;
            float ss = (x[0] * x[0] + x[1] * x[1]) + (x[2] * x[2] + x[3] * x[3]);
            ss = red16(ss);
            const float s0 = rdl(ss, 0), s1 = rdl(ss, 16), s2 = rdl(ss, 32), s3 = rdl(ss, 48);
            float tot, inv;
            if (j >= 4) { tot = (s0 + s1) + (s2 + s3); inv = 1.f / 256.f; } else { tot = lane < 32 ? s0 + s1 : s2 + s3; inv = 1.f / 128.f; }
            const float rstd = rsqrtf(tot * inv + EPS);
            const f32x4 w = j < 2 ? wg : j < 4 ? wh : j == 4 ? ws0 : ws1;
            f32x4 y = x * rstd * w; if (j < 4) y = y * g;
            u32x2 ov; ov.x = pk2(y[0], y[1]); ov.y = pk2(y[2], y[3]);
            *(u32x2*)(oc + 256 * j) = ov;
        }
    }
}

__device__ __forceinline__ void glu_fix_phase(KP p, int layer) {
    const bf16* RB = (const bf16*)(p->ws + WS_RAWB); bf16* G = (bf16*)(p->ws + WS_G);
    const float* cw = p->in[24] + (size_t)layer * 3 * FF2; const float* cbp = p->in[25] + (size_t)layer * FF2;
    const int gt = bid_opaque() * 512 + tid_opaque(), NT = grid_opaque() * 512;
    constexpr int NPAIR = FF / 2;
    for (int idx = gt; idx < (MH / 64) * NPAIR; idx += NT) {
        const int b = idx / NPAIR, c = (idx % NPAIR) * 2;
        unsigned g[4], v[4];
#pragma unroll
        for (int s_ = 0; s_ < 4; ++s_) { g[s_] = *(const unsigned*)(RB + (size_t)(b * 4 + s_) * FF2 + c); v[s_] = *(const unsigned*)(RB + (size_t)(b * 4 + s_) * FF2 + FF + c); }
        if (((b * 64) % SEQ) == 0) { g[0] = 0u; g[1] = 0u; v[0] = 0u; v[1] = 0u; }
        float wg[3][2], wv[3][2];
#pragma unroll
        for (int k = 0; k < 3; ++k) { wg[k][0] = cw[k * FF2 + c]; wg[k][1] = cw[k * FF2 + c + 1]; wv[k][0] = cw[k * FF2 + FF + c]; wv[k][1] = cw[k * FF2 + FF + c + 1]; }
        const float bg0 = cbp[c], bg1 = cbp[c + 1], bv0 = cbp[FF + c], bv1 = cbp[FF + c + 1];
#pragma unroll
        for (int r = 0; r < 2; ++r) {
            const float ga = wg[0][0] * bflo(g[r]) + wg[1][0] * bflo(g[r + 1]) + wg[2][0] * bflo(g[r + 2]) + bg0;
            const float gb = wg[0][1] * bfhi(g[r]) + wg[1][1] * bfhi(g[r + 1]) + wg[2][1] * bfhi(g[r + 2]) + bg1;
            const float va = wv[0][0] * bflo(v[r]) + wv[1][0] * bflo(v[r + 1]) + wv[2][0] * bflo(v[r + 2]) + bv0;
            const float vb = wv[0][1] * bfhi(v[r]) + wv[1][1] * bfhi(v[r + 1]) + wv[2][1] * bfhi(v[r + 2]) + bv1;
            *(unsigned*)(G + (size_t)(b * 64 + r) * FF + c) = pk2(silu_f(ga) * va, silu_f(gb) * vb);
        }
    }
}

__device__ __forceinline__ void final_norm_phase(KP p) {
    const int tid_ = tid_opaque(), lane = tid_ & 63, wave = __builtin_amdgcn_readfirstlane(tid_ >> 6);
    const int gw = bid_opaque() * 8 + wave, NGW = grid_opaque() * 8;
    const float* nw = p->in[27];
    const int rpw = (MTOT + NGW - 1) / NGW, r0 = gw * rpw, r1 = r0 + rpw < MTOT ? r0 + rpw : MTOT;
    if (r0 >= r1) return;
    f32x4 w[4], v[4], vn[4];
#pragma unroll
    for (int j = 0; j < 4; ++j) { w[j] = *(const f32x4*)(nw + 4 * lane + 256 * j); vn[j] = ((const f32x4*)(p->out + (size_t)r0 * 1024) + lane)[64 * j]; }
    for (int r = r0; r < r1; ++r) {
#pragma unroll
        for (int j = 0; j < 4; ++j) v[j] = vn[j];
        if (r + 1 < r1) {
#pragma unroll
            for (int j = 0; j < 4; ++j) vn[j] = ((const f32x4*)(p->out + (size_t)(r + 1) * 1024) + lane)[64 * j]; }
        float s = 0.f;
#pragma unroll
        for (int j = 0; j < 4; ++j) s += (v[j][0] * v[j][0] + v[j][1] * v[j][1]) + (v[j][2] * v[j][2] + v[j][3] * v[j][3]);
        const float rstd = rsqrtf(wave_sum(s) * (1.f / 1024.f) + EPS);
        f32x4* xr = (f32x4*)(p->out + (size_t)r * 1024) + lane;
#pragma unroll
        for (int j = 0; j < 4; ++j) xr[64 * j] = v[j] * rstd * w[j];
    }
}


#define XB_TMO      128
#define XB_XCNT(j)  (256  + 64 * (j))
#define XB_XSUB(j)  (1280 + 64 * (j))
#define XB_XGEN(j)  (2304 + 64 * (j))
#define XB_TOP      3328
#define XB_TOPGEN   3392
#define XCD_BAR_WORDS 3456
#define XB_SPIN_CAP (1u << 20)
__device__ __forceinline__ unsigned xb_ld(unsigned* p)              { return __hip_atomic_load(p, __ATOMIC_RELAXED, __HIP_MEMORY_SCOPE_AGENT); }
__device__ __forceinline__ unsigned xb_add(unsigned* p, unsigned v) { return __hip_atomic_fetch_add(p, v, __ATOMIC_RELAXED, __HIP_MEMORY_SCOPE_AGENT); }
__device__ __forceinline__ unsigned xb_xcc_id() { return (unsigned)__builtin_amdgcn_s_getreg((3 << 11) | 20) & 0xFu; }
#define XB_SPIN(cond, bar) do { unsigned _sp = 0; while (cond) { __builtin_amdgcn_s_sleep(1); \
    if ((++_sp & 255u) == 0u) { if (xb_ld(&(bar)[XB_TMO])) break; if (_sp > XB_SPIN_CAP) { atomicAdd(&(bar)[XB_TMO], 1u); break; } } } } while (0)
struct XcdBarrier { unsigned* bar; unsigned x; volatile LAS unsigned* st; };
__device__ __forceinline__ XcdBarrier xcd_barrier_post(unsigned* bar, volatile LAS unsigned* st) {
    XcdBarrier b; b.bar = bar; b.x = xb_xcc_id(); b.st = st;
    if (threadIdx.x == 0) (void)xb_add(&bar[XB_XCNT(b.x)], 1u);
    return b;
}
__device__ __forceinline__ void xcd_barrier_complete(unsigned* bar, unsigned x, unsigned& nloc, unsigned& nx) {
    const unsigned G = gridDim.x * gridDim.y * gridDim.z;
    unsigned sum, cnt, mine, sp = 0u;
    for (;;) {
        sum = 0u; cnt = 0u; mine = 0u;
#pragma unroll
        for (unsigned j = 0; j < 16; ++j) { const unsigned c = xb_ld(&bar[XB_XCNT(j)]); sum += c; cnt += (c > 0u) ? 1u : 0u; mine = (j == x) ? c : mine; }
        if (sum == G) break;
        __builtin_amdgcn_s_sleep(1);
        if ((++sp & 255u) == 0u) { if (xb_ld(&bar[XB_TMO])) break; if (sp > XB_SPIN_CAP) { atomicAdd(&bar[XB_TMO], 1u); break; } }
    }
    nloc = mine > 0u ? mine : 1u; nx = cnt > 0u ? cnt : 1u;
}
__device__ __forceinline__ void xcd_barrier(const XcdBarrier& b) {
    asm volatile("s_waitcnt vmcnt(0)" ::: "memory");
    __syncthreads();
    if (threadIdx.x == 0) {
        unsigned* bar = b.bar;
        __builtin_amdgcn_s_waitcnt(0);
        unsigned nloc = b.st[0], nx = b.st[1];
        if (nloc == 0u) { xcd_barrier_complete(bar, b.x, nloc, nx); b.st[0] = nloc; b.st[1] = nx; }
        const unsigned old = xb_add(&bar[XB_XSUB(b.x)], 1u);
        const unsigned gen = old / nloc;
        if (old + 1u == (gen + 1u) * nloc) {
            __builtin_amdgcn_fence(__ATOMIC_RELEASE, "agent");
            asm volatile("s_waitcnt vmcnt(0)" ::: "memory");
            const unsigned og = xb_add(&bar[XB_TOP], 1u);
            const unsigned tg = og / nx;
            if (og + 1u == (tg + 1u) * nx) xb_add(&bar[XB_TOPGEN], 1u);
            else XB_SPIN(xb_ld(&bar[XB_TOPGEN]) == tg, bar);
            __builtin_amdgcn_fence(__ATOMIC_ACQUIRE, "agent");
            xb_add(&bar[XB_XGEN(b.x)], 1u);
            asm volatile("s_waitcnt vmcnt(0)" ::: "memory");
        } else {
            XB_SPIN(xb_ld(&bar[XB_XGEN(b.x)]) == gen, bar);
            __builtin_amdgcn_fence(__ATOMIC_ACQUIRE, "agent");
            asm volatile("s_waitcnt vmcnt(0)" ::: "memory");
        }
    }
    __syncthreads();
}

__global__ void __launch_bounds__(512, 2) mk_fwd(Params pv) {
    extern __shared__ __attribute__((aligned(16))) unsigned char lds_raw[];
    LAS unsigned char* lds = (LAS unsigned char*)lds_raw;
    cg::grid_group grid = cg::this_grid();
    const int ph_lo = pv.ph_lo, ph_hi = pv.ph_hi;
    volatile LAS unsigned* xst = (volatile LAS unsigned*)(lds + XB_ST_OFF);
    if (threadIdx.x < 2) xst[threadIdx.x] = 0u;
    __syncthreads();
    (void)xcd_barrier_post((unsigned*)(pv.ws + WS_BAR), xst);

    for (int ph = ph_lo; ph < ph_hi; ++ph) {
        if (ph > ph_lo) { if (ph == ph_lo + 1) grid.sync(); else { XcdBarrier xb_; xb_.bar = (unsigned*)(kparams()->ws + WS_BAR); xb_.x = xb_xcc_id(); xb_.st = (volatile LAS unsigned*)(lds_opaque(lds) + XB_ST_OFF); xcd_barrier(xb_); } }
        KP p = kparams();
        const int G = grid_opaque();
        unsigned char* ws = p->ws;
        if (ph == 0) { p0_prologue(p, lds); continue; }
        if (ph == NPH - 1) { final_norm_phase(p); continue; }
        const int q = ph - 1, layer = q / 20, hb = (q / 10) % 2, sub = q % 10;
        const int row_base = hb * MH;
        const float* mod = (const float*)(ws + WS_MOD) + (size_t)layer * 16 * 6144;
        const bf16* WL = (const bf16*)(ws + WS_W) + (size_t)layer * W_LAYER;
        bf16* HBUF = (bf16*)(ws + WS_H);
        const bf16* gA = nullptr; const bf16* gB = nullptr; int nt = 0, lda = 0, ldb = 0, nN = 0, epi = -1;
        switch (sub) {
        case 0: {
            const float* xin = (layer == 0 ? p->in[0] : p->out);
            norm_mod_phase(xin + (size_t)row_base * 1024, row_base, p->in[4] + layer * 1024, mod + 0, mod + 1024, HBUF, WL + W_IN + (size_t)C_SMALL * 1024, (float*)(ws + WS_SM));
        } break;
        case 1:
            gA = HBUF; gB = WL + W_IN; nt = 16; lda = 1024; ldb = 1024; nN = ((MH + G * 8 - 1) / (G * 8) == 16) ? C_SMALL / 256 : NP / 256; epi = 0; break;
        case 2: {
            const int b = bid_opaque();
            if (b < 64) ssd_unit(p, b, layer, lds);
            else if (b < 128) hgrn_unit(p, b - 64, layer, lds);
            else if (b < 160) gdn2_unit(p, b - 128, layer, layer * 2 + hb, lds);
            else if (G - 160 >= 32 && (G - 160) % 32 == 0) {
                u32x4 xr[3][4][2]; const int st = G - 160; int j = b - 160;
                gdn1_load_rows(p, ((j & 31) << 6) | (j >> 5), xr);
                for (; j < 2048; j += st) { const int jn = j + st < 2048 ? j + st : j; gdn1_unit(p, ((j & 31) << 6) | (j >> 5), layer, lds, xr, j == b - 160, ((jn & 31) << 6) | (jn >> 5)); }
            } else {
                u32x4 xr[3][4][2]; const int st = G - 160;
                for (int j = b - 160; j < 2048; j += st) { gdn1_load_rows(p, ((j & 31) << 6) | (j >> 5), xr); gdn1_unit(p, ((j & 31) << 6) | (j >> 5), layer, lds, xr, true, ((j & 31) << 6) | (j >> 5)); }
            }
        } break;
        case 3:
            normgate_phase(p, layer);
            break;
        case 4:
            gA = (const bf16*)(ws + WS_OCAT); gB = WL + W_BR; nt = 24; lda = OC; ldb = OC; nN = 4; epi = 1; break;
        case 5:
            gA = HBUF; gB = WL + W_OUT; nt = 16; lda = 1024; ldb = 1024; nN = 4; epi = 4; break;
        case 6:
            norm_mod_phase(p->out + (size_t)row_base * 1024, row_base, p->in[22] + layer * 1024, mod + 3072, mod + 4096, HBUF, nullptr, nullptr);
            break;
        case 7:
            gA = HBUF; gB = WL + W_UP; nt = 16; lda = 1024; ldb = 1024; nN = FF2 / 256; epi = 5; break;
        case 8:
            glu_fix_phase(p, layer);
            break;
        default:
            gA = (const bf16*)(ws + WS_G); gB = WL + W_DN; nt = FF / 64; lda = FF; ldb = FF; nN = 4; epi = 6; break;
        }
        if (epi >= 0) pg8::gemm_phase(lds, gA, gB, nt, lda, ldb, nN, epi, layer, row_base);
    }
}

extern "C" void kernel_launch(void* const* d_in, const int* in_sizes, int n_in, void* d_out, int out_size, void* d_ws, size_t ws_size, hipStream_t stream) {
    static int grid = 0;
    if (grid == 0) {
        if (n_in != 28 || out_size != MTOT * DM || ws_size < WS_END) { fprintf(stderr, "kernel_launch: unexpected problem: n_in %d out %d ws %zu (need %zu)\n", n_in, out_size, ws_size, (size_t)WS_END); grid = -1; return; }
        int dev = 0, cus = 0, per_cu = 0;
        hipGetDevice(&dev); hipDeviceGetAttribute(&cus, hipDeviceAttributeMultiprocessorCount, dev);
        hipFuncSetAttribute((const void*)mk_fwd, hipFuncAttributeMaxDynamicSharedMemorySize, LDS_BYTES);
        hipOccupancyMaxActiveBlocksPerMultiprocessor(&per_cu, (const void*)mk_fwd, 512, LDS_BYTES);
        if (per_cu < 1) { fprintf(stderr, "kernel_launch: occupancy query says %d blocks per CU\n", per_cu); per_cu = 1; }
        (void)hipGetLastError();
        grid = cus;
        if (grid < 192) { fprintf(stderr, "kernel_launch: %d CUs: the mixer phase needs at least 192 workgroups\n", grid); grid = -1; return; }
    }
    if (grid < 0) return;
    Params p{};
    for (int i = 0; i < 28; ++i) p.in[i] = (const float*)d_in[i];
    p.out = (float*)d_out; p.ws = (unsigned char*)d_ws;
#if MK_COOP
    p.ph_lo = 0; p.ph_hi = NPH;
    (void)hipMemsetAsync((char*)d_ws + WS_BAR, 0, 16384, stream);
    void* args[] = {&p};
    hipError_t e = hipLaunchCooperativeKernel((const void*)mk_fwd, dim3(grid), dim3(512), args, LDS_BYTES, stream);
    if (e != hipSuccess) fprintf(stderr, "cooperative launch failed: %s (grid %d)\n", hipGetErrorString(e), grid);
#else
    for (int ph = 0; ph < NPH; ++ph) { p.ph_lo = ph; p.ph_hi = ph + 1; hipLaunchKernelGGL(mk_fwd, dim3(grid), dim3(512), LDS_BYTES, stream, p); }
#endif
}
```

```cpp
#include <hip/hip_runtime.h>
#include <hip/hip_cooperative_groups.h>
#include <cstdio>
#include <cstdint>
namespace cg = cooperative_groups;

#ifndef MK_COOP
#define MK_COOP 1
#endif

#define LAS __attribute__((address_space(3)))
typedef unsigned short bf16;
typedef short bf16x8 __attribute__((ext_vector_type(8)));
typedef float f32x4 __attribute__((ext_vector_type(4)));
typedef unsigned u32x4 __attribute__((ext_vector_type(4)));
typedef unsigned u32x2 __attribute__((ext_vector_type(2)));

constexpr int DM = 1024, SEQ = 4096, BATCH = 16, MTOT = BATCH * SEQ, HB_SEQ = 8, MH = HB_SEQ * SEQ;
constexpr int NIN = 8720, NP = 8960;
constexpr int C_GZ = 1536, C_HQ = 2048, C_HF = 2560, C_HI = 3072, C_HG = 3584, C_SZ = 4096, C_XBC = 4608, C_GATE = 5632, C_SMALL = 8704;
constexpr int FF = 2816, FF2 = 5632, OC = 1536;
constexpr float EPS = 1e-6f;
constexpr size_t W_IN = 0, W_BR = (size_t)NP * 1024, W_OUT = W_BR + 3 * 524288, W_UP = W_OUT + 1048576, W_DN = W_UP + (size_t)FF2 * 1024, W_LAYER = W_DN + (size_t)FF * 1024;
constexpr size_t MiB = 1u << 20;
constexpr size_t WS_MOD = 0, WS_W = 1 * MiB, WS_H = 80 * MiB, WS_SM = 144 * MiB, WS_OCAT = 146 * MiB, WS_ORAW = 242 * MiB, WS_PROJ = 434 * MiB, WS_G = 786 * MiB, WS_END = 994 * MiB;
static_assert(WS_W + 2 * W_LAYER * 2 <= WS_H, "weights fit");
constexpr size_t WS_RAWB = 338 * MiB;
constexpr int LDS_BYTES = 147456 + 256;
constexpr int XB_ST_OFF = 147456;
constexpr size_t WS_BAR = 900 * 1024;
constexpr int NPH = 42;

typedef float f32x2_t __attribute__((ext_vector_type(2)));
typedef __bf16 bf16x2_t __attribute__((ext_vector_type(2)));
__device__ __forceinline__ unsigned pk2(float lo, float hi) { const f32x2_t v = {lo, hi}; const bf16x2_t b = __builtin_convertvector(v, bf16x2_t); return __builtin_bit_cast(unsigned, b); }
__device__ __forceinline__ unsigned f2bf(float f) { return pk2(f, f) & 0xffffu; }
__device__ __forceinline__ unsigned pk1(float f) { return pk2(f, f); }
__device__ __forceinline__ float bf2f(unsigned b) { return __builtin_bit_cast(float, b << 16); }
__device__ __forceinline__ float bflo(unsigned w) { return __builtin_bit_cast(float, w << 16); }
__device__ __forceinline__ float bfhi(unsigned w) { return __builtin_bit_cast(float, w & 0xffff0000u); }
__device__ __forceinline__ float silu_f(float v) { return v * __builtin_amdgcn_rcpf(1.f + __builtin_amdgcn_exp2f(-1.4426950408889634f * v)); }
__device__ __forceinline__ float sigmoid_f(float v) { return __builtin_amdgcn_rcpf(1.f + __builtin_amdgcn_exp2f(-1.4426950408889634f * v)); }
__device__ __forceinline__ float softplus_f(float v) { const float z = __expf(-fabsf(v)); const float l = (z < 0.01f) ? z * (1.f - z * (0.5f - z * (1.f / 3.f))) : __logf(1.f + z); return fmaxf(v, 0.f) + l; }
template <int CTRL> __device__ __forceinline__ float dppf(float v) { return __builtin_bit_cast(float, __builtin_amdgcn_update_dpp(0, __builtin_bit_cast(int, v), CTRL, 0xf, 0xf, true)); }
__device__ __forceinline__ float red16(float v) { v += dppf<0xB1>(v); v += dppf<0x4E>(v); v += dppf<0x141>(v); v += dppf<0x128>(v); return v; }
__device__ __forceinline__ float rdl(float v, int l) { return __builtin_bit_cast(float, __builtin_amdgcn_readlane(__builtin_bit_cast(int, v), l)); }
__device__ __forceinline__ float wave_sum(float v) { v = red16(v); return (rdl(v, 0) + rdl(v, 16)) + (rdl(v, 32) + rdl(v, 48)); }
__device__ __forceinline__ float wave_scan_incl(float v, int lane) {
    v += dppf<0x111>(v); v += dppf<0x112>(v); v += dppf<0x114>(v); v += dppf<0x118>(v);
    const float t0 = rdl(v, 15), t1 = rdl(v, 31), t2 = rdl(v, 47); const int q = lane >> 4;
    return v + (q >= 1 ? t0 : 0.f) + (q >= 2 ? t1 : 0.f) + (q >= 3 ? t2 : 0.f);
}

struct Params { const float* in[28]; float* out; unsigned char* ws; int ph_lo, ph_hi; };
typedef const __attribute__((address_space(4))) Params* KP;
__device__ __forceinline__ int tid_opaque() { int t = threadIdx.x; asm volatile("" : "+v"(t)); return t; }
__device__ __forceinline__ int bid_opaque() { int b = blockIdx.x; asm volatile("" : "+s"(b)); return b; }
__device__ __forceinline__ int grid_opaque() { int g = gridDim.x; asm volatile("" : "+s"(g)); return g; }
__device__ __forceinline__ LAS unsigned char* lds_opaque(LAS unsigned char* l) { asm volatile("" : "+s"(l)); return l; }
__device__ __forceinline__ KP kparams() { KP q = (KP)__builtin_amdgcn_kernarg_segment_ptr(); asm volatile("" : "+s"(q)); return q; }


namespace pg8 {
constexpr int BM = 256, BK = 64, HALF = 128, HTB = HALF * BK * 2, STAGE_BYTES = 8 * HTB, NXCD = 8, WGM = 4;
__device__ __forceinline__ int lds_byte(int r, int c) { const int st = (r >> 4) * 2 + (c >> 5), rr = r & 15, cc = c & 31, ob = rr * 64 + cc * 2; return st * 1024 + (ob ^ (((ob >> 9) & 1) << 5)); }
__device__ __forceinline__ void stage_rc(int b, int& R, int& C) { const int st = b / 1024, sb = b % 1024, swz = sb ^ (((sb >> 9) & 1) << 5); R = (st >> 1) * 16 + swz / 64; C = (st & 1) * 32 + (swz % 64) / 2; }
__device__ __forceinline__ int perm32(int rho) { const int n = rho >> 4, i = rho & 15; return 8 * (i >> 2) + 4 * n + (i & 3); }
struct Unit { int pm, pn; };
struct StaticOrder {
    int nM, nN, nwg, G, c;
    __device__ __forceinline__ void init(int M, int N, int G_, int c_) { nM = M / BM; nN = N / BM; nwg = nM * nN; G = G_; c = c_; }
    __device__ __forceinline__ bool next(int i, Unit& u) const {
        const long L = (long)i * G + c; if (L >= nwg) return false;
        int wgid = (int)L; { const int q = nwg / NXCD, r = nwg % NXCD, xcd = wgid % NXCD, off = wgid / NXCD; wgid = (xcd < r ? xcd * (q + 1) : r * (q + 1) + (xcd - r) * q) + off; }
        const int nig = WGM * nN, gid = wgid / nig, fm = gid * WGM, gsz = (nM - fm) < WGM ? (nM - fm) : WGM;
        u.pm = fm + ((wgid % nig) % gsz); u.pn = (wgid % nig) / gsz; return true;
    }
};
__device__ __forceinline__ unsigned cvt_pk_bf16(float lo, float hi) { return pk2(lo, hi); }

template <int LDC, bool SMALL> struct EpiBf16 {
    static constexpr bool PERM = true;
    __device__ __forceinline__ void operator()(const f32x4 (&acc)[2][2][4][2], const Unit& u, int wr, int wc, int fr, int fq) const {
        KP p = kparams(); unsigned char* ws = p->ws;
        bf16* O = (bf16*)(ws + WS_PROJ);
        const int row0 = u.pm * BM + wr * 64 + fr; const int col0 = u.pn * BM + wc * 32 + 8 * fq;
#pragma unroll
        for (int ai = 0; ai < 2; ++ai)
#pragma unroll
            for (int m = 0; m < 4; ++m) { bf16* rowp = O + (size_t)(row0 + ai * HALF + m * 16) * LDC + col0;
#pragma unroll
                for (int bj = 0; bj < 2; ++bj) { const f32x4 v0 = acc[ai][bj][m][0], v1 = acc[ai][bj][m][1];
                    u32x4 w; w.x = cvt_pk_bf16(v0[0], v0[1]); w.y = cvt_pk_bf16(v0[2], v0[3]); w.z = cvt_pk_bf16(v1[0], v1[1]); w.w = cvt_pk_bf16(v1[2], v1[3]);
                    *(u32x4*)(rowp + bj * HALF) = w; } }
        if (SMALL && u.pn == C_SMALL / 256 && wc == 0 && fq < 2) {
            float* sm = (float*)(ws + WS_SM);
#pragma unroll
            for (int ai = 0; ai < 2; ++ai)
#pragma unroll
                for (int m = 0; m < 4; ++m) { float* q = sm + (size_t)(row0 + ai * HALF + m * 16) * 16 + 8 * fq; *(f32x4*)q = acc[ai][0][m][0]; *(f32x4*)(q + 4) = acc[ai][0][m][1]; }
        }
    }
};
__device__ __forceinline__ void branch_rescale(f32x4 (&acc)[2][2][4][2], const Unit& u, int wr, int wc, int fr, int fq, int which) {
    KP p = kparams();
    const bf16* gate = (const bf16*)(p->ws + WS_PROJ) + C_GATE + which * 1024;
    const int col0 = u.pn * BM + wc * 32 + 4 * fq;
#pragma unroll
    for (int ai = 0; ai < 2; ++ai)
#pragma unroll
        for (int mp = 0; mp < 2; ++mp) {
            u32x2 ga[2][2][2], gb[2][2][2];
#pragma unroll
            for (int mm = 0; mm < 2; ++mm) { const size_t row = (size_t)(u.pm * BM + ai * HALF + wr * 64 + (2 * mp + mm) * 16 + fr);
#pragma unroll
                for (int bj = 0; bj < 2; ++bj)
#pragma unroll
                    for (int n = 0; n < 2; ++n) { const int c = col0 + bj * HALF + n * 16; ga[mm][bj][n] = *(const u32x2*)(gate + row * NP + c); gb[mm][bj][n] = *(const u32x2*)(gate + row * NP + 1024 + c); } }
#pragma unroll
            for (int mm = 0; mm < 2; ++mm)
#pragma unroll
                for (int bj = 0; bj < 2; ++bj)
#pragma unroll
                    for (int n = 0; n < 2; ++n) { const u32x2 xa = ga[mm][bj][n], xb = gb[mm][bj][n];
                        f32x4 r;
                        r[0] = (1.f + __builtin_amdgcn_exp2f(-1.4426950408889634f * bflo(xb.x))) * __builtin_amdgcn_rcpf(1.f + __builtin_amdgcn_exp2f(-1.4426950408889634f * bflo(xa.x)));
                        r[1] = (1.f + __builtin_amdgcn_exp2f(-1.4426950408889634f * bfhi(xb.x))) * __builtin_amdgcn_rcpf(1.f + __builtin_amdgcn_exp2f(-1.4426950408889634f * bfhi(xa.x)));
                        r[2] = (1.f + __builtin_amdgcn_exp2f(-1.4426950408889634f * bflo(xb.y))) * __builtin_amdgcn_rcpf(1.f + __builtin_amdgcn_exp2f(-1.4426950408889634f * bflo(xa.y)));
                        r[3] = (1.f + __builtin_amdgcn_exp2f(-1.4426950408889634f * bfhi(xb.y))) * __builtin_amdgcn_rcpf(1.f + __builtin_amdgcn_exp2f(-1.4426950408889634f * bfhi(xa.y)));
                        acc[ai][bj][2 * mp + mm][n] = acc[ai][bj][2 * mp + mm][n] * r; }
        }
    asm volatile("s_waitcnt vmcnt(0)" ::: "memory");
}
struct EpiBranchFinal {
    static constexpr bool PERM = false;
    __device__ __forceinline__ void operator()(const f32x4 (&acc)[2][2][4][2], const Unit& u, int wr, int wc, int fr, int fq) const {
        KP p = kparams(); unsigned char* ws = p->ws;
        const bf16* gate = (const bf16*)(ws + WS_PROJ) + C_GATE + 2048; bf16* mb = (bf16*)(ws + WS_H);
        const int col0 = u.pn * BM + wc * 32 + 4 * fq;
#pragma unroll
        for (int ai = 0; ai < 2; ++ai)
#pragma unroll
            for (int mp = 0; mp < 2; ++mp) {
                u32x2 gr[2][2][2];
#pragma unroll
                for (int mm = 0; mm < 2; ++mm) { const size_t row = (size_t)(u.pm * BM + ai * HALF + wr * 64 + (2 * mp + mm) * 16 + fr);
#pragma unroll
                    for (int bj = 0; bj < 2; ++bj)
#pragma unroll
                        for (int n = 0; n < 2; ++n) gr[mm][bj][n] = *(const u32x2*)(gate + row * NP + col0 + bj * HALF + n * 16); }
#pragma unroll
                for (int mm = 0; mm < 2; ++mm) { const size_t row = (size_t)(u.pm * BM + ai * HALF + wr * 64 + (2 * mp + mm) * 16 + fr);
#pragma unroll
                    for (int bj = 0; bj < 2; ++bj)
#pragma unroll
                        for (int n = 0; n < 2; ++n) { const int c = col0 + bj * HALF + n * 16; const u32x2 x = gr[mm][bj][n];
                            f32x4 g; g[0] = sigmoid_f(bflo(x.x)); g[1] = sigmoid_f(bfhi(x.x)); g[2] = sigmoid_f(bflo(x.y)); g[3] = sigmoid_f(bfhi(x.y));
                            const f32x4 v = acc[ai][bj][2 * mp + mm][n] * g; u32x2 w; w.x = cvt_pk_bf16(v[0], v[1]); w.y = cvt_pk_bf16(v[2], v[3]); *(u32x2*)(mb + row * 1024 + c) = w; } }
            }
    }
};
struct EpiUpGlu {
    static constexpr bool PERM = true;
    int layer;
    __device__ __forceinline__ void operator()(const f32x4 (&acc)[2][2][4][2], const Unit& u, int wr, int wc, int fr, int fq) const {
        KP p = kparams(); unsigned char* ws = p->ws;
        bf16* G = (bf16*)(ws + WS_G); bf16* RB = (bf16*)(ws + WS_RAWB);
        const float* cw = p->in[24] + (size_t)layer * 3 * FF2; const float* cb = p->in[25] + (size_t)layer * FF2;
        const int gcol = u.pn * 128 + wc * 32 + 8 * fq;
#pragma unroll
        for (int n = 0; n < 2; ++n) {
            asm volatile("" ::: "memory");
            f32x4 wg[3], wv[3];
#pragma unroll
            for (int k = 0; k < 3; ++k) { wg[k] = *(const f32x4*)(cw + k * FF2 + gcol + 4 * n); wv[k] = *(const f32x4*)(cw + k * FF2 + FF + gcol + 4 * n); }
            const f32x4 bg = *(const f32x4*)(cb + gcol + 4 * n), bv = *(const f32x4*)(cb + FF + gcol + 4 * n);
#pragma unroll
            for (int ai = 0; ai < 2; ++ai)
#pragma unroll
                for (int m = 0; m < 4; ++m) {
                    const int row = u.pm * BM + ai * HALF + wr * 64 + m * 16 + fr;
                    float o[4];
#pragma unroll
                    for (int e = 0; e < 4; ++e) {
                        const float cg = n == 0 ? acc[ai][0][m][0][e] : acc[ai][0][m][1][e], cv = n == 0 ? acc[ai][1][m][0][e] : acc[ai][1][m][1][e];
                        const float pg = m > 0 ? (n == 0 ? acc[ai][0][m > 0 ? m - 1 : 0][0][e] : acc[ai][0][m > 0 ? m - 1 : 0][1][e]) : cg;
                        const float pv = m > 0 ? (n == 0 ? acc[ai][1][m > 0 ? m - 1 : 0][0][e] : acc[ai][1][m > 0 ? m - 1 : 0][1][e]) : cv;
                        const float cg1 = dppf<0x121>(cg), pg1 = dppf<0x121>(pg), cg2 = dppf<0x122>(cg), pg2 = dppf<0x122>(pg);
                        const float cv1 = dppf<0x121>(cv), pv1 = dppf<0x121>(pv), cv2 = dppf<0x122>(cv), pv2 = dppf<0x122>(pv);
                        const float g1 = fr >= 1 ? cg1 : pg1, g2 = fr >= 2 ? cg2 : pg2, v1 = fr >= 1 ? cv1 : pv1, v2 = fr >= 2 ? cv2 : pv2;
                        const float yg = wg[0][e] * g2 + wg[1][e] * g1 + wg[2][e] * cg + bg[e];
                        const float yv = wv[0][e] * v2 + wv[1][e] * v1 + wv[2][e] * cv + bv[e];
                        o[e] = silu_f(yg) * yv;
                    }
                    if (!(m == 0 && fr < 2)) { u32x2 w; w.x = pk2(o[0], o[1]); w.y = pk2(o[2], o[3]); *(u32x2*)(G + (size_t)row * FF + gcol + 4 * n) = w; }
                    int slot = -1, b = row >> 6;
                    if (m == 0 && fr < 2) slot = 2 + fr; else if (m == 3 && fr >= 14) { slot = fr - 14; b += 1; }
                    if (slot >= 0 && b < MH / 64) {
                        const f32x4 g0 = n == 0 ? acc[ai][0][m][0] : acc[ai][0][m][1], v0 = n == 0 ? acc[ai][1][m][0] : acc[ai][1][m][1];
                        bf16* rb = RB + (size_t)(b * 4 + slot) * FF2 + gcol + 4 * n;
                        u32x2 w; w.x = pk2(g0[0], g0[1]); w.y = pk2(g0[2], g0[3]); *(u32x2*)rb = w;
                        w.x = pk2(v0[0], v0[1]); w.y = pk2(v0[2], v0[3]); *(u32x2*)(rb + FF) = w;
                    }
                }
        }
    }
};
template <bool SECOND> struct EpiResid {
    static constexpr bool PERM = false;
    int layer, row_base;
    __device__ __forceinline__ void operator()(const f32x4 (&acc)[2][2][4][2], const Unit& u, int wr, int wc, int fr, int fq) const {
        KP p = kparams();
        float* out = p->out; const float* base = (SECOND || layer != 0) ? (const float*)out : p->in[0];
        const float* gate = (const float*)(p->ws + WS_MOD) + (size_t)layer * 16 * 6144 + (SECOND ? 5120 : 2048);
        const int col0 = u.pn * BM + wc * 32 + 4 * fq;
        const int b = (row_base + u.pm * BM) / SEQ;
        f32x4 gv[2][2];
#pragma unroll
        for (int bj = 0; bj < 2; ++bj)
#pragma unroll
            for (int n = 0; n < 2; ++n) gv[bj][n] = *(const f32x4*)(gate + (size_t)b * 6144 + col0 + bj * HALF + n * 16);
#pragma unroll
        for (int ai = 0; ai < 2; ++ai)
#pragma unroll
            for (int mp = 0; mp < 2; ++mp) {
                f32x4 bs[2][2][2];
#pragma unroll
                for (int mm = 0; mm < 2; ++mm) { const size_t off = (size_t)(row_base + u.pm * BM + ai * HALF + wr * 64 + (2 * mp + mm) * 16 + fr) * 1024 + col0;
#pragma unroll
                    for (int bj = 0; bj < 2; ++bj)
#pragma unroll
                        for (int n = 0; n < 2; ++n) bs[mm][bj][n] = *(const f32x4*)(base + off + bj * HALF + n * 16); }
#pragma unroll
                for (int mm = 0; mm < 2; ++mm) { const size_t off = (size_t)(row_base + u.pm * BM + ai * HALF + wr * 64 + (2 * mp + mm) * 16 + fr) * 1024 + col0;
#pragma unroll
                    for (int bj = 0; bj < 2; ++bj)
#pragma unroll
                        for (int n = 0; n < 2; ++n) *(f32x4*)(out + off + bj * HALF + n * 16) = bs[mm][bj][n] + gv[bj][n] * acc[ai][bj][2 * mp + mm][n]; }
            }
    }
};

__device__ __forceinline__ void gemm_phase(LAS unsigned char* lds, const bf16* gA, const bf16* gBt, const int nt, const int LDA, const int LDB, const int nN, const int epi, const int layer, const int row_base) {
    StaticOrder S; S.nM = MH / BM; S.nN = nN; S.nwg = S.nM * nN; S.G = grid_opaque(); S.c = bid_opaque();
    const bool PERM = (epi == 0 || epi == 5);
    const int tid = tid_opaque(), wid = __builtin_amdgcn_readfirstlane(tid >> 6), lane = tid & 63, wr = wid >> 2, wc = wid & 3;
    unsigned voffA[2], voffB[2];
#pragma unroll
    for (int i = 0; i < 2; ++i) { int R, C; stage_rc(tid * 16 + i * 8192, R, C); const int Rb = PERM ? ((R & ~31) + perm32(R & 31)) : R;
        voffA[i] = (unsigned)(R * LDA + C) * 2u; voffB[i] = (unsigned)(Rb * LDB + C) * 2u; }
    constexpr size_t kstep = (size_t)(BK * 2);
    const size_t hstepA = (size_t)HALF * LDA * 2, hstepB = (size_t)HALF * LDB * 2;
    const size_t tstepA = 2 * hstepA, tstepB = 2 * hstepB;
    const unsigned ldsw = (unsigned)wid * 1024u;
    const int aoff = lds_byte(wr * 64 + (lane & 15), (lane >> 4) * 8), boff = lds_byte(wc * 32 + (lane & 15), (lane >> 4) * 8);
#define PG8_SA(b, h) (((b) * 2 + (h)) * HTB)
#define PG8_SB(b, h) ((4 + (b) * 2 + (h)) * HTB)
#define PG8_STAGE(bufoff, gbase, voff) do { _Pragma("unroll") for (int _i = 0; _i < 2; ++_i) \
        __builtin_amdgcn_global_load_lds((const unsigned*)((const char*)(gbase) + (voff)[_i]), (LAS unsigned*)(lds + (bufoff) + ldsw + _i * 8192), 16, 0, 0); } while (0)
#define PG8_LDA(dst, b, h) do { _Pragma("unroll") for (int m = 0; m < 4; ++m) _Pragma("unroll") for (int k = 0; k < 2; ++k) dst[m][k] = *(const LAS bf16x8*)(lds + PG8_SA(b, h) + aoff + m * 2048 + k * 1024); } while (0)
#define PG8_LDB(dst, b, h) do { _Pragma("unroll") for (int n = 0; n < 2; ++n) _Pragma("unroll") for (int k = 0; k < 2; ++k) dst[n][k] = *(const LAS bf16x8*)(lds + PG8_SB(b, h) + boff + n * 2048 + k * 1024); } while (0)
#define PG8_MMA(ai, bj, At, Bt) do { __builtin_amdgcn_s_setprio(1); _Pragma("unroll") for (int m = 0; m < 4; ++m) _Pragma("unroll") for (int n = 0; n < 2; ++n) _Pragma("unroll") for (int k = 0; k < 2; ++k) \
        acc[ai][bj][m][n] = __builtin_amdgcn_mfma_f32_16x16x32_bf16(Bt[n][k], At[m][k], acc[ai][bj][m][n], 0, 0, 0); __builtin_amdgcn_s_setprio(0); } while (0)
#define PG8_WAIT_V(n) asm volatile("s_waitcnt vmcnt(" #n ")" ::: "memory")
#define PG8_WAIT_L(n) asm volatile("s_waitcnt lgkmcnt(" #n ")" ::: "memory")
#define PG8_BAR __builtin_amdgcn_s_barrier()
#define PG8_SCHED __builtin_amdgcn_sched_barrier(0)
    Unit cur, nxt; int ui = 0;
    if (!S.next(0, cur)) return;
    f32x4 acc[2][2][4][2];
#pragma unroll
    for (int a = 0; a < 2; ++a)
#pragma unroll
        for (int b = 0; b < 2; ++b)
#pragma unroll
            for (int m = 0; m < 4; ++m)
#pragma unroll
                for (int n = 0; n < 2; ++n) acc[a][b][m][n] = (f32x4){0.f, 0.f, 0.f, 0.f};
    bf16x8 At[4][2], B0[2][2], B1[2][2];
    const char* cA = (const char*)gA + (size_t)cur.pm * tstepA; const char* cB = (const char*)gBt + (size_t)cur.pn * tstepB;
    PG8_STAGE(PG8_SB(0, 0), cB, voffB); PG8_STAGE(PG8_SB(0, 1), cB + hstepB, voffB); PG8_STAGE(PG8_SA(0, 0), cA, voffA); PG8_STAGE(PG8_SA(0, 1), cA + hstepA, voffA);
    if (wr == 1) PG8_BAR;
    PG8_WAIT_V(2); PG8_BAR;
    PG8_STAGE(PG8_SB(1, 0), cB + kstep, voffB); PG8_STAGE(PG8_SA(1, 0), cA + kstep, voffA); PG8_STAGE(PG8_SB(1, 1), cB + hstepB + kstep, voffB);
    PG8_WAIT_V(6); PG8_BAR;
    for (;;) {
        const bool has_next = S.next(ui + 1, nxt);
        const char* nA = has_next ? (const char*)gA + (size_t)nxt.pm * tstepA : cA; const char* nB = has_next ? (const char*)gBt + (size_t)nxt.pn * tstepB : cB;
        for (int t = 0; t < nt; t += 2) {
            if (epi == 1 && (t == 8 || t == 16)) { const int tr_ = tid_opaque(); branch_rescale(acc, cur, wr, wc, tr_ & 15, (tr_ & 63) >> 4, t == 8 ? 0 : 1); }
            const bool last = (t == nt - 2);
            const char* a1 = cA + (size_t)(t + 1) * kstep;
            const char* a2 = last ? nA : cA + (size_t)(t + 2) * kstep; const char* b2 = last ? nB : cB + (size_t)(t + 2) * kstep;
            const char* a3 = a2 + kstep; const char* b3 = b2 + kstep;
            PG8_LDB(B0, 0, 0); PG8_LDB(B1, 0, 1); PG8_SCHED; PG8_LDA(At, 0, 0); PG8_STAGE(PG8_SA(1, 1), a1 + hstepA, voffA);
            PG8_WAIT_V(8); PG8_WAIT_L(0); PG8_BAR; PG8_MMA(0, 0, At, B0); PG8_MMA(0, 1, At, B1); PG8_BAR; PG8_SCHED;
            PG8_LDA(At, 0, 1); PG8_STAGE(PG8_SB(0, 0), b2, voffB); PG8_STAGE(PG8_SB(0, 1), b2 + hstepB, voffB); PG8_STAGE(PG8_SA(0, 0), a2, voffA);
            PG8_WAIT_V(8); PG8_WAIT_L(0); PG8_BAR; PG8_MMA(1, 0, At, B0); PG8_MMA(1, 1, At, B1); PG8_BAR; PG8_SCHED;
            PG8_LDB(B0, 1, 0); PG8_LDB(B1, 1, 1); PG8_SCHED; PG8_LDA(At, 1, 0); PG8_STAGE(PG8_SA(0, 1), a2 + hstepA, voffA);
            PG8_WAIT_V(8); PG8_WAIT_L(0); PG8_BAR; PG8_MMA(0, 0, At, B0); PG8_MMA(0, 1, At, B1); PG8_BAR; PG8_SCHED;
            PG8_LDA(At, 1, 1); PG8_STAGE(PG8_SB(1, 0), b3, voffB); PG8_STAGE(PG8_SB(1, 1), b3 + hstepB, voffB); PG8_STAGE(PG8_SA(1, 0), a3, voffA);
            PG8_WAIT_V(8); PG8_WAIT_L(0); PG8_BAR; PG8_MMA(1, 0, At, B0); PG8_MMA(1, 1, At, B1); PG8_BAR; PG8_SCHED;
        }
        if (wr == 0) PG8_BAR;
        const int te = tid_opaque(), fr = te & 15, fq = (te & 63) >> 4;
        switch (epi) {
        case 0: { EpiBf16<NP, true> E; E(acc, cur, wr, wc, fr, fq); } break;
        case 1: { EpiBranchFinal E; E(acc, cur, wr, wc, fr, fq); } break;
        case 4: { EpiResid<false> E{layer, row_base}; E(acc, cur, wr, wc, fr, fq); } break;
        case 5: { EpiUpGlu E{layer}; E(acc, cur, wr, wc, fr, fq); } break;
        default: { EpiResid<true> E{layer, row_base}; E(acc, cur, wr, wc, fr, fq); } break;
        }
        if (!has_next) break;
#pragma unroll
        for (int a = 0; a < 2; ++a)
#pragma unroll
            for (int b = 0; b < 2; ++b)
#pragma unroll
                for (int m = 0; m < 4; ++m)
#pragma unroll
                    for (int n = 0; n < 2; ++n) acc[a][b][m][n] = (f32x4){0.f, 0.f, 0.f, 0.f};
        cur = nxt; cA = nA; cB = nB; ++ui;
        if (wr == 1) PG8_BAR;
    }
    PG8_WAIT_V(0);
    PG8_BAR;
#undef PG8_SA
#undef PG8_SB
#undef PG8_STAGE
#undef PG8_LDA
#undef PG8_LDB
#undef PG8_MMA
#undef PG8_WAIT_V
#undef PG8_WAIT_L
#undef PG8_BAR
#undef PG8_SCHED
}
}

__device__ __forceinline__ void tr_item(const float* W, int K, int ldw, int src_col0, int nblk, bf16* WT, int dst_row0, LAS float* scr, int item, int lane) {
    const int kb = item / nblk, nb = item % nblk, k0 = 64 * kb, n0 = 32 * nb;
    float wv_[32];
#pragma unroll
    for (int i = 0; i < 32; ++i) { const int kk = 2 * i + (lane >> 5); wv_[i] = W[(size_t)(k0 + kk) * ldw + src_col0 + n0 + (lane & 31)]; }
#pragma unroll
    for (int i = 0; i < 32; ++i) { const int kk = 2 * i + (lane >> 5); scr[kk * 33 + (lane & 31)] = wv_[i]; }
    asm volatile("s_waitcnt lgkmcnt(0)" ::: "memory");
    const int c = lane & 7;
#pragma unroll
    for (int j = 0; j < 4; ++j) { const int n = (lane >> 3) + 8 * j; const LAS float* s = scr + (8 * c) * 33 + n;
        u32x4 o; o.x = pk2(s[0 * 33], s[1 * 33]); o.y = pk2(s[2 * 33], s[3 * 33]); o.z = pk2(s[4 * 33], s[5 * 33]); o.w = pk2(s[6 * 33], s[7 * 33]);
        *(u32x4*)(WT + (size_t)(dst_row0 + n0 + n) * K + k0 + 8 * c) = o; }
    asm volatile("s_waitcnt lgkmcnt(0)" ::: "memory");
}
__device__ __forceinline__ void p0_prologue(KP p, LAS unsigned char* lds) {
    const int tid = tid_opaque(), lane = tid & 63, wave = __builtin_amdgcn_readfirstlane(tid >> 6);
    LAS float* scr = (LAS float*)(lds + wave * 16384);
    const int gw = bid_opaque() * 8 + wave, NGW = grid_opaque() * 8;
    constexpr int I_A = 16 * 48, I_B = 16 * 128, I_C = 16 * 96, I_BR = 8 * 32, I_O = 16 * 32, I_U = 16 * 176, I_D = 44 * 32;
    constexpr int PER_LAYER = I_A + I_B + I_C + 3 * I_BR + I_O + I_U + I_D;
    for (int it = gw; it < 2 * PER_LAYER; it += NGW) {
        KP pp = kparams();
        const int l = it / PER_LAYER; int r = it % PER_LAYER;
        bf16* WL = (bf16*)(pp->ws + WS_W) + (size_t)l * W_LAYER;
        const float* W; int K, ldw, src0 = 0, nblk, dst0 = 0; size_t wo;
        if (r < I_A) { W = pp->in[5] + (size_t)l * 1024 * NIN; K = 1024; ldw = NIN; src0 = 0; nblk = 48; wo = W_IN; dst0 = 0; }
        else if ((r -= I_A) < I_B) { W = pp->in[5] + (size_t)l * 1024 * NIN; K = 1024; ldw = NIN; src0 = 1544; nblk = 128; wo = W_IN; dst0 = 1536; }
        else if ((r -= I_B) < I_C) { W = pp->in[5] + (size_t)l * 1024 * NIN; K = 1024; ldw = NIN; src0 = 5648; nblk = 96; wo = W_IN; dst0 = 5632; }
        else if ((r -= I_C) < I_BR) { W = pp->in[18] + (size_t)l * 524288; K = 1536; ldw = 1024; nblk = 32; wo = W_BR; }
        else if ((r -= I_BR) < I_BR) { W = pp->in[19] + (size_t)l * 524288; K = 1536; ldw = 1024; nblk = 32; wo = W_BR + 512; }
        else if ((r -= I_BR) < I_BR) { W = pp->in[20] + (size_t)l * 524288; K = 1536; ldw = 1024; nblk = 32; wo = W_BR + 1024; }
        else if ((r -= I_BR) < I_O) { W = pp->in[21] + (size_t)l * 1048576; K = 1024; ldw = 1024; nblk = 32; wo = W_OUT; }
        else if ((r -= I_O) < I_U) { const int kb_ = r / 176, c_ = 32 * (r % 176);
            W = pp->in[23] + (size_t)l * 1024 * FF2; K = 1024; ldw = FF2; src0 = c_; nblk = 1; wo = W_UP; r = kb_;
            dst0 = c_ < FF ? 256 * (c_ >> 7) + (c_ & 127) : 256 * ((c_ - FF) >> 7) + 128 + ((c_ - FF) & 127); }
        else { r -= I_U; W = pp->in[26] + (size_t)l * FF * 1024; K = FF; ldw = 1024; nblk = 32; wo = W_DN; }
        tr_item(W, K, ldw, src0, nblk, WL + wo, dst0, scr, r, lane);
    }
    {
        const int gt = bid_opaque() * 512 + tid, NT = grid_opaque() * 512;
        for (int e = gt; e < 2 * 16 * 1024; e += NT) {
            const int l = e >> 14, r = (e >> 10) & 15, k = e & 1023;
            const int src = r < 8 ? 1536 + r : 5640 + (r - 8);
            bf16* WL = (bf16*)(p->ws + WS_W) + (size_t)l * W_LAYER;
            WL[W_IN + (size_t)(C_SMALL + r) * 1024 + k] = (bf16)pk1(p->in[5][(size_t)l * 1024 * NIN + (size_t)k * NIN + src]);
        }
    }
    __syncthreads();
    LAS float* cact = (LAS float*)lds;
    LAS float* part = (LAS float*)(lds + 65536);
    bool loaded = false;
    for (int it = bid_opaque(); it < 192; it += grid_opaque()) {
        if (!loaded) { for (int e = tid; e < 16384; e += 512) cact[e] = silu_f(p->in[1][e]); loaded = true; }
        __syncthreads();
        const int l = it / 96, n0 = (it % 96) * 64;
        const float* W = p->in[2] + (size_t)l * 1024 * 6144 + n0 + lane;
        float acc[16];
#pragma unroll
        for (int b = 0; b < 16; ++b) acc[b] = 0.f;
        for (int k16 = 0; k16 < 8; ++k16) {
            const int kb_ = wave * 128 + k16 * 16;
            float wr_[16];
#pragma unroll
            for (int i = 0; i < 16; ++i) wr_[i] = W[(size_t)(kb_ + i) * 6144];
#pragma unroll
            for (int q = 0; q < 4; ++q)
#pragma unroll
                for (int b = 0; b < 16; ++b) { const f32x4 cv = *(const LAS f32x4*)(cact + b * 1024 + kb_ + 4 * q); acc[b] += cv[0] * wr_[4 * q] + cv[1] * wr_[4 * q + 1] + cv[2] * wr_[4 * q + 2] + cv[3] * wr_[4 * q + 3]; }
        }
#pragma unroll
        for (int b = 0; b < 16; ++b) part[(wave * 16 + b) * 64 + lane] = acc[b];
        __syncthreads();
        for (int e = tid; e < 1024; e += 512) { const int b = e >> 6, j = e & 63; float s = 0.f;
#pragma unroll
            for (int w = 0; w < 8; ++w) s += part[(w * 16 + b) * 64 + j];
            ((float*)(p->ws + WS_MOD))[(size_t)(l * 16 + b) * 6144 + n0 + j] = s + p->in[3][(size_t)l * 6144 + n0 + j]; }
    }
}

__device__ __forceinline__ void norm_mod_phase(const float* src  , int row_base, const float* nw, const float* shift, const float* scale, bf16* dst, const bf16* wsmall  , float* smout  ) {
    const int tid_ = tid_opaque(), lane = tid_ & 63, wave = __builtin_amdgcn_readfirstlane(tid_ >> 6);
    const int gw = bid_opaque() * 8 + wave, NGW = grid_opaque() * 8;
    const int rpw = (MH + NGW - 1) / NGW, r0 = gw * rpw, r1 = r0 + rpw < MH ? r0 + rpw : MH;
    if (r0 >= r1) return;
    f32x4 wm[4], sh[4]; int bcur = -1;
    f32x4 v[4], vn[4];
    { const f32x4* xr = (const f32x4*)(src + (size_t)r0 * 1024) + lane;
#pragma unroll
      for (int j = 0; j < 4; ++j) vn[j] = xr[64 * j]; }
    for (int r = r0; r < r1; ++r) {
#pragma unroll
        for (int j = 0; j < 4; ++j) v[j] = vn[j];
        if (r + 1 < r1) { const f32x4* xr = (const f32x4*)(src + (size_t)(r + 1) * 1024) + lane;
#pragma unroll
            for (int j = 0; j < 4; ++j) vn[j] = xr[64 * j]; }
        const int b = (row_base + r) / SEQ;
        if (b != bcur) { bcur = b;
            f32x4 t0[4], t1[4];
#pragma unroll
            for (int j = 0; j < 4; ++j) { const int c = 4 * lane + 256 * j; t0[j] = *(const f32x4*)(nw + c); t1[j] = *(const f32x4*)(scale + (size_t)b * 6144 + c); sh[j] = *(const f32x4*)(shift + (size_t)b * 6144 + c); }
#pragma unroll
            for (int j = 0; j < 4; ++j) wm[j] = t0[j] * (t1[j] + 1.f); }
        float s = 0.f;
#pragma unroll
        for (int j = 0; j < 4; ++j) s += (v[j][0] * v[j][0] + v[j][1] * v[j][1]) + (v[j][2] * v[j][2] + v[j][3] * v[j][3]);
        const float rstd = rsqrtf(wave_sum(s) * (1.f / 1024.f) + EPS);
        u32x2* o8 = (u32x2*)(dst + (size_t)r * 1024) + lane;
#pragma unroll
        for (int j = 0; j < 4; ++j) { const f32x4 y = v[j] * rstd * wm[j] + sh[j]; u32x2 o; o.x = pk2(y[0], y[1]); o.y = pk2(y[2], y[3]); o8[64 * j] = o; }
    }
    if (wsmall != nullptr && rpw == 16) {
        asm volatile("s_waitcnt vmcnt(0)" ::: "memory");
        const int r16 = lane & 15, q4 = lane >> 4;
        const bf16* ap = dst + (size_t)(r0 + r16) * 1024 + q4 * 8; const bf16* bp = wsmall + (size_t)r16 * 1024 + q4 * 8;
        f32x4 acc = (f32x4){0.f, 0.f, 0.f, 0.f};
#pragma unroll 1
        for (int kb = 0; kb < 4; ++kb) {
            bf16x8 af[8], bfr[8];
#pragma unroll
            for (int i = 0; i < 8; ++i) { af[i] = *(const bf16x8*)(ap + (kb * 8 + i) * 32); bfr[i] = *(const bf16x8*)(bp + (kb * 8 + i) * 32); }
#pragma unroll
            for (int i = 0; i < 8; ++i) acc = __builtin_amdgcn_mfma_f32_16x16x32_bf16(af[i], bfr[i], acc, 0, 0, 0);
        }
#pragma unroll
        for (int j = 0; j < 4; ++j) smout[(size_t)(r0 + 4 * q4 + j) * 16 + r16] = acc[j];
    }
}

#define LBAR() do { asm volatile("s_waitcnt lgkmcnt(0)" ::: "memory"); __builtin_amdgcn_s_barrier(); asm volatile("" ::: "memory"); } while (0)

constexpr int HG_QS = 0, HG_KS = 17408, HG_QG = 34816, HG_KET = 52224, HG_GEND = 68608, HG_VT = 70656, HG_SB = 89088, HG_END = 123904;
static_assert(HG_END <= LDS_BYTES, "HGRN LDS map");
__device__ __forceinline__ bf16x8 mk_frag(unsigned a, unsigned b, unsigned c, unsigned d) { u32x4 u; u.x = a; u.y = b; u.z = c; u.w = d; return __builtin_bit_cast(bf16x8, u); }
__device__ __forceinline__ void hgrn_unit(KP p, int idx, int layer, LAS unsigned char* L0) {
    LAS unsigned char* L = lds_opaque(L0);
    const int tid = tid_opaque(), lane = tid & 63, wave = __builtin_amdgcn_readfirstlane(tid >> 6);
    const int bl = idx >> 3, h = (idx >> 1) & 3, dvh = idx & 1; const bool act = wave < 4; const int dvt = dvh * 4 + (wave & 3);
    const bf16* P = (const bf16*)(p->ws + WS_PROJ) + (size_t)bl * SEQ * NP;
    bf16* OR = (bf16*)(p->ws + WS_ORAW) + (size_t)bl * SEQ * OC + 512 + h * 128 + dvt * 16;
    const int pk = tid & 127, psub = tid >> 7;
    float lb = 0.f;
    if (layer == 1) { const float* lp = p->in[10]; lb = sigmoid_f(lp[512 + h * 128 + pk] - lp[h * 128 + pk]); }
    const int r16 = lane & 15, q4 = lane >> 4;
    f32x4 S[8];
#pragma unroll
    for (int i = 0; i < 8; ++i) S[i] = (f32x4){0.f, 0.f, 0.f, 0.f};
    { LAS unsigned char* SB = L + HG_SB + wave * 4352; for (int i = lane; i < 1088; i += 64) ((LAS unsigned*)SB)[i] = 0u; }
    unsigned rq[16], rf[16], rv[16];
    unsigned pq[8], pks[8], pqg[8], ke[8]; float gendv = 0.f;
#define HG_LOAD(mcx) do { if ((mcx) < 64) { const bf16* src_ = P + (size_t)((mcx) * 64 + psub * 16) * NP + h * 128 + pk; \
        _Pragma("unroll") for (int i = 0; i < 16; ++i) { rq[i] = src_[(size_t)i * NP + C_HQ]; rf[i] = src_[(size_t)i * NP + C_HF]; } \
        if (act) { const bf16* srv_ = P + (size_t)((mcx) * 64 + q4 * 16) * NP + C_HI + h * 128 + dvt * 16 + r16; \
            _Pragma("unroll") for (int i = 0; i < 16; ++i) rv[i] = srv_[(size_t)i * NP]; } } } while (0)
#define HG_COMPUTE() do { float qv[16], kv[16], G[16]; float run = 0.f; \
        _Pragma("unroll") for (int i = 0; i < 16; ++i) { const float qr = bf2f(rq[i]), fr = bf2f(rf[i]); const float sg = sigmoid_f(fr), f = lb + (1.f - lb) * sg; \
            run += __logf(f); G[i] = run; kv[i] = (1.f - lb) * (1.f - sg); qv[i] = silu_f(qr); } \
        const float Gref = G[7], Gend = G[15]; const float eref = __expf(Gref), c2 = __expf(Gend - Gref); \
        _Pragma("unroll") for (int i = 0; i < 8; ++i) { \
            const float e1a = __expf(G[2 * i] - Gref), r1a = __builtin_amdgcn_rcpf(e1a), e1b = __expf(G[2 * i + 1] - Gref), r1b = __builtin_amdgcn_rcpf(e1b); \
            pq[i] = pk2(qv[2 * i] * e1a, qv[2 * i + 1] * e1b); pks[i] = pk2(kv[2 * i] * r1a, kv[2 * i + 1] * r1b); \
            pqg[i] = pk2(qv[2 * i] * e1a * eref, qv[2 * i + 1] * e1b * eref); ke[i] = pk2(kv[2 * i] * r1a * c2, kv[2 * i + 1] * r1b * c2); } \
        gendv = __expf(Gend); } while (0)
#define HG_WRITE() do { _Pragma("unroll") for (int i = 0; i < 8; ++i) { const int t_ = psub * 16 + 2 * i; \
            *(LAS bf16*)(L + HG_QS + t_ * 272 + pk * 2) = (bf16)(pq[i] & 0xffffu); *(LAS bf16*)(L + HG_QS + (t_ + 1) * 272 + pk * 2) = (bf16)(pq[i] >> 16); \
            *(LAS bf16*)(L + HG_KS + t_ * 272 + pk * 2) = (bf16)(pks[i] & 0xffffu); *(LAS bf16*)(L + HG_KS + (t_ + 1) * 272 + pk * 2) = (bf16)(pks[i] >> 16); \
            *(LAS bf16*)(L + HG_QG + t_ * 272 + pk * 2) = (bf16)(pqg[i] & 0xffffu); *(LAS bf16*)(L + HG_QG + (t_ + 1) * 272 + pk * 2) = (bf16)(pqg[i] >> 16); } \
        LAS u32x4* kd_ = (LAS u32x4*)(L + HG_KET + (psub * 128 + pk) * 32); kd_[0] = (u32x4){ke[0], ke[1], ke[2], ke[3]}; kd_[1] = (u32x4){ke[4], ke[5], ke[6], ke[7]}; \
        *(LAS float*)(L + HG_GEND + (psub * 128 + pk) * 4) = gendv; } while (0)
    if (act) __builtin_amdgcn_s_setprio(2);
    HG_LOAD(0);
    if (!act) { HG_COMPUTE(); HG_LOAD(1); }
    for (int mc = 0; mc < 64; ++mc) {
        L = lds_opaque(L0);
        LAS unsigned char* VT = L + HG_VT + wave * 2304;
        LAS unsigned char* SB = L + HG_SB + wave * 4352;
        LBAR();
        if (act) {
            HG_COMPUTE(); HG_WRITE();
            {
                unsigned w[8];
#pragma unroll
                for (int i = 0; i < 8; ++i) w[i] = rv[2 * i] | (rv[2 * i + 1] << 16);
                LAS u32x4* vd = (LAS u32x4*)(VT + r16 * 144 + q4 * 32);
                vd[0] = (u32x4){w[0], w[1], w[2], w[3]}; vd[1] = (u32x4){w[4], w[5], w[6], w[7]};
            }
            HG_LOAD(mc + 1);
        } else {
            HG_WRITE();
        }
        LBAR();
        if (!act) { if (mc + 1 < 64) { HG_COMPUTE(); HG_LOAD(mc + 2); } }
        else
#pragma unroll 1
        for (int sb = 0; sb < 4; ++sb) {
            const int t0 = sb * 16;
            f32x4 sc = (f32x4){0.f, 0.f, 0.f, 0.f};
#pragma unroll
            for (int kk = 0; kk < 4; ++kk) {
                const bf16x8 a = *(const LAS bf16x8*)(L + HG_KS + (t0 + r16) * 272 + kk * 64 + q4 * 16);
                const bf16x8 b = *(const LAS bf16x8*)(L + HG_QS + (t0 + r16) * 272 + kk * 64 + q4 * 16);
                sc = __builtin_amdgcn_mfma_f32_16x16x32_bf16(a, b, sc, 0, 0, 0);
            }
#pragma unroll
            for (int j = 0; j < 4; ++j) if (4 * q4 + j > r16) sc[j] = 0.f;
            const bf16x8 a2 = mk_frag(pk2(sc[0], sc[1]), pk2(sc[2], sc[3]), 0u, 0u);
            const u32x2 vv = *(const LAS u32x2*)(VT + r16 * 144 + (t0 + 4 * q4) * 2);
            const bf16x8 b2 = mk_frag(vv.x, vv.y, 0u, 0u);
            f32x4 o = __builtin_amdgcn_mfma_f32_16x16x32_bf16(a2, b2, (f32x4){0.f, 0.f, 0.f, 0.f}, 0, 0, 0);
#pragma unroll
            for (int kk = 0; kk < 4; ++kk) {
                const bf16x8 a = *(const LAS bf16x8*)(L + HG_QG + (t0 + r16) * 272 + kk * 64 + q4 * 16);
                const bf16x8 b = *(const LAS bf16x8*)(SB + r16 * 272 + kk * 64 + q4 * 16);
                o = __builtin_amdgcn_mfma_f32_16x16x32_bf16(a, b, o, 0, 0, 0);
            }
            bf16* orow = OR + (size_t)(mc * 64 + t0 + 4 * q4) * OC + r16;
#pragma unroll
            for (int j = 0; j < 4; ++j) orow[(size_t)j * OC] = (bf16)pk1(o[j]);
#pragma unroll
            for (int kt = 0; kt < 8; ++kt) {
                const u32x2 ke = *(const LAS u32x2*)(L + HG_KET + (sb * 128 + kt * 16 + r16) * 32 + q4 * 8);
                const f32x4 ge = *(const LAS f32x4*)(L + HG_GEND + (sb * 128 + kt * 16 + 4 * q4) * 4);
                S[kt] = __builtin_amdgcn_mfma_f32_16x16x32_bf16(mk_frag(ke.x, ke.y, 0u, 0u), b2, S[kt] * ge, 0, 0, 0);
                *(LAS u32x2*)(SB + r16 * 272 + (kt * 16 + 4 * q4) * 2) = (u32x2){pk2(S[kt][0], S[kt][1]), pk2(S[kt][2], S[kt][3])};
            }
        }
    }
    __builtin_amdgcn_s_setprio(0);
    LBAR();
}


#undef HG_LOAD
#undef HG_COMPUTE
#undef HG_WRITE
constexpr int SD_CS = 0, SD_BS = 17408, SD_BT = 34816, SD_CBS = 53248  , SD_SC = SD_CBS + 2 * 9216, SD_PRIV = SD_SC + 1024, SD_PRIV_SZ = 8960, SD_END = SD_PRIV + 8 * SD_PRIV_SZ;
static_assert(SD_END <= LDS_BYTES, "SSD LDS map");
__device__ __forceinline__ void ssd_unit(KP p, int idx, int layer, LAS unsigned char* L0) {
    LAS unsigned char* L = lds_opaque(L0);
    const int tid = tid_opaque(), lane = tid & 63, wave = __builtin_amdgcn_readfirstlane(tid >> 6);
    const int r16 = lane & 15, q4 = lane >> 4;
    const int bl = idx >> 3, head = idx & 7, g = head >> 2;
    const int hh = 0, pt = wave & 3; const bool act = wave < 4;
    const bf16* P = (const bf16*)(p->ws + WS_PROJ) + (size_t)bl * SEQ * NP;
    const float* SM = (const float*)(p->ws + WS_SM) + (size_t)bl * SEQ * 16;
    bf16* OR = (bf16*)(p->ws + WS_ORAW) + (size_t)bl * SEQ * OC + 1024 + head * 64 + pt * 16;
    const int pc = tid & 255, phalf = tid >> 8, pn = pc & 127; const bool isB = pc >= 128;
    const int xi = (isB ? 512 : 768) + g * 128 + pn;
    const float* cwp = p->in[12] + (size_t)layer * 4096; const float* cbp = p->in[13] + (size_t)layer * 1024;
    const float cw0 = cwp[xi], cw1 = cwp[1024 + xi], cw2 = cwp[2048 + xi], cw3 = cwp[3072 + xi], cb = cbp[xi];
    const int xp = head * 64 + pt * 16 + r16;
    const float xw0 = cwp[xp], xw1 = cwp[1024 + xp], xw2 = cwp[2048 + xp], xw3 = cwp[3072 + xp], xb_ = cbp[xp];
    const float A_h = -__expf(p->in[14][layer * 8 + head]), dtb = p->in[15][layer * 8 + head], Dh = p->in[16][layer * 8 + head];
    f32x4 H[8];
#pragma unroll
    for (int i = 0; i < 8; ++i) H[i] = (f32x4){0.f, 0.f, 0.f, 0.f};
    { LAS unsigned char* HB = L + SD_PRIV + wave * SD_PRIV_SZ + 4608; for (int i = lane; i < 1088; i += 64) ((LAS unsigned*)HB)[i] = 0u; }
    unsigned rs[35], rx[19];
    {
        const bf16* src = P + (size_t)(phalf * 32) * NP + C_XBC + xi;
#pragma unroll
        for (int i = 0; i < 35; ++i) rs[i] = (phalf * 32 - 3 + i >= 0) ? (unsigned)src[(long)(i - 3) * NP] : 0u;
        const bf16* srx = P + (size_t)(q4 * 16) * NP + C_XBC + xp;
#pragma unroll
        for (int i = 0; i < 19; ++i) rx[i] = (act && q4 * 16 - 3 + i >= 0) ? (unsigned)srx[(long)(i - 3) * NP] : 0u;
    }
    for (int c = 0; c < 64; ++c) {
        L = lds_opaque(L0);
        LAS unsigned char* XT = L + SD_PRIV + wave * SD_PRIV_SZ; LAS unsigned char* XDT = XT + 2304; LAS unsigned char* HB = XT + 4608;
        LAS float* ACS = (LAS float*)(L + SD_SC) + hh * 64; LAS float* DT = (LAS float*)(L + SD_SC) + 128 + hh * 64;
        LBAR();
        {
            float x[35];
#pragma unroll
            for (int i = 0; i < 35; ++i) x[i] = bf2f(rs[i]);
            unsigned pkd[16]; unsigned lo = 0;
            LAS unsigned char* dst = L + (isB ? SD_BS : SD_CS) + (phalf * 32) * 272 + pn * 2;
#pragma unroll
            for (int j = 0; j < 32; ++j) {
                const unsigned b = f2bf(silu_f(cw0 * x[j] + cw1 * x[j + 1] + cw2 * x[j + 2] + cw3 * x[j + 3] + cb));
                *(LAS bf16*)(dst + j * 272) = (bf16)b;
                if (j & 1) pkd[j >> 1] = lo | (b << 16); else lo = b;
            }
            if (isB) { LAS u32x4* bt = (LAS u32x4*)(L + SD_BT + pn * 144 + phalf * 64);
#pragma unroll
                for (int i = 0; i < 4; ++i) bt[i] = (u32x4){pkd[4 * i], pkd[4 * i + 1], pkd[4 * i + 2], pkd[4 * i + 3]}; }
        }
        if (wave == 0) {
            const float dtv = softplus_f(SM[(size_t)(c * 64 + lane) * 16 + 8 + head] + dtb);
            const float v = wave_scan_incl(dtv * A_h, lane);
            ACS[lane] = v; DT[lane] = dtv;
        }
        float xv[16];
        if (act) {
            float x[19];
#pragma unroll
            for (int i = 0; i < 19; ++i) x[i] = bf2f(rx[i]);
#pragma unroll
            for (int j = 0; j < 16; ++j) xv[j] = silu_f(xw0 * x[j] + xw1 * x[j + 1] + xw2 * x[j + 2] + xw3 * x[j + 3] + xb_);
        }
        if (c + 1 < 64) {
            const bf16* src = P + (size_t)((c + 1) * 64 + phalf * 32) * NP + C_XBC + xi;
#pragma unroll
            for (int i = 0; i < 35; ++i) rs[i] = src[(long)(i - 3) * NP];
            if (act) { const bf16* srx = P + (size_t)((c + 1) * 64 + q4 * 16) * NP + C_XBC + xp;
#pragma unroll
                for (int i = 0; i < 19; ++i) rx[i] = srx[(long)(i - 3) * NP]; }
        }
        LBAR();
        if (act) {
            unsigned a[8], b[8];
#pragma unroll
            for (int i = 0; i < 4; ++i) { const f32x4 d = *(const LAS f32x4*)(DT + q4 * 16 + 4 * i);
                a[2 * i] = pk2(xv[4 * i], xv[4 * i + 1]); a[2 * i + 1] = pk2(xv[4 * i + 2], xv[4 * i + 3]);
                b[2 * i] = pk2(xv[4 * i] * d[0], xv[4 * i + 1] * d[1]); b[2 * i + 1] = pk2(xv[4 * i + 2] * d[2], xv[4 * i + 3] * d[3]); }
            LAS u32x4* xd = (LAS u32x4*)(XT + r16 * 144 + q4 * 32); xd[0] = (u32x4){a[0], a[1], a[2], a[3]}; xd[1] = (u32x4){a[4], a[5], a[6], a[7]};
            LAS u32x4* yd = (LAS u32x4*)(XDT + r16 * 144 + q4 * 32); yd[0] = (u32x4){b[0], b[1], b[2], b[3]}; yd[1] = (u32x4){b[4], b[5], b[6], b[7]};
        }
        {
            const int tl = wave & 3;
            const LAS float* AC0 = (const LAS float*)(L + SD_SC);
            const f32x4 al0 = *(const LAS f32x4*)(AC0 + 16 * tl + 4 * q4);
#pragma unroll
            for (int u = 0; u < 2; ++u) { const int ts = 2 * (wave >> 2) + u;
                f32x4 acc = (f32x4){0.f, 0.f, 0.f, 0.f};
#pragma unroll
                for (int kk = 0; kk < 4; ++kk) {
                    const bf16x8 a = *(const LAS bf16x8*)(L + SD_CS + (16 * tl + r16) * 272 + kk * 64 + q4 * 16);
                    const bf16x8 b = *(const LAS bf16x8*)(L + SD_BS + (16 * ts + r16) * 272 + kk * 64 + q4 * 16);
                    acc = __builtin_amdgcn_mfma_f32_16x16x32_bf16(a, b, acc, 0, 0, 0);
                }
                const int sidx = 16 * ts + r16; const float as0 = AC0[sidx];
#pragma unroll
                for (int j = 0; j < 4; ++j) { const int l = 16 * tl + 4 * q4 + j;
                    *(LAS bf16*)(L + SD_CBS + l * 144 + sidx * 2) = (bf16)pk1(sidx <= l ? acc[j] * __expf(fminf(al0[j] - as0, 0.f)) : 0.f); }
            }
        }
        LBAR();
        if (act) {
        const float acs_last = ACS[63];
        const bf16x8 xb0 = *(const LAS bf16x8*)(XDT + r16 * 144 + q4 * 16), xb1 = *(const LAS bf16x8*)(XDT + r16 * 144 + 64 + q4 * 16);
#pragma unroll 1
        for (int tl = 0; tl < 4; ++tl) {
            f32x4 acc = (f32x4){0.f, 0.f, 0.f, 0.f};
#pragma unroll
            for (int kk = 0; kk < 4; ++kk) {
                const bf16x8 a = *(const LAS bf16x8*)(L + SD_CS + (16 * tl + r16) * 272 + kk * 64 + q4 * 16);
                const bf16x8 b = *(const LAS bf16x8*)(HB + r16 * 272 + kk * 64 + q4 * 16);
                acc = __builtin_amdgcn_mfma_f32_16x16x32_bf16(a, b, acc, 0, 0, 0);
            }
            const f32x4 al = *(const LAS f32x4*)(ACS + 16 * tl + 4 * q4);
#pragma unroll
            for (int j = 0; j < 4; ++j) acc[j] *= __expf(al[j]);
            acc = __builtin_amdgcn_mfma_f32_16x16x32_bf16(*(const LAS bf16x8*)(L + SD_CBS + hh * 9216 + (16 * tl + r16) * 144 + q4 * 16), xb0, acc, 0, 0, 0);
            if (tl >= 2) acc = __builtin_amdgcn_mfma_f32_16x16x32_bf16(*(const LAS bf16x8*)(L + SD_CBS + hh * 9216 + (16 * tl + r16) * 144 + 64 + q4 * 16), xb1, acc, 0, 0, 0);
            const u32x2 xs = *(const LAS u32x2*)(XT + r16 * 144 + (16 * tl + 4 * q4) * 2);
            acc[0] += Dh * bflo(xs.x); acc[1] += Dh * bfhi(xs.x); acc[2] += Dh * bflo(xs.y); acc[3] += Dh * bfhi(xs.y);
            bf16* orow = OR + (size_t)(c * 64 + 16 * tl + 4 * q4) * OC + r16;
#pragma unroll
            for (int j = 0; j < 4; ++j) orow[(size_t)j * OC] = (bf16)pk1(acc[j]);
        }
        {
            bf16x8 xe[2];
#pragma unroll
            for (int kk = 0; kk < 2; ++kk) {
                const u32x4 xw = __builtin_bit_cast(u32x4, kk == 0 ? xb0 : xb1);
                const f32x4 s0 = *(const LAS f32x4*)(ACS + kk * 32 + 8 * q4), s1 = *(const LAS f32x4*)(ACS + kk * 32 + 8 * q4 + 4);
                float v[8];
                v[0] = bflo(xw.x); v[1] = bfhi(xw.x); v[2] = bflo(xw.y); v[3] = bfhi(xw.y); v[4] = bflo(xw.z); v[5] = bfhi(xw.z); v[6] = bflo(xw.w); v[7] = bfhi(xw.w);
#pragma unroll
                for (int e = 0; e < 8; ++e) { const float as = e < 4 ? s0[e & 3] : s1[e & 3]; v[e] *= __expf(acs_last - as); }
                xe[kk] = mk_frag(pk2(v[0], v[1]), pk2(v[2], v[3]), pk2(v[4], v[5]), pk2(v[6], v[7]));
            }
            const float eh = __expf(acs_last);
#pragma unroll
            for (int nt = 0; nt < 8; ++nt) {
                H[nt] = H[nt] * eh;
#pragma unroll
                for (int kk = 0; kk < 2; ++kk) {
                    const bf16x8 a = *(const LAS bf16x8*)(L + SD_BT + (16 * nt + r16) * 144 + kk * 64 + q4 * 16);
                    H[nt] = __builtin_amdgcn_mfma_f32_16x16x32_bf16(a, xe[kk], H[nt], 0, 0, 0);
                }
                *(LAS u32x2*)(HB + r16 * 272 + (16 * nt + 4 * q4) * 2) = (u32x2){pk2(H[nt][0], H[nt][1]), pk2(H[nt][2], H[nt][3])};
            }
        }
        }
    }
    LBAR();
}


constexpr int GD_QN = 0, GD_KN = 17408, GD_VN = 34816, GD_MT = 52224, GD_KET = 68608, GD_SC = 87040, GD_PRIV = 88064, GD_PRIV_SZ = 6656, GD_WL = GD_PRIV + 8 * GD_PRIV_SZ, GD_END = GD_WL + 6144;
static_assert(GD_END <= LDS_BYTES, "GDN LDS map");
typedef float f32x2 __attribute__((ext_vector_type(2)));
__device__ __forceinline__ float red8(float v) { v += dppf<0xB1>(v); v += dppf<0x4E>(v); v += dppf<0x141>(v); return v; }
__device__ __forceinline__ float bfel(const u32x4& a, const u32x4& b, int c) { const u32x4& v = (c < 8) ? a : b; const unsigned w = v[(c & 7) >> 1]; return (c & 1) ? bfhi(w) : bflo(w); }
constexpr size_t AUXA_UNIT = 32768, AUXB_UNIT = 40960;
constexpr size_t WS_GE = 920 * 1024;
constexpr int GCNT_WORD = 3648;
constexpr int GCNT_UNUSED = 3584;
__device__ __forceinline__ void gdn1_load_rows(KP p, int u, u32x4 (&xr)[3][4][2]) {
    const int tid0 = tid_opaque(); const int bl = u >> 8, h = (u >> 6) & 3, c = u & 63, t = tid0 >> 3;
    const bf16* Pu = (const bf16*)(p->ws + WS_PROJ) + (size_t)bl * SEQ * NP + h * 128 + (tid0 & 7) * 16;
#pragma unroll
    for (int mat = 0; mat < 3; ++mat)
#pragma unroll
        for (int i = 0; i < 4; ++i) {
            if (c * 64 + t - 3 + i >= 0) { const bf16* src = Pu + (long)(c * 64 + t - 3 + i) * NP + mat * 512; xr[mat][i][0] = *(const u32x4*)src; xr[mat][i][1] = *(const u32x4*)(src + 8); }
            else { xr[mat][i][0] = (u32x4){0u, 0u, 0u, 0u}; xr[mat][i][1] = (u32x4){0u, 0u, 0u, 0u}; }
        }
}
__device__ __forceinline__ void gdn1_unit(KP p, int u, int layer, LAS unsigned char* L0, u32x4 (&xr)[3][4][2], bool load_w, int u_next) {
    LAS unsigned char* L = lds_opaque(L0);
    const int tid0 = tid_opaque(), wave = __builtin_amdgcn_readfirstlane(tid0 >> 6);
    const int bl = u >> 8, h = (u >> 6) & 3, c = u & 63;
    const float sA = __builtin_bit_cast(float, __builtin_amdgcn_readfirstlane(__builtin_bit_cast(int, -__expf(p->in[7][layer * 4 + h])))), sB = __builtin_bit_cast(float, __builtin_amdgcn_readfirstlane(__builtin_bit_cast(int, p->in[8][layer * 4 + h])));
    LBAR();
    if (load_w) {
        const float* cwp = p->in[6] + (size_t)layer * 4 * 1536;
        for (int e = tid0; e < 1536; e += 512) { const int mat = e >> 9, k = (e >> 7) & 3, col = e & 127; *(LAS float*)(L + GD_WL + e * 4) = cwp[k * 1536 + mat * 512 + h * 128 + col]; }
        LBAR();
    }
    {
        LAS float* GC = (LAS float*)(L + GD_SC); LAS float* BETA = GC + 64;
        {
            const int tid = tid_opaque();
            const int t = tid >> 3, seg = tid & 7;
#pragma unroll
            for (int mat = 0; mat < 3; ++mat) {
                float y[16]; float ss = 0.f;
#pragma unroll
                for (int cg = 0; cg < 4; ++cg) {
                    const LAS float* wl = (const LAS float*)(L + GD_WL) + mat * 512 + seg * 16 + 4 * cg;
                    const f32x4 w0 = *(const LAS f32x4*)(wl), w1 = *(const LAS f32x4*)(wl + 128), w2 = *(const LAS f32x4*)(wl + 256), w3 = *(const LAS f32x4*)(wl + 384);
#pragma unroll
                    for (int e = 0; e < 4; ++e) { const int ci = 4 * cg + e;
                        const float v = silu_f(w0[e] * bfel(xr[mat][0][0], xr[mat][0][1], ci) + w1[e] * bfel(xr[mat][1][0], xr[mat][1][1], ci) + w2[e] * bfel(xr[mat][2][0], xr[mat][2][1], ci) + w3[e] * bfel(xr[mat][3][0], xr[mat][3][1], ci));
                        y[ci] = v; ss += v * v; }
                }
                float r = 1.f;
                if (mat < 2) { ss = red8(ss); r = rsqrtf(ss + EPS) * (mat == 0 ? 0.08838834764831845f : 1.f); }
                LAS u32x4* d = (LAS u32x4*)(L + (mat == 0 ? GD_QN : mat == 1 ? GD_KN : GD_VN) + t * 272 + seg * 32);
                d[0] = (u32x4){pk2(y[0] * r, y[1] * r), pk2(y[2] * r, y[3] * r), pk2(y[4] * r, y[5] * r), pk2(y[6] * r, y[7] * r)};
                d[1] = (u32x4){pk2(y[8] * r, y[9] * r), pk2(y[10] * r, y[11] * r), pk2(y[12] * r, y[13] * r), pk2(y[14] * r, y[15] * r)};
            }
        }
        if (wave == 0) {
            const int tid = tid_opaque(), lane = tid & 63, r16 = lane & 15, q4 = lane >> 4; (void)r16; (void)q4; (void)lane;
            KP pp = kparams(); const float* sm = (const float*)(pp->ws + WS_SM) + ((size_t)bl * SEQ + c * 64 + lane) * 16;
            const float v = wave_scan_incl(sA * softplus_f(sm[h] + sB), lane);
            GC[lane] = v; BETA[lane] = sigmoid_f(sm[4 + h]);
        }
        LBAR();
        f32x4 at[2];
        {
            const int tid = tid_opaque(), lane = tid & 63, r16 = lane & 15, q4 = lane >> 4; (void)r16; (void)q4; (void)lane;
            const int tl = wave & 3;
            const f32x4 gl = *(const LAS f32x4*)(GC + 16 * tl + 4 * q4), bl4 = *(const LAS f32x4*)(BETA + 16 * tl + 4 * q4);
#pragma unroll
            for (int u = 0; u < 2; ++u) { const int ts = 2 * (wave >> 2) + u;
                f32x4 kk = (f32x4){0.f, 0.f, 0.f, 0.f}, qk = (f32x4){0.f, 0.f, 0.f, 0.f};
#pragma unroll
                for (int k4 = 0; k4 < 4; ++k4) {
                    const bf16x8 b = *(const LAS bf16x8*)(L + GD_KN + (16 * ts + r16) * 272 + k4 * 64 + q4 * 16);
                    const bf16x8 ak = *(const LAS bf16x8*)(L + GD_KN + (16 * tl + r16) * 272 + k4 * 64 + q4 * 16);
                    const bf16x8 aq = *(const LAS bf16x8*)(L + GD_QN + (16 * tl + r16) * 272 + k4 * 64 + q4 * 16);
                    kk = __builtin_amdgcn_mfma_f32_16x16x32_bf16(ak, b, kk, 0, 0, 0);
                    qk = __builtin_amdgcn_mfma_f32_16x16x32_bf16(aq, b, qk, 0, 0, 0);
                }
                const int sidx = 16 * ts + r16; const float gs = GC[sidx];
                f32x4 m;
#pragma unroll
                for (int j = 0; j < 4; ++j) { const int l = 16 * tl + 4 * q4 + j; const float dec = __expf(fminf(gl[j] - gs, 0.f));
                    m[j] = (sidx < l) ? bl4[j] * kk[j] * dec : 0.f; qk[j] = (sidx <= l) ? qk[j] * dec : 0.f; }
                *(LAS f32x4*)(L + GD_MT + sidx * 256 + (16 * tl + 4 * q4) * 4) = m;
                at[u] = qk;
            }
        }
        LBAR();
        f32x2 acc2[32];
        if (wave < 4) {
            const int tid = tid_opaque(), lane = tid & 63, r16 = lane & 15, q4 = lane >> 4; (void)r16; (void)q4; (void)lane;
            const LAS unsigned char* rb = L + (tid < 128 ? GD_VN : GD_KN) + (tid & 127) * 2;
#pragma unroll
            for (int l4 = 0; l4 < 16; ++l4) {
                const f32x4 b4 = *(const LAS f32x4*)(BETA + 4 * l4); f32x4 g4 = (f32x4){1.f, 1.f, 1.f, 1.f};
                if (tid >= 128) { const f32x4 gg = *(const LAS f32x4*)(GC + 4 * l4); g4 = (f32x4){__expf(gg[0]), __expf(gg[1]), __expf(gg[2]), __expf(gg[3])}; }
                acc2[2 * l4] = (f32x2){bf2f(*(const LAS bf16*)(rb + (4 * l4) * 272)) * b4[0] * g4[0], bf2f(*(const LAS bf16*)(rb + (4 * l4 + 1) * 272)) * b4[1] * g4[1]};
                acc2[2 * l4 + 1] = (f32x2){bf2f(*(const LAS bf16*)(rb + (4 * l4 + 2) * 272)) * b4[2] * g4[2], bf2f(*(const LAS bf16*)(rb + (4 * l4 + 3) * 272)) * b4[3] * g4[3]};
            }
#pragma unroll
            for (int s_ = 0; s_ < 63; ++s_) {
                const float xs = (s_ & 1) ? acc2[s_ >> 1][1] : acc2[s_ >> 1][0]; const f32x2 xs2 = (f32x2){xs, xs};
#pragma unroll
                for (int l4 = ((s_ + 1) >> 2) << 2; l4 < 64; l4 += 4) {
                    const f32x4 m = *(const LAS f32x4*)(L + GD_MT + s_ * 256 + l4 * 4);
                    acc2[l4 >> 1] -= (f32x2){m[0], m[1]} * xs2;
                    acc2[(l4 >> 1) + 1] -= (f32x2){m[2], m[3]} * xs2;
                }
            }
        } else {
            const int tid = tid_opaque(), lane = tid & 63, r16 = lane & 15, q4 = lane >> 4; (void)r16; (void)q4; (void)lane;
            const int tt = tid - 256, t = tt >> 2, sg = tt & 3;
            const float gt = GC[t]; const float eg = __expf(gt), ee = __expf(GC[63] - gt);
            LAS u32x4* qp = (LAS u32x4*)(L + GD_QN + t * 272 + sg * 64);
            const LAS u32x4* kp = (const LAS u32x4*)(L + GD_KN + t * 272 + sg * 64);
#pragma unroll
            for (int i = 0; i < 4; ++i) {
                const u32x4 w = qp[i];
                qp[i] = (u32x4){pk2(bflo(w.x) * eg, bfhi(w.x) * eg), pk2(bflo(w.y) * eg, bfhi(w.y) * eg), pk2(bflo(w.z) * eg, bfhi(w.z) * eg), pk2(bflo(w.w) * eg, bfhi(w.w) * eg)};
                const u32x4 kw = kp[i];
                LAS unsigned char* kd = L + GD_KET + (sg * 32 + i * 8) * 144 + t * 2;
                *(LAS bf16*)(kd + 0 * 144) = (bf16)pk1(bflo(kw.x) * ee); *(LAS bf16*)(kd + 1 * 144) = (bf16)pk1(bfhi(kw.x) * ee);
                *(LAS bf16*)(kd + 2 * 144) = (bf16)pk1(bflo(kw.y) * ee); *(LAS bf16*)(kd + 3 * 144) = (bf16)pk1(bfhi(kw.y) * ee);
                *(LAS bf16*)(kd + 4 * 144) = (bf16)pk1(bflo(kw.z) * ee); *(LAS bf16*)(kd + 5 * 144) = (bf16)pk1(bfhi(kw.z) * ee);
                *(LAS bf16*)(kd + 6 * 144) = (bf16)pk1(bflo(kw.w) * ee); *(LAS bf16*)(kd + 7 * 144) = (bf16)pk1(bfhi(kw.w) * ee);
            }
        }
        LBAR();
        if (wave < 2) {
            const int tid = tid_opaque(), lane = tid & 63, r16 = lane & 15, q4 = lane >> 4; (void)r16; (void)q4; (void)lane;
            LAS u32x2* ud = (LAS u32x2*)(L + GD_KN + tid * 136);
#pragma unroll
            for (int i = 0; i < 16; ++i) ud[i] = (u32x2){pk2(acc2[2 * i][0], acc2[2 * i][1]), pk2(acc2[2 * i + 1][0], acc2[2 * i + 1][1])};
        } else if (wave < 4) {
            const int tid = tid_opaque(), lane = tid & 63, r16 = lane & 15, q4 = lane >> 4; (void)r16; (void)q4; (void)lane;
            LAS unsigned char* wd = L + GD_VN + (tid - 128) * 2;
#pragma unroll
            for (int i = 0; i < 32; ++i) { *(LAS bf16*)(wd + (2 * i) * 272) = (bf16)pk1(acc2[i][0]); *(LAS bf16*)(wd + (2 * i + 1) * 272) = (bf16)pk1(acc2[i][1]); }
        }
        {
            const int tid = tid_opaque(), lane = tid & 63, r16 = lane & 15, q4 = lane >> 4; (void)r16; (void)q4; (void)lane;
            const int tl = wave & 3;
#pragma unroll
            for (int u = 0; u < 2; ++u) { const int ts = 2 * (wave >> 2) + u;
#pragma unroll
                for (int j = 0; j < 4; ++j) *(LAS bf16*)(L + GD_MT + (16 * tl + 4 * q4 + j) * 144 + (16 * ts + r16) * 2) = (bf16)pk1(at[u][j]); }
        }
        LBAR();
        {
            const int tid = tid_opaque();
            KP pp = kparams();
            const __amdgpu_buffer_rsrc_t ra_ = __builtin_amdgcn_make_buffer_rsrc((void*)(pp->ws + WS_H + (size_t)u * AUXA_UNIT), (short)0, (int)AUXA_UNIT, 0x00020000);
            const __amdgpu_buffer_rsrc_t rb_ = __builtin_amdgcn_make_buffer_rsrc((void*)(pp->ws + WS_OCAT + (size_t)u * AUXB_UNIT), (short)0, (int)AUXB_UNIT, 0x00020000);
#pragma unroll
            for (int k = 0; k < 2; ++k) { const int i = tid + 512 * k;
                __builtin_amdgcn_raw_buffer_store_b128(*(const LAS u32x4*)(L + GD_VN + (i >> 4) * 272 + (i & 15) * 16), ra_, i * 16, 0, 16);
                __builtin_amdgcn_raw_buffer_store_b128(*(const LAS u32x4*)(L + GD_QN + (i >> 4) * 272 + (i & 15) * 16), rb_, i * 16, 0, 16);
                __builtin_amdgcn_raw_buffer_store_b128(*(const LAS u32x4*)(L + GD_KET + (i >> 3) * 144 + (i & 7) * 16), rb_, 16384 + i * 16, 0, 16); }
#pragma unroll
            for (int k = 0; k < 4; ++k) { const int i = tid + 512 * k; __builtin_amdgcn_raw_buffer_store_b64(*(const LAS u32x2*)(L + GD_KN + (i >> 4) * 136 + (i & 15) * 8), ra_, 16384 + i * 8, 0, 16); }
            __builtin_amdgcn_raw_buffer_store_b128(*(const LAS u32x4*)(L + GD_MT + (tid >> 3) * 144 + (tid & 7) * 16), rb_, 32768 + tid * 16, 0, 16);
            if (tid == 0) __hip_atomic_store((float*)(pp->ws + WS_GE) + u, __expf(GC[63]), __ATOMIC_RELAXED, __HIP_MEMORY_SCOPE_AGENT);
            asm volatile("s_waitcnt vmcnt(0)" ::: "memory");
            __syncthreads();
            if (tid == 0) (void)__hip_atomic_fetch_add((unsigned*)(pp->ws + WS_BAR) + GCNT_WORD + c, 1u, __ATOMIC_RELAXED, __HIP_MEMORY_SCOPE_AGENT);
        }
    }
    gdn1_load_rows(kparams(), u_next, xr);
}
#define GDN2_ENSURE(cn) do { if ((cn) >= ready_upto) { const int hi_ = ready_upto + 8 < 64 ? ready_upto + 8 : 64; \
        if (tid_opaque() == 0) { unsigned* cnt_ = (unsigned*)(kparams()->ws + WS_BAR) + GCNT_WORD; unsigned sp_ = 0; \
            for (int cc_ = ready_upto; cc_ < hi_; ++cc_) while (__hip_atomic_load(cnt_ + cc_, __ATOMIC_RELAXED, __HIP_MEMORY_SCOPE_AGENT) < want) { __builtin_amdgcn_s_sleep(2); if (++sp_ > (1u << 24)) break; } \
            __builtin_amdgcn_fence(__ATOMIC_ACQUIRE, "agent"); asm volatile("s_waitcnt vmcnt(0)" ::: "memory"); } \
        __syncthreads(); ready_upto = hi_; } } while (0)
__device__ __forceinline__ void gdn2_unit(KP p, int idx, int layer, int pass, LAS unsigned char* L0) {
    const unsigned want = 32u * (unsigned)(pass + 1); int ready_upto = 0;
    LAS unsigned char* L = lds_opaque(L0);
    const int tid0 = tid_opaque(), wave = __builtin_amdgcn_readfirstlane(tid0 >> 6);
    const int bl = idx >> 2, h = idx & 3;
    { LAS unsigned char* SB = L + GD_PRIV + wave * GD_PRIV_SZ + 2304; for (int i = tid0 & 63; i < 1088; i += 64) ((LAS unsigned*)SB)[i] = 0u; }
    f32x4 S[8];
#pragma unroll
    for (int i = 0; i < 8; ++i) S[i] = (f32x4){0.f, 0.f, 0.f, 0.f};
    const size_t u0 = (size_t)(bl * 4 + h) * 64;
    u32x4 rw[2], rq[2], rk[2], ra; u32x2 ru[4]; float rge;
    GDN2_ENSURE(0);
    {
        const unsigned char* A = p->ws + WS_H + u0 * AUXA_UNIT; const unsigned char* B = p->ws + WS_OCAT + u0 * AUXB_UNIT;
#pragma unroll
        for (int k = 0; k < 2; ++k) { const int i = tid0 + 512 * k; rw[k] = ((const u32x4*)A)[i]; rq[k] = ((const u32x4*)B)[i]; rk[k] = ((const u32x4*)(B + 16384))[i]; }
#pragma unroll
        for (int k = 0; k < 4; ++k) ru[k] = ((const u32x2*)(A + 16384))[tid0 + 512 * k];
        ra = ((const u32x4*)(B + 32768))[tid0]; rge = ((const float*)(p->ws + WS_GE))[u0];
    }
    for (int c = 0; c < 64; ++c) {
        L = lds_opaque(L0);
        LAS unsigned char* VNT = L + GD_PRIV + wave * GD_PRIV_SZ; LAS unsigned char* SB = VNT + 2304;
        LBAR();
        const float ge = rge;
        {
            const int tid = tid_opaque();
#pragma unroll
            for (int k = 0; k < 2; ++k) { const int i = tid + 512 * k;
                *(LAS u32x4*)(L + GD_VN + (i >> 4) * 272 + (i & 15) * 16) = rw[k];
                *(LAS u32x4*)(L + GD_QN + (i >> 4) * 272 + (i & 15) * 16) = rq[k];
                *(LAS u32x4*)(L + GD_KET + (i >> 3) * 144 + (i & 7) * 16) = rk[k]; }
#pragma unroll
            for (int k = 0; k < 4; ++k) { const int i = tid + 512 * k; *(LAS u32x2*)(L + GD_KN + (i >> 4) * 136 + (i & 15) * 8) = ru[k]; }
            *(LAS u32x4*)(L + GD_MT + (tid >> 3) * 144 + (tid & 7) * 16) = ra;
        }
        LBAR();
        GDN2_ENSURE(c + 1 < 64 ? c + 1 : 63);
        {
            const int tid = tid_opaque(); KP pp = kparams();
            const size_t un = u0 + (c + 1 < 64 ? c + 1 : 63);
            const unsigned char* A = pp->ws + WS_H + un * AUXA_UNIT; const unsigned char* B = pp->ws + WS_OCAT + un * AUXB_UNIT;
#pragma unroll
            for (int k = 0; k < 2; ++k) { const int i = tid + 512 * k; rw[k] = ((const u32x4*)A)[i]; rq[k] = ((const u32x4*)B)[i]; rk[k] = ((const u32x4*)(B + 16384))[i]; }
#pragma unroll
            for (int k = 0; k < 4; ++k) ru[k] = ((const u32x2*)(A + 16384))[tid + 512 * k];
            ra = ((const u32x4*)(B + 32768))[tid]; rge = ((const float*)(pp->ws + WS_GE))[un];
        }
        {
            const int tid = tid_opaque(), lane = tid & 63, r16 = lane & 15, q4 = lane >> 4; (void)r16; (void)q4; (void)lane;
            KP pp = kparams(); bf16* ORp = (bf16*)(pp->ws + WS_ORAW) + (size_t)bl * SEQ * OC + h * 128 + wave * 16;
            bf16x8 sbf[4];
#pragma unroll
            for (int k4 = 0; k4 < 4; ++k4) sbf[k4] = *(const LAS bf16x8*)(SB + r16 * 272 + k4 * 64 + q4 * 16);
#pragma unroll
            for (int tl = 0; tl < 4; ++tl) {
                f32x4 p1 = (f32x4){0.f, 0.f, 0.f, 0.f};
#pragma unroll
                for (int k4 = 0; k4 < 4; ++k4) p1 = __builtin_amdgcn_mfma_f32_16x16x32_bf16(*(const LAS bf16x8*)(L + GD_VN + (16 * tl + r16) * 272 + k4 * 64 + q4 * 16), sbf[k4], p1, 0, 0, 0);
                const u32x2 uu = *(const LAS u32x2*)(L + GD_KN + (16 * wave + r16) * 136 + (16 * tl + 4 * q4) * 2);
                *(LAS u32x2*)(VNT + r16 * 144 + (16 * tl + 4 * q4) * 2) = (u32x2){pk2(bflo(uu.x) - p1[0], bfhi(uu.x) - p1[1]), pk2(bflo(uu.y) - p1[2], bfhi(uu.y) - p1[3])};
            }
            const bf16x8 vb0 = *(const LAS bf16x8*)(VNT + r16 * 144 + q4 * 16), vb1 = *(const LAS bf16x8*)(VNT + r16 * 144 + 64 + q4 * 16);
#pragma unroll
            for (int tl = 0; tl < 4; ++tl) {
                f32x4 o = (f32x4){0.f, 0.f, 0.f, 0.f};
#pragma unroll
                for (int k4 = 0; k4 < 4; ++k4) o = __builtin_amdgcn_mfma_f32_16x16x32_bf16(*(const LAS bf16x8*)(L + GD_QN + (16 * tl + r16) * 272 + k4 * 64 + q4 * 16), sbf[k4], o, 0, 0, 0);
                o = __builtin_amdgcn_mfma_f32_16x16x32_bf16(*(const LAS bf16x8*)(L + GD_MT + (16 * tl + r16) * 144 + q4 * 16), vb0, o, 0, 0, 0);
                if (tl >= 2) o = __builtin_amdgcn_mfma_f32_16x16x32_bf16(*(const LAS bf16x8*)(L + GD_MT + (16 * tl + r16) * 144 + 64 + q4 * 16), vb1, o, 0, 0, 0);
                bf16* orow = ORp + (size_t)(c * 64 + 16 * tl + 4 * q4) * OC + r16;
#pragma unroll
                for (int j = 0; j < 4; ++j) orow[(size_t)j * OC] = (bf16)pk1(o[j]);
            }
#pragma unroll
            for (int kt = 0; kt < 8; ++kt) {
                S[kt] = S[kt] * ge;
                S[kt] = __builtin_amdgcn_mfma_f32_16x16x32_bf16(*(const LAS bf16x8*)(L + GD_KET + (16 * kt + r16) * 144 + q4 * 16), vb0, S[kt], 0, 0, 0);
                S[kt] = __builtin_amdgcn_mfma_f32_16x16x32_bf16(*(const LAS bf16x8*)(L + GD_KET + (16 * kt + r16) * 144 + 64 + q4 * 16), vb1, S[kt], 0, 0, 0);
                *(LAS u32x2*)(SB + r16 * 272 + (16 * kt + 4 * q4) * 2) = (u32x2){pk2(S[kt][0], S[kt][1]), pk2(S[kt][2], S[kt][3])};
            }
        }
    }
    LBAR();
}

__device__ __forceinline__ void normgate_phase(KP p, int layer) {
    const int tid_ = tid_opaque(), lane = tid_ & 63, wave = __builtin_amdgcn_readfirstlane(tid_ >> 6);
    const bf16* P = (const bf16*)(p->ws + WS_PROJ); const bf16* ORAW = (const bf16*)(p->ws + WS_ORAW); bf16* OCAT = (bf16*)(p->ws + WS_OCAT);
    const int gw = bid_opaque() * 8 + wave, NGW = grid_opaque() * 8;
    const int c4 = 4 * lane;
    const f32x4 wg = *(const f32x4*)(p->in[9] + layer * 128 + (c4 & 127)), wh = *(const f32x4*)(p->in[11] + layer * 128 + (c4 & 127));
    const f32x4 ws0 = *(const f32x4*)(p->in[17] + layer * 512 + c4), ws1 = *(const f32x4*)(p->in[17] + layer * 512 + 256 + c4);
    const int rpw = (MH + NGW - 1) / NGW, r0 = gw * rpw, r1 = r0 + rpw < MH ? r0 + rpw : MH;
    if (r0 >= r1) return;
    u32x2 on[6], zn[6];
    { const bf16* o = ORAW + (size_t)r0 * OC + c4; const bf16* pr = P + (size_t)r0 * NP + c4;
#pragma unroll
      for (int j = 0; j < 6; ++j) on[j] = *(const u32x2*)(o + 256 * j);
      zn[0] = *(const u32x2*)(pr + C_GZ); zn[1] = *(const u32x2*)(pr + C_GZ + 256); zn[2] = *(const u32x2*)(pr + C_HG); zn[3] = *(const u32x2*)(pr + C_HG + 256); zn[4] = *(const u32x2*)(pr + C_SZ); zn[5] = *(const u32x2*)(pr + C_SZ + 256); }
    for (int r = r0; r < r1; ++r) {
        bf16* oc = OCAT + (size_t)r * OC + c4;
        f32x4 v[6]; u32x2 z[6];
#pragma unroll
        for (int j = 0; j < 6; ++j) { v[j] = (f32x4){bflo(on[j].x), bfhi(on[j].x), bflo(on[j].y), bfhi(on[j].y)}; z[j] = zn[j]; }
        if (r + 1 < r1) { const bf16* o = ORAW + (size_t)(r + 1) * OC + c4; const bf16* pr = P + (size_t)(r + 1) * NP + c4;
#pragma unroll
            for (int j = 0; j < 6; ++j) on[j] = *(const u32x2*)(o + 256 * j);
            zn[0] = *(const u32x2*)(pr + C_GZ); zn[1] = *(const u32x2*)(pr + C_GZ + 256); zn[2] = *(const u32x2*)(pr + C_HG); zn[3] = *(const u32x2*)(pr + C_HG + 256); zn[4] = *(const u32x2*)(pr + C_SZ); zn[5] = *(const u32x2*)(pr + C_SZ + 256); }
#pragma unroll
        for (int j = 0; j < 6; ++j) {
            f32x4 g; g[0] = silu_f(bflo(z[j].x)); g[1] = silu_f(bfhi(z[j].x)); g[2] = silu_f(bflo(z[j].y)); g[3] = silu_f(bfhi(z[j].y));
            f32x4 x = v[j]; if (j >= 4) x = x * g;
            float ss = (x[0] * x[0] + x[1] * x[1]) + (x[2] * x[2] + x[3] * x[3]);
            ss = red16(ss);
            const float s0 = rdl(ss, 0), s1 = rdl(ss, 16), s2 = rdl(ss, 32), s3 = rdl(ss, 48);
            float tot, inv;
            if (j >= 4) { tot = (s0 + s1) + (s2 + s3); inv = 1.f / 256.f; } else { tot = lane < 32 ? s0 + s1 : s2 + s3; inv = 1.f / 128.f; }
            const float rstd = rsqrtf(tot * inv + EPS);
            const f32x4 w = j < 2 ? wg : j < 4 ? wh : j == 4 ? ws0 : ws1;
            f32x4 y = x * rstd * w; if (j < 4) y = y * g;
            u32x2 ov; ov.x = pk2(y[0], y[1]); ov.y = pk2(y[2], y[3]);
            *(u32x2*)(oc + 256 * j) = ov;
        }
    }
}

__device__ __forceinline__ void glu_fix_phase(KP p, int layer) {
    const bf16* RB = (const bf16*)(p->ws + WS_RAWB); bf16* G = (bf16*)(p->ws + WS_G);
    const float* cw = p->in[24] + (size_t)layer * 3 * FF2; const float* cbp = p->in[25] + (size_t)layer * FF2;
    const int gt = bid_opaque() * 512 + tid_opaque(), NT = grid_opaque() * 512;
    constexpr int NPAIR = FF / 2;
    for (int idx = gt; idx < (MH / 64) * NPAIR; idx += NT) {
        const int b = idx / NPAIR, c = (idx % NPAIR) * 2;
        unsigned g[4], v[4];
#pragma unroll
        for (int s_ = 0; s_ < 4; ++s_) { g[s_] = *(const unsigned*)(RB + (size_t)(b * 4 + s_) * FF2 + c); v[s_] = *(const unsigned*)(RB + (size_t)(b * 4 + s_) * FF2 + FF + c); }
        if (((b * 64) % SEQ) == 0) { g[0] = 0u; g[1] = 0u; v[0] = 0u; v[1] = 0u; }
        float wg[3][2], wv[3][2];
#pragma unroll
        for (int k = 0; k < 3; ++k) { wg[k][0] = cw[k * FF2 + c]; wg[k][1] = cw[k * FF2 + c + 1]; wv[k][0] = cw[k * FF2 + FF + c]; wv[k][1] = cw[k * FF2 + FF + c + 1]; }
        const float bg0 = cbp[c], bg1 = cbp[c + 1], bv0 = cbp[FF + c], bv1 = cbp[FF + c + 1];
#pragma unroll
        for (int r = 0; r < 2; ++r) {
            const float ga = wg[0][0] * bflo(g[r]) + wg[1][0] * bflo(g[r + 1]) + wg[2][0] * bflo(g[r + 2]) + bg0;
            const float gb = wg[0][1] * bfhi(g[r]) + wg[1][1] * bfhi(g[r + 1]) + wg[2][1] * bfhi(g[r + 2]) + bg1;
            const float va = wv[0][0] * bflo(v[r]) + wv[1][0] * bflo(v[r + 1]) + wv[2][0] * bflo(v[r + 2]) + bv0;
            const float vb = wv[0][1] * bfhi(v[r]) + wv[1][1] * bfhi(v[r + 1]) + wv[2][1] * bfhi(v[r + 2]) + bv1;
            *(unsigned*)(G + (size_t)(b * 64 + r) * FF + c) = pk2(silu_f(ga) * va, silu_f(gb) * vb);
        }
    }
}

__device__ __forceinline__ void final_norm_phase(KP p) {
    const int tid_ = tid_opaque(), lane = tid_ & 63, wave = __builtin_amdgcn_readfirstlane(tid_ >> 6);
    const int gw = bid_opaque() * 8 + wave, NGW = grid_opaque() * 8;
    const float* nw = p->in[27];
    const int rpw = (MTOT + NGW - 1) / NGW, r0 = gw * rpw, r1 = r0 + rpw < MTOT ? r0 + rpw : MTOT;
    if (r0 >= r1) return;
    f32x4 w[4], v[4], vn[4];
#pragma unroll
    for (int j = 0; j < 4; ++j) { w[j] = *(const f32x4*)(nw + 4 * lane + 256 * j); vn[j] = ((const f32x4*)(p->out + (size_t)r0 * 1024) + lane)[64 * j]; }
    for (int r = r0; r < r1; ++r) {
#pragma unroll
        for (int j = 0; j < 4; ++j) v[j] = vn[j];
        if (r + 1 < r1) {
#pragma unroll
            for (int j = 0; j < 4; ++j) vn[j] = ((const f32x4*)(p->out + (size_t)(r + 1) * 1024) + lane)[64 * j]; }
        float s = 0.f;
#pragma unroll
        for (int j = 0; j < 4; ++j) s += (v[j][0] * v[j][0] + v[j][1] * v[j][1]) + (v[j][2] * v[j][2] + v[j][3] * v[j][3]);
        const float rstd = rsqrtf(wave_sum(s) * (1.f / 1024.f) + EPS);
        f32x4* xr = (f32x4*)(p->out + (size_t)r * 1024) + lane;
#pragma unroll
        for (int j = 0; j < 4; ++j) xr[64 * j] = v[j] * rstd * w[j];
    }
}


#define XB_TMO      128
#define XB_XCNT(j)  (256  + 64 * (j))
#define XB_XSUB(j)  (1280 + 64 * (j))
#define XB_XGEN(j)  (2304 + 64 * (j))
#define XB_TOP      3328
#define XB_TOPGEN   3392
#define XCD_BAR_WORDS 3456
#define XB_SPIN_CAP (1u << 20)
__device__ __forceinline__ unsigned xb_ld(unsigned* p)              { return __hip_atomic_load(p, __ATOMIC_RELAXED, __HIP_MEMORY_SCOPE_AGENT); }
__device__ __forceinline__ unsigned xb_add(unsigned* p, unsigned v) { return __hip_atomic_fetch_add(p, v, __ATOMIC_RELAXED, __HIP_MEMORY_SCOPE_AGENT); }
__device__ __forceinline__ unsigned xb_xcc_id() { return (unsigned)__builtin_amdgcn_s_getreg((3 << 11) | 20) & 0xFu; }
#define XB_SPIN(cond, bar) do { unsigned _sp = 0; while (cond) { __builtin_amdgcn_s_sleep(1); \
    if ((++_sp & 255u) == 0u) { if (xb_ld(&(bar)[XB_TMO])) break; if (_sp > XB_SPIN_CAP) { atomicAdd(&(bar)[XB_TMO], 1u); break; } } } } while (0)
struct XcdBarrier { unsigned* bar; unsigned x; volatile LAS unsigned* st; };
__device__ __forceinline__ XcdBarrier xcd_barrier_post(unsigned* bar, volatile LAS unsigned* st) {
    XcdBarrier b; b.bar = bar; b.x = xb_xcc_id(); b.st = st;
    if (threadIdx.x == 0) (void)xb_add(&bar[XB_XCNT(b.x)], 1u);
    return b;
}
__device__ __forceinline__ void xcd_barrier_complete(unsigned* bar, unsigned x, unsigned& nloc, unsigned& nx) {
    const unsigned G = gridDim.x * gridDim.y * gridDim.z;
    unsigned sum, cnt, mine, sp = 0u;
    for (;;) {
        sum = 0u; cnt = 0u; mine = 0u;
#pragma unroll
        for (unsigned j = 0; j < 16; ++j) { const unsigned c = xb_ld(&bar[XB_XCNT(j)]); sum += c; cnt += (c > 0u) ? 1u : 0u; mine = (j == x) ? c : mine; }
        if (sum == G) break;
        __builtin_amdgcn_s_sleep(1);
        if ((++sp & 255u) == 0u) { if (xb_ld(&bar[XB_TMO])) break; if (sp > XB_SPIN_CAP) { atomicAdd(&bar[XB_TMO], 1u); break; } }
    }
    nloc = mine > 0u ? mine : 1u; nx = cnt > 0u ? cnt : 1u;
}
__device__ __forceinline__ void xcd_barrier(const XcdBarrier& b) {
    asm volatile("s_waitcnt vmcnt(0)" ::: "memory");
    __syncthreads();
    if (threadIdx.x == 0) {
        unsigned* bar = b.bar;
        __builtin_amdgcn_s_waitcnt(0);
        unsigned nloc = b.st[0], nx = b.st[1];
        if (nloc == 0u) { xcd_barrier_complete(bar, b.x, nloc, nx); b.st[0] = nloc; b.st[1] = nx; }
        const unsigned old = xb_add(&bar[XB_XSUB(b.x)], 1u);
        const unsigned gen = old / nloc;
        if (old + 1u == (gen + 1u) * nloc) {
            __builtin_amdgcn_fence(__ATOMIC_RELEASE, "agent");
            asm volatile("s_waitcnt vmcnt(0)" ::: "memory");
            const unsigned og = xb_add(&bar[XB_TOP], 1u);
            const unsigned tg = og / nx;
            if (og + 1u == (tg + 1u) * nx) xb_add(&bar[XB_TOPGEN], 1u);
            else XB_SPIN(xb_ld(&bar[XB_TOPGEN]) == tg, bar);
            __builtin_amdgcn_fence(__ATOMIC_ACQUIRE, "agent");
            xb_add(&bar[XB_XGEN(b.x)], 1u);
            asm volatile("s_waitcnt vmcnt(0)" ::: "memory");
        } else {
            XB_SPIN(xb_ld(&bar[XB_XGEN(b.x)]) == gen, bar);
            __builtin_amdgcn_fence(__ATOMIC_ACQUIRE, "agent");
            asm volatile("s_waitcnt vmcnt(0)" ::: "memory");
        }
    }
    __syncthreads();
}

__global__ void __launch_bounds__(512, 2) mk_fwd(Params pv) {
    extern __shared__ __attribute__((aligned(16))) unsigned char lds_raw[];
    LAS unsigned char* lds = (LAS unsigned char*)lds_raw;
    cg::grid_group grid = cg::this_grid();
    const int ph_lo = pv.ph_lo, ph_hi = pv.ph_hi;
    volatile LAS unsigned* xst = (volatile LAS unsigned*)(lds + XB_ST_OFF);
    if (threadIdx.x < 2) xst[threadIdx.x] = 0u;
    __syncthreads();
    (void)xcd_barrier_post((unsigned*)(pv.ws + WS_BAR), xst);

    for (int ph = ph_lo; ph < ph_hi; ++ph) {
        if (ph > ph_lo) { if (ph == ph_lo + 1) grid.sync(); else { XcdBarrier xb_; xb_.bar = (unsigned*)(kparams()->ws + WS_BAR); xb_.x = xb_xcc_id(); xb_.st = (volatile LAS unsigned*)(lds_opaque(lds) + XB_ST_OFF); xcd_barrier(xb_); } }
        KP p = kparams();
        const int G = grid_opaque();
        unsigned char* ws = p->ws;
        if (ph == 0) { p0_prologue(p, lds); continue; }
        if (ph == NPH - 1) { final_norm_phase(p); continue; }
        const int q = ph - 1, layer = q / 20, hb = (q / 10) % 2, sub = q % 10;
        const int row_base = hb * MH;
        const float* mod = (const float*)(ws + WS_MOD) + (size_t)layer * 16 * 6144;
        const bf16* WL = (const bf16*)(ws + WS_W) + (size_t)layer * W_LAYER;
        bf16* HBUF = (bf16*)(ws + WS_H);
        const bf16* gA = nullptr; const bf16* gB = nullptr; int nt = 0, lda = 0, ldb = 0, nN = 0, epi = -1;
        switch (sub) {
        case 0: {
            const float* xin = (layer == 0 ? p->in[0] : p->out);
            norm_mod_phase(xin + (size_t)row_base * 1024, row_base, p->in[4] + layer * 1024, mod + 0, mod + 1024, HBUF, WL + W_IN + (size_t)C_SMALL * 1024, (float*)(ws + WS_SM));
        } break;
        case 1:
            gA = HBUF; gB = WL + W_IN; nt = 16; lda = 1024; ldb = 1024; nN = ((MH + G * 8 - 1) / (G * 8) == 16) ? C_SMALL / 256 : NP / 256; epi = 0; break;
        case 2: {
            const int b = bid_opaque();
            if (b < 64) ssd_unit(p, b, layer, lds);
            else if (b < 128) hgrn_unit(p, b - 64, layer, lds);
            else if (b < 160) gdn2_unit(p, b - 128, layer, layer * 2 + hb, lds);
            else if (G - 160 >= 32 && (G - 160) % 32 == 0) {
                u32x4 xr[3][4][2]; const int st = G - 160; int j = b - 160;
                gdn1_load_rows(p, ((j & 31) << 6) | (j >> 5), xr);
                for (; j < 2048; j += st) { const int jn = j + st < 2048 ? j + st : j; gdn1_unit(p, ((j & 31) << 6) | (j >> 5), layer, lds, xr, j == b - 160, ((jn & 31) << 6) | (jn >> 5)); }
            } else {
                u32x4 xr[3][4][2]; const int st = G - 160;
                for (int j = b - 160; j < 2048; j += st) { gdn1_load_rows(p, ((j & 31) << 6) | (j >> 5), xr); gdn1_unit(p, ((j & 31) << 6) | (j >> 5), layer, lds, xr, true, ((j & 31) << 6) | (j >> 5)); }
            }
        } break;
        case 3:
            normgate_phase(p, layer);
            break;
        case 4:
            gA = (const bf16*)(ws + WS_OCAT); gB = WL + W_BR; nt = 24; lda = OC; ldb = OC; nN = 4; epi = 1; break;
        case 5:
            gA = HBUF; gB = WL + W_OUT; nt = 16; lda = 1024; ldb = 1024; nN = 4; epi = 4; break;
        case 6:
            norm_mod_phase(p->out + (size_t)row_base * 1024, row_base, p->in[22] + layer * 1024, mod + 3072, mod + 4096, HBUF, nullptr, nullptr);
            break;
        case 7:
            gA = HBUF; gB = WL + W_UP; nt = 16; lda = 1024; ldb = 1024; nN = FF2 / 256; epi = 5; break;
        case 8:
            glu_fix_phase(p, layer);
            break;
        default:
            gA = (const bf16*)(ws + WS_G); gB = WL + W_DN; nt = FF / 64; lda = FF; ldb = FF; nN = 4; epi = 6; break;
        }
        if (epi >= 0) pg8::gemm_phase(lds, gA, gB, nt, lda, ldb, nN, epi, layer, row_base);
    }
}

extern "C" void kernel_launch(void* const* d_in, const int* in_sizes, int n_in, void* d_out, int out_size, void* d_ws, size_t ws_size, hipStream_t stream) {
    static int grid = 0;
    if (grid == 0) {
        if (n_in != 28 || out_size != MTOT * DM || ws_size < WS_END) { fprintf(stderr, "kernel_launch: unexpected problem: n_in %d out %d ws %zu (need %zu)\n", n_in, out_size, ws_size, (size_t)WS_END); grid = -1; return; }
        int dev = 0, cus = 0, per_cu = 0;
        hipGetDevice(&dev); hipDeviceGetAttribute(&cus, hipDeviceAttributeMultiprocessorCount, dev);
        hipFuncSetAttribute((const void*)mk_fwd, hipFuncAttributeMaxDynamicSharedMemorySize, LDS_BYTES);
        hipOccupancyMaxActiveBlocksPerMultiprocessor(&per_cu, (const void*)mk_fwd, 512, LDS_BYTES);
        if (per_cu < 1) { fprintf(stderr, "kernel_launch: occupancy query says %d blocks per CU\n", per_cu); per_cu = 1; }
        (void)hipGetLastError();
        grid = cus;
        if (grid < 192) { fprintf(stderr, "kernel_launch: %d CUs: the mixer phase needs at least 192 workgroups\n", grid); grid = -1; return; }
    }
    if (grid < 0) return;
    Params p{};
    for (int i = 0; i < 28; ++i) p.in[i] = (const float*)d_in[i];
    p.out = (float*)d_out; p.ws = (unsigned char*)d_ws;
#if MK_COOP
    p.ph_lo = 0; p.ph_hi = NPH;
    (void)hipMemsetAsync((char*)d_ws + WS_BAR, 0, 16384, stream);
    void* args[] = {&p};
    hipError_t e = hipLaunchCooperativeKernel((const void*)mk_fwd, dim3(grid), dim3(512), args, LDS_BYTES, stream);
    if (e != hipSuccess) fprintf(stderr, "cooperative launch failed: %s (grid %d)\n", hipGetErrorString(e), grid);
#else
    for (int ph = 0; ph < NPH; ++ph) { p.ph_lo = ph; p.ph_hi = ph + 1; hipLaunchKernelGGL(mk_fwd, dim3(grid), dim3(512), LDS_BYTES, stream, p); }
#endif
}
```

```cpp
#include <hip/hip_runtime.h>
#include <hip/hip_cooperative_groups.h>
#include <cstdio>
#include <cstdint>
namespace cg = cooperative_groups;

#ifndef MK_COOP
#define MK_COOP 1
#endif

#define LAS __attribute__((address_space(3)))
typedef unsigned short bf16;
typedef short bf16x8 __attribute__((ext_vector_type(8)));
typedef float f32x4 __attribute__((ext_vector_type(4)));
typedef unsigned u32x4 __attribute__((ext_vector_type(4)));
typedef unsigned u32x2 __attribute__((ext_vector_type(2)));

constexpr int DM = 1024, SEQ = 4096, BATCH = 16, MTOT = BATCH * SEQ, HB_SEQ = 8, MH = HB_SEQ * SEQ;
constexpr int NIN = 8720, NP = 8960;
constexpr int C_GZ = 1536, C_HQ = 2048, C_HF = 2560, C_HI = 3072, C_HG = 3584, C_SZ = 4096, C_XBC = 4608, C_GATE = 5632, C_SMALL = 8704;
constexpr int FF = 2816, FF2 = 5632, OC = 1536;
constexpr float EPS = 1e-6f;
constexpr size_t W_IN = 0, W_BR = (size_t)NP * 1024, W_OUT = W_BR + 3 * 524288, W_UP = W_OUT + 1048576, W_DN = W_UP + (size_t)FF2 * 1024, W_LAYER = W_DN + (size_t)FF * 1024;
constexpr size_t MiB = 1u << 20;
constexpr size_t WS_MOD = 0, WS_W = 1 * MiB, WS_H = 80 * MiB, WS_SM = 144 * MiB, WS_OCAT = 146 * MiB, WS_ORAW = 242 * MiB, WS_PROJ = 434 * MiB, WS_G = 786 * MiB, WS_END = 994 * MiB;
static_assert(WS_W + 2 * W_LAYER * 2 <= WS_H, "weights fit");
constexpr size_t WS_RAWB = 338 * MiB;
constexpr int LDS_BYTES = 147456 + 256;
constexpr int XB_ST_OFF = 147456;
constexpr size_t WS_BAR = 900 * 1024;
constexpr int NPH = 42;

typedef float f32x2_t __attribute__((ext_vector_type(2)));
typedef __bf16 bf16x2_t __attribute__((ext_vector_type(2)));
__device__ __forceinline__ unsigned pk2(float lo, float hi) { const f32x2_t v = {lo, hi}; const bf16x2_t b = __builtin_convertvector(v, bf16x2_t); return __builtin_bit_cast(unsigned, b); }
__device__ __forceinline__ unsigned f2bf(float f) { return pk2(f, f) & 0xffffu; }
__device__ __forceinline__ unsigned pk1(float f) { return pk2(f, f); }
__device__ __forceinline__ float bf2f(unsigned b) { return __builtin_bit_cast(float, b << 16); }
__device__ __forceinline__ float bflo(unsigned w) { return __builtin_bit_cast(float, w << 16); }
__device__ __forceinline__ float bfhi(unsigned w) { return __builtin_bit_cast(float, w & 0xffff0000u); }
__device__ __forceinline__ float silu_f(float v) { return v * __builtin_amdgcn_rcpf(1.f + __builtin_amdgcn_exp2f(-1.4426950408889634f * v)); }
__device__ __forceinline__ float sigmoid_f(float v) { return __builtin_amdgcn_rcpf(1.f + __builtin_amdgcn_exp2f(-1.4426950408889634f * v)); }
__device__ __forceinline__ float softplus_f(float v) { const float z = __expf(-fabsf(v)); const float l = (z < 0.01f) ? z * (1.f - z * (0.5f - z * (1.f / 3.f))) : __logf(1.f + z); return fmaxf(v, 0.f) + l; }
template <int CTRL> __device__ __forceinline__ float dppf(float v) { return __builtin_bit_cast(float, __builtin_amdgcn_update_dpp(0, __builtin_bit_cast(int, v), CTRL, 0xf, 0xf, true)); }
__device__ __forceinline__ float red16(float v) { v += dppf<0xB1>(v); v += dppf<0x4E>(v); v += dppf<0x141>(v); v += dppf<0x128>(v); return v; }
__device__ __forceinline__ float rdl(float v, int l) { return __builtin_bit_cast(float, __builtin_amdgcn_readlane(__builtin_bit_cast(int, v), l)); }
__device__ __forceinline__ float wave_sum(float v) { v = red16(v); return (rdl(v, 0) + rdl(v, 16)) + (rdl(v, 32) + rdl(v, 48)); }
__device__ __forceinline__ float wave_scan_incl(float v, int lane) {
    v += dppf<0x111>(v); v += dppf<0x112>(v); v += dppf<0x114>(v); v += dppf<0x118>(v);
    const float t0 = rdl(v, 15), t1 = rdl(v, 31), t2 = rdl(v, 47); const int q = lane >> 4;
    return v + (q >= 1 ? t0 : 0.f) + (q >= 2 ? t1 : 0.f) + (q >= 3 ? t2 : 0.f);
}

struct Params { const float* in[28]; float* out; unsigned char* ws; int ph_lo, ph_hi; };
typedef const __attribute__((address_space(4))) Params* KP;
__device__ __forceinline__ int tid_opaque() { int t = threadIdx.x; asm volatile("" : "+v"(t)); return t; }
__device__ __forceinline__ int bid_opaque() { int b = blockIdx.x; asm volatile("" : "+s"(b)); return b; }
__device__ __forceinline__ int grid_opaque() { int g = gridDim.x; asm volatile("" : "+s"(g)); return g; }
__device__ __forceinline__ LAS unsigned char* lds_opaque(LAS unsigned char* l) { asm volatile("" : "+s"(l)); return l; }
__device__ __forceinline__ KP kparams() { KP q = (KP)__builtin_amdgcn_kernarg_segment_ptr(); asm volatile("" : "+s"(q)); return q; }


namespace pg8 {
constexpr int BM = 256, BK = 64, HALF = 128, HTB = HALF * BK * 2, STAGE_BYTES = 8 * HTB, NXCD = 8, WGM = 4;
__device__ __forceinline__ int lds_byte(int r, int c) { const int st = (r >> 4) * 2 + (c >> 5), rr = r & 15, cc = c & 31, ob = rr * 64 + cc * 2; return st * 1024 + (ob ^ (((ob >> 9) & 1) << 5)); }
__device__ __forceinline__ void stage_rc(int b, int& R, int& C) { const int st = b / 1024, sb = b % 1024, swz = sb ^ (((sb >> 9) & 1) << 5); R = (st >> 1) * 16 + swz / 64; C = (st & 1) * 32 + (swz % 64) / 2; }
__device__ __forceinline__ int perm32(int rho) { const int n = rho >> 4, i = rho & 15; return 8 * (i >> 2) + 4 * n + (i & 3); }
struct Unit { int pm, pn; };
struct StaticOrder {
    int nM, nN, nwg, G, c;
    __device__ __forceinline__ void init(int M, int N, int G_, int c_) { nM = M / BM; nN = N / BM; nwg = nM * nN; G = G_; c = c_; }
    __device__ __forceinline__ bool next(int i, Unit& u) const {
        const long L = (long)i * G + c; if (L >= nwg) return false;
        int wgid = (int)L; { const int q = nwg / NXCD, r = nwg % NXCD, xcd = wgid % NXCD, off = wgid / NXCD; wgid = (xcd < r ? xcd * (q + 1) : r * (q + 1) + (xcd - r) * q) + off; }
        const int nig = WGM * nN, gid = wgid / nig, fm = gid * WGM, gsz = (nM - fm) < WGM ? (nM - fm) : WGM;
        u.pm = fm + ((wgid % nig) % gsz); u.pn = (wgid % nig) / gsz; return true;
    }
};
__device__ __forceinline__ unsigned cvt_pk_bf16(float lo, float hi) { return pk2(lo, hi); }

template <int LDC, bool SMALL> struct EpiBf16 {
    static constexpr bool PERM = true;
    __device__ __forceinline__ void operator()(const f32x4 (&acc)[2][2][4][2], const Unit& u, int wr, int wc, int fr, int fq) const {
        KP p = kparams(); unsigned char* ws = p->ws;
        bf16* O = (bf16*)(ws + WS_PROJ);
        const int row0 = u.pm * BM + wr * 64 + fr; const int col0 = u.pn * BM + wc * 32 + 8 * fq;
#pragma unroll
        for (int ai = 0; ai < 2; ++ai)
#pragma unroll
            for (int m = 0; m < 4; ++m) { bf16* rowp = O + (size_t)(row0 + ai * HALF + m * 16) * LDC + col0;
#pragma unroll
                for (int bj = 0; bj < 2; ++bj) { const f32x4 v0 = acc[ai][bj][m][0], v1 = acc[ai][bj][m][1];
                    u32x4 w; w.x = cvt_pk_bf16(v0[0], v0[1]); w.y = cvt_pk_bf16(v0[2], v0[3]); w.z = cvt_pk_bf16(v1[0], v1[1]); w.w = cvt_pk_bf16(v1[2], v1[3]);
                    *(u32x4*)(rowp + bj * HALF) = w; } }
        if (SMALL && u.pn == C_SMALL / 256 && wc == 0 && fq < 2) {
            float* sm = (float*)(ws + WS_SM);
#pragma unroll
            for (int ai = 0; ai < 2; ++ai)
#pragma unroll
                for (int m = 0; m < 4; ++m) { float* q = sm + (size_t)(row0 + ai * HALF + m * 16) * 16 + 8 * fq; *(f32x4*)q = acc[ai][0][m][0]; *(f32x4*)(q + 4) = acc[ai][0][m][1]; }
        }
    }
};
__device__ __forceinline__ void branch_rescale(f32x4 (&acc)[2][2][4][2], const Unit& u, int wr, int wc, int fr, int fq, int which) {
    KP p = kparams();
    const bf16* gate = (const bf16*)(p->ws + WS_PROJ) + C_GATE + which * 1024;
    const int col0 = u.pn * BM + wc * 32 + 4 * fq;
#pragma unroll
    for (int ai = 0; ai < 2; ++ai)
#pragma unroll
        for (int mp = 0; mp < 2; ++mp) {
            u32x2 ga[2][2][2], gb[2][2][2];
#pragma unroll
            for (int mm = 0; mm < 2; ++mm) { const size_t row = (size_t)(u.pm * BM + ai * HALF + wr * 64 + (2 * mp + mm) * 16 + fr);
#pragma unroll
                for (int bj = 0; bj < 2; ++bj)
#pragma unroll
                    for (int n = 0; n < 2; ++n) { const int c = col0 + bj * HALF + n * 16; ga[mm][bj][n] = *(const u32x2*)(gate + row * NP + c); gb[mm][bj][n] = *(const u32x2*)(gate + row * NP + 1024 + c); } }
#pragma unroll
            for (int mm = 0; mm < 2; ++mm)
#pragma unroll
                for (int bj = 0; bj < 2; ++bj)
#pragma unroll
                    for (int n = 0; n < 2; ++n) { const u32x2 xa = ga[mm][bj][n], xb = gb[mm][bj][n];
                        f32x4 r;
                        r[0] = (1.f + __builtin_amdgcn_exp2f(-1.4426950408889634f * bflo(xb.x))) * __builtin_amdgcn_rcpf(1.f + __builtin_amdgcn_exp2f(-1.4426950408889634f * bflo(xa.x)));
                        r[1] = (1.f + __builtin_amdgcn_exp2f(-1.4426950408889634f * bfhi(xb.x))) * __builtin_amdgcn_rcpf(1.f + __builtin_amdgcn_exp2f(-1.4426950408889634f * bfhi(xa.x)));
                        r[2] = (1.f + __builtin_amdgcn_exp2f(-1.4426950408889634f * bflo(xb.y))) * __builtin_amdgcn_rcpf(1.f + __builtin_amdgcn_exp2f(-1.4426950408889634f * bflo(xa.y)));
                        r[3] = (1.f + __builtin_amdgcn_exp2f(-1.4426950408889634f * bfhi(xb.y))) * __builtin_amdgcn_rcpf(1.f + __builtin_amdgcn_exp2f(-1.4426950408889634f * bfhi(xa.y)));
                        acc[ai][bj][2 * mp + mm][n] = acc[ai][bj][2 * mp + mm][n] * r; }
        }
    asm volatile("s_waitcnt vmcnt(0)" ::: "memory");
}
struct EpiBranchFinal {
    static constexpr bool PERM = false;
    __device__ __forceinline__ void operator()(const f32x4 (&acc)[2][2][4][2], const Unit& u, int wr, int wc, int fr, int fq) const {
        KP p = kparams(); unsigned char* ws = p->ws;
        const bf16* gate = (const bf16*)(ws + WS_PROJ) + C_GATE + 2048; bf16* mb = (bf16*)(ws + WS_H);
        const int col0 = u.pn * BM + wc * 32 + 4 * fq;
#pragma unroll
        for (int ai = 0; ai < 2; ++ai)
#pragma unroll
            for (int mp = 0; mp < 2; ++mp) {
                u32x2 gr[2][2][2];
#pragma unroll
                for (int mm = 0; mm < 2; ++mm) { const size_t row = (size_t)(u.pm * BM + ai * HALF + wr * 64 + (2 * mp + mm) * 16 + fr);
#pragma unroll
                    for (int bj = 0; bj < 2; ++bj)
#pragma unroll
                        for (int n = 0; n < 2; ++n) gr[mm][bj][n] = *(const u32x2*)(gate + row * NP + col0 + bj * HALF + n * 16); }
#pragma unroll
                for (int mm = 0; mm < 2; ++mm) { const size_t row = (size_t)(u.pm * BM + ai * HALF + wr * 64 + (2 * mp + mm) * 16 + fr);
#pragma unroll
                    for (int bj = 0; bj < 2; ++bj)
#pragma unroll
                        for (int n = 0; n < 2; ++n) { const int c = col0 + bj * HALF + n * 16; const u32x2 x = gr[mm][bj][n];
                            f32x4 g; g[0] = sigmoid_f(bflo(x.x)); g[1] = sigmoid_f(bfhi(x.x)); g[2] = sigmoid_f(bflo(x.y)); g[3] = sigmoid_f(bfhi(x.y));
                            const f32x4 v = acc[ai][bj][2 * mp + mm][n] * g; u32x2 w; w.x = cvt_pk_bf16(v[0], v[1]); w.y = cvt_pk_bf16(v[2], v[3]); *(u32x2*)(mb + row * 1024 + c) = w; } }
            }
    }
};
struct EpiUpGlu {
    static constexpr bool PERM = true;
    int layer;
    __device__ __forceinline__ void operator()(const f32x4 (&acc)[2][2][4][2], const Unit& u, int wr, int wc, int fr, int fq) const {
        KP p = kparams(); unsigned char* ws = p->ws;
        bf16* G = (bf16*)(ws + WS_G); bf16* RB = (bf16*)(ws + WS_RAWB);
        const float* cw = p->in[24] + (size_t)layer * 3 * FF2; const float* cb = p->in[25] + (size_t)layer * FF2;
        const int gcol = u.pn * 128 + wc * 32 + 8 * fq;
#pragma unroll
        for (int n = 0; n < 2; ++n) {
            asm volatile("" ::: "memory");
            f32x4 wg[3], wv[3];
#pragma unroll
            for (int k = 0; k < 3; ++k) { wg[k] = *(const f32x4*)(cw + k * FF2 + gcol + 4 * n); wv[k] = *(const f32x4*)(cw + k * FF2 + FF + gcol + 4 * n); }
            const f32x4 bg = *(const f32x4*)(cb + gcol + 4 * n), bv = *(const f32x4*)(cb + FF + gcol + 4 * n);
#pragma unroll
            for (int ai = 0; ai < 2; ++ai)
#pragma unroll
                for (int m = 0; m < 4; ++m) {
                    const int row = u.pm * BM + ai * HALF + wr * 64 + m * 16 + fr;
                    float o[4];
#pragma unroll
                    for (int e = 0; e < 4; ++e) {
                        const float cg = n == 0 ? acc[ai][0][m][0][e] : acc[ai][0][m][1][e], cv = n == 0 ? acc[ai][1][m][0][e] : acc[ai][1][m][1][e];
                        const float pg = m > 0 ? (n == 0 ? acc[ai][0][m > 0 ? m - 1 : 0][0][e] : acc[ai][0][m > 0 ? m - 1 : 0][1][e]) : cg;
                        const float pv = m > 0 ? (n == 0 ? acc[ai][1][m > 0 ? m - 1 : 0][0][e] : acc[ai][1][m > 0 ? m - 1 : 0][1][e]) : cv;
                        const float cg1 = dppf<0x121>(cg), pg1 = dppf<0x121>(pg), cg2 = dppf<0x122>(cg), pg2 = dppf<0x122>(pg);
                        const float cv1 = dppf<0x121>(cv), pv1 = dppf<0x121>(pv), cv2 = dppf<0x122>(cv), pv2 = dppf<0x122>(pv);
                        const float g1 = fr >= 1 ? cg1 : pg1, g2 = fr >= 2 ? cg2 : pg2, v1 = fr >= 1 ? cv1 : pv1, v2 = fr >= 2 ? cv2 : pv2;
                        const float yg = wg[0][e] * g2 + wg[1][e] * g1 + wg[2][e] * cg + bg[e];
                        const float yv = wv[0][e] * v2 + wv[1][e] * v1 + wv[2][e] * cv + bv[e];
                        o[e] = silu_f(yg) * yv;
                    }
                    if (!(m == 0 && fr < 2)) { u32x2 w; w.x = pk2(o[0], o[1]); w.y = pk2(o[2], o[3]); *(u32x2*)(G + (size_t)row * FF + gcol + 4 * n) = w; }
                    int slot = -1, b = row >> 6;
                    if (m == 0 && fr < 2) slot = 2 + fr; else if (m == 3 && fr >= 14) { slot = fr - 14; b += 1; }
                    if (slot >= 0 && b < MH / 64) {
                        const f32x4 g0 = n == 0 ? acc[ai][0][m][0] : acc[ai][0][m][1], v0 = n == 0 ? acc[ai][1][m][0] : acc[ai][1][m][1];
                        bf16* rb = RB + (size_t)(b * 4 + slot) * FF2 + gcol + 4 * n;
                        u32x2 w; w.x = pk2(g0[0], g0[1]); w.y = pk2(g0[2], g0[3]); *(u32x2*)rb = w;
                        w.x = pk2(v0[0], v0[1]); w.y = pk2(v0[2], v0[3]); *(u32x2*)(rb + FF) = w;
                    }
                }
        }
    }
};
template <bool SECOND> struct EpiResid {
    static constexpr bool PERM = false;
    int layer, row_base;
    __device__ __forceinline__ void operator()(const f32x4 (&acc)[2][2][4][2], const Unit& u, int wr, int wc, int fr, int fq) const {
        KP p = kparams();
        float* out = p->out; const float* base = (SECOND || layer != 0) ? (const float*)out : p->in[0];
        const float* gate = (const float*)(p->ws + WS_MOD) + (size_t)layer * 16 * 6144 + (SECOND ? 5120 : 2048);
        const int col0 = u.pn * BM + wc * 32 + 4 * fq;
        const int b = (row_base + u.pm * BM) / SEQ;
        f32x4 gv[2][2];
#pragma unroll
        for (int bj = 0; bj < 2; ++bj)
#pragma unroll
            for (int n = 0; n < 2; ++n) gv[bj][n] = *(const f32x4*)(gate + (size_t)b * 6144 + col0 + bj * HALF + n * 16);
#pragma unroll
        for (int ai = 0; ai < 2; ++ai)
#pragma unroll
            for (int mp = 0; mp < 2; ++mp) {
                f32x4 bs[2][2][2];
#pragma unroll
                for (int mm = 0; mm < 2; ++mm) { const size_t off = (size_t)(row_base + u.pm * BM + ai * HALF + wr * 64 + (2 * mp + mm) * 16 + fr) * 1024 + col0;
#pragma unroll
                    for (int bj = 0; bj < 2; ++bj)
#pragma unroll
                        for (int n = 0; n < 2; ++n) bs[mm][bj][n] = *(const f32x4*)(base + off + bj * HALF + n * 16); }
#pragma unroll
                for (int mm = 0; mm < 2; ++mm) { const size_t off = (size_t)(row_base + u.pm * BM + ai * HALF + wr * 64 + (2 * mp + mm) * 16 + fr) * 1024 + col0;
#pragma unroll
                    for (int bj = 0; bj < 2; ++bj)
#pragma unroll
                        for (int n = 0; n < 2; ++n) *(f32x4*)(out + off + bj * HALF + n * 16) = bs[mm][bj][n] + gv[bj][n] * acc[ai][bj][2 * mp + mm][n]; }
            }
    }
};

__device__ __forceinline__ void gemm_phase(LAS unsigned char* lds, const bf16* gA, const bf16* gBt, const int nt, const int LDA, const int LDB, const int nN, const int epi, const int layer, const int row_base) {
    StaticOrder S; S.nM = MH / BM; S.nN = nN; S.nwg = S.nM * nN; S.G = grid_opaque(); S.c = bid_opaque();
    const bool PERM = (epi == 0 || epi == 5);
    const int tid = tid_opaque(), wid = __builtin_amdgcn_readfirstlane(tid >> 6), lane = tid & 63, wr = wid >> 2, wc = wid & 3;
    unsigned voffA[2], voffB[2];
#pragma unroll
    for (int i = 0; i < 2; ++i) { int R, C; stage_rc(tid * 16 + i * 8192, R, C); const int Rb = PERM ? ((R & ~31) + perm32(R & 31)) : R;
        voffA[i] = (unsigned)(R * LDA + C) * 2u; voffB[i] = (unsigned)(Rb * LDB + C) * 2u; }
    constexpr size_t kstep = (size_t)(BK * 2);
    const size_t hstepA = (size_t)HALF * LDA * 2, hstepB = (size_t)HALF * LDB * 2;
    const size_t tstepA = 2 * hstepA, tstepB = 2 * hstepB;
    const unsigned ldsw = (unsigned)wid * 1024u;
    const int aoff = lds_byte(wr * 64 + (lane & 15), (lane >> 4) * 8), boff = lds_byte(wc * 32 + (lane & 15), (lane >> 4) * 8);
#define PG8_SA(b, h) (((b) * 2 + (h)) * HTB)
#define PG8_SB(b, h) ((4 + (b) * 2 + (h)) * HTB)
#define PG8_STAGE(bufoff, gbase, voff) do { _Pragma("unroll") for (int _i = 0; _i < 2; ++_i) \
        __builtin_amdgcn_global_load_lds((const unsigned*)((const char*)(gbase) + (voff)[_i]), (LAS unsigned*)(lds + (bufoff) + ldsw + _i * 8192), 16, 0, 0); } while (0)
#define PG8_LDA(dst, b, h) do { _Pragma("unroll") for (int m = 0; m < 4; ++m) _Pragma("unroll") for (int k = 0; k < 2; ++k) dst[m][k] = *(const LAS bf16x8*)(lds + PG8_SA(b, h) + aoff + m * 2048 + k * 1024); } while (0)
#define PG8_LDB(dst, b, h) do { _Pragma("unroll") for (int n = 0; n < 2; ++n) _Pragma("unroll") for (int k = 0; k < 2; ++k) dst[n][k] = *(const LAS bf16x8*)(lds + PG8_SB(b, h) + boff + n * 2048 + k * 1024); } while (0)
#define PG8_MMA(ai, bj, At, Bt) do { __builtin_amdgcn_s_setprio(1); _Pragma("unroll") for (int m = 0; m < 4; ++m) _Pragma("unroll") for (int n = 0; n < 2; ++n) _Pragma("unroll") for (int k = 0; k < 2; ++k) \
        acc[ai][bj][m][n] = __builtin_amdgcn_mfma_f32_16x16x32_bf16(Bt[n][k], At[m][k], acc[ai][bj][m][n], 0, 0, 0); __builtin_amdgcn_s_setprio(0); } while (0)
#define PG8_WAIT_V(n) asm volatile("s_waitcnt vmcnt(" #n ")" ::: "memory")
#define PG8_WAIT_L(n) asm volatile("s_waitcnt lgkmcnt(" #n ")" ::: "memory")
#define PG8_BAR __builtin_amdgcn_s_barrier()
#define PG8_SCHED __builtin_amdgcn_sched_barrier(0)
    Unit cur, nxt; int ui = 0;
    if (!S.next(0, cur)) return;
    f32x4 acc[2][2][4][2];
#pragma unroll
    for (int a = 0; a < 2; ++a)
#pragma unroll
        for (int b = 0; b < 2; ++b)
#pragma unroll
            for (int m = 0; m < 4; ++m)
#pragma unroll
                for (int n = 0; n < 2; ++n) acc[a][b][m][n] = (f32x4){0.f, 0.f, 0.f, 0.f};
    bf16x8 At[4][2], B0[2][2], B1[2][2];
    const char* cA = (const char*)gA + (size_t)cur.pm * tstepA; const char* cB = (const char*)gBt + (size_t)cur.pn * tstepB;
    PG8_STAGE(PG8_SB(0, 0), cB, voffB); PG8_STAGE(PG8_SB(0, 1), cB + hstepB, voffB); PG8_STAGE(PG8_SA(0, 0), cA, voffA); PG8_STAGE(PG8_SA(0, 1), cA + hstepA, voffA);
    if (wr == 1) PG8_BAR;
    PG8_WAIT_V(2); PG8_BAR;
    PG8_STAGE(PG8_SB(1, 0), cB + kstep, voffB); PG8_STAGE(PG8_SA(1, 0), cA + kstep, voffA); PG8_STAGE(PG8_SB(1, 1), cB + hstepB + kstep, voffB);
    PG8_WAIT_V(6); PG8_BAR;
    for (;;) {
        const bool has_next = S.next(ui + 1, nxt);
        const char* nA = has_next ? (const char*)gA + (size_t)nxt.pm * tstepA : cA; const char* nB = has_next ? (const char*)gBt + (size_t)nxt.pn * tstepB : cB;
        for (int t = 0; t < nt; t += 2) {
            if (epi == 1 && (t == 8 || t == 16)) { const int tr_ = tid_opaque(); branch_rescale(acc, cur, wr, wc, tr_ & 15, (tr_ & 63) >> 4, t == 8 ? 0 : 1); }
            const bool last = (t == nt - 2);
            const char* a1 = cA + (size_t)(t + 1) * kstep;
            const char* a2 = last ? nA : cA + (size_t)(t + 2) * kstep; const char* b2 = last ? nB : cB + (size_t)(t + 2) * kstep;
            const char* a3 = a2 + kstep; const char* b3 = b2 + kstep;
            PG8_LDB(B0, 0, 0); PG8_LDB(B1, 0, 1); PG8_SCHED; PG8_LDA(At, 0, 0); PG8_STAGE(PG8_SA(1, 1), a1 + hstepA, voffA);
            PG8_WAIT_V(8); PG8_WAIT_L(0); PG8_BAR; PG8_MMA(0, 0, At, B0); PG8_MMA(0, 1, At, B1); PG8_BAR; PG8_SCHED;
            PG8_LDA(At, 0, 1); PG8_STAGE(PG8_SB(0, 0), b2, voffB); PG8_STAGE(PG8_SB(0, 1), b2 + hstepB, voffB); PG8_STAGE(PG8_SA(0, 0), a2, voffA);
            PG8_WAIT_V(8); PG8_WAIT_L(0); PG8_BAR; PG8_MMA(1, 0, At, B0); PG8_MMA(1, 1, At, B1); PG8_BAR; PG8_SCHED;
            PG8_LDB(B0, 1, 0); PG8_LDB(B1, 1, 1); PG8_SCHED; PG8_LDA(At, 1, 0); PG8_STAGE(PG8_SA(0, 1), a2 + hstepA, voffA);
            PG8_WAIT_V(8); PG8_WAIT_L(0); PG8_BAR; PG8_MMA(0, 0, At, B0); PG8_MMA(0, 1, At, B1); PG8_BAR; PG8_SCHED;
            PG8_LDA(At, 1, 1); PG8_STAGE(PG8_SB(1, 0), b3, voffB); PG8_STAGE(PG8_SB(1, 1), b3 + hstepB, voffB); PG8_STAGE(PG8_SA(1, 0), a3, voffA);
            PG8_WAIT_V(8); PG8_WAIT_L(0); PG8_BAR; PG8_MMA(1, 0, At, B0); PG8_MMA(1, 1, At, B1); PG8_BAR; PG8_SCHED;
        }
        if (wr == 0) PG8_BAR;
        const int te = tid_opaque(), fr = te & 15, fq = (te & 63) >> 4;
        switch (epi) {
        case 0: { EpiBf16<NP, true> E; E(acc, cur, wr, wc, fr, fq); } break;
        case 1: { EpiBranchFinal E; E(acc, cur, wr, wc, fr, fq); } break;
        case 4: { EpiResid<false> E{layer, row_base}; E(acc, cur, wr, wc, fr, fq); } break;
        case 5: { EpiUpGlu E{layer}; E(acc, cur, wr, wc, fr, fq); } break;
        default: { EpiResid<true> E{layer, row_base}; E(acc, cur, wr, wc, fr, fq); } break;
        }
        if (!has_next) break;
#pragma unroll
        for (int a = 0; a < 2; ++a)
#pragma unroll
            for (int b = 0; b < 2; ++b)
#pragma unroll
                for (int m = 0; m < 4; ++m)
#pragma unroll
                    for (int n = 0; n < 2; ++n) acc[a][b][m][n] = (f32x4){0.f, 0.f, 0.f, 0.f};
        cur = nxt; cA = nA; cB = nB; ++ui;
        if (wr == 1) PG8_BAR;
    }
    PG8_WAIT_V(0);
    PG8_BAR;
#undef PG8_SA
#undef PG8_SB
#undef PG8_STAGE
#undef PG8_LDA
#undef PG8_LDB
#undef PG8_MMA
#undef PG8_WAIT_V
#undef PG8_WAIT_L
#undef PG8_BAR
#undef PG8_SCHED
}
}

__device__ __forceinline__ void tr_item(const float* W, int K, int ldw, int src_col0, int nblk, bf16* WT, int dst_row0, LAS float* scr, int item, int lane) {
    const int kb = item / nblk, nb = item % nblk, k0 = 64 * kb, n0 = 32 * nb;
    float wv_[32];
#pragma unroll
    for (int i = 0; i < 32; ++i) { const int kk = 2 * i + (lane >> 5); wv_[i] = W[(size_t)(k0 + kk) * ldw + src_col0 + n0 + (lane & 31)]; }
#pragma unroll
    for (int i = 0; i < 32; ++i) { const int kk = 2 * i + (lane >> 5); scr[kk * 33 + (lane & 31)] = wv_[i]; }
    asm volatile("s_waitcnt lgkmcnt(0)" ::: "memory");
    const int c = lane & 7;
#pragma unroll
    for (int j = 0; j < 4; ++j) { const int n = (lane >> 3) + 8 * j; const LAS float* s = scr + (8 * c) * 33 + n;
        u32x4 o; o.x = pk2(s[0 * 33], s[1 * 33]); o.y = pk2(s[2 * 33], s[3 * 33]); o.z = pk2(s[4 * 33], s[5 * 33]); o.w = pk2(s[6 * 33], s[7 * 33]);
        *(u32x4*)(WT + (size_t)(dst_row0 + n0 + n) * K + k0 + 8 * c) = o; }
    asm volatile("s_waitcnt lgkmcnt(0)" ::: "memory");
}
__device__ __forceinline__ void p0_prologue(KP p, LAS unsigned char* lds) {
    const int tid = tid_opaque(), lane = tid & 63, wave = __builtin_amdgcn_readfirstlane(tid >> 6);
    LAS float* scr = (LAS float*)(lds + wave * 16384);
    const int gw = bid_opaque() * 8 + wave, NGW = grid_opaque() * 8;
    constexpr int I_A = 16 * 48, I_B = 16 * 128, I_C = 16 * 96, I_BR = 8 * 32, I_O = 16 * 32, I_U = 16 * 176, I_D = 44 * 32;
    constexpr int PER_LAYER = I_A + I_B + I_C + 3 * I_BR + I_O + I_U + I_D;
    for (int it = gw; it < 2 * PER_LAYER; it += NGW) {
        KP pp = kparams();
        const int l = it / PER_LAYER; int r = it % PER_LAYER;
        bf16* WL = (bf16*)(pp->ws + WS_W) + (size_t)l * W_LAYER;
        const float* W; int K, ldw, src0 = 0, nblk, dst0 = 0; size_t wo;
        if (r < I_A) { W = pp->in[5] + (size_t)l * 1024 * NIN; K = 1024; ldw = NIN; src0 = 0; nblk = 48; wo = W_IN; dst0 = 0; }
        else if ((r -= I_A) < I_B) { W = pp->in[5] + (size_t)l * 1024 * NIN; K = 1024; ldw = NIN; src0 = 1544; nblk = 128; wo = W_IN; dst0 = 1536; }
        else if ((r -= I_B) < I_C) { W = pp->in[5] + (size_t)l * 1024 * NIN; K = 1024; ldw = NIN; src0 = 5648; nblk = 96; wo = W_IN; dst0 = 5632; }
        else if ((r -= I_C) < I_BR) { W = pp->in[18] + (size_t)l * 524288; K = 1536; ldw = 1024; nblk = 32; wo = W_BR; }
        else if ((r -= I_BR) < I_BR) { W = pp->in[19] + (size_t)l * 524288; K = 1536; ldw = 1024; nblk = 32; wo = W_BR + 512; }
        else if ((r -= I_BR) < I_BR) { W = pp->in[20] + (size_t)l * 524288; K = 1536; ldw = 1024; nblk = 32; wo = W_BR + 1024; }
        else if ((r -= I_BR) < I_O) { W = pp->in[21] + (size_t)l * 1048576; K = 1024; ldw = 1024; nblk = 32; wo = W_OUT; }
        else if ((r -= I_O) < I_U) { const int kb_ = r / 176, c_ = 32 * (r % 176);
            W = pp->in[23] + (size_t)l * 1024 * FF2; K = 1024; ldw = FF2; src0 = c_; nblk = 1; wo = W_UP; r = kb_;
            dst0 = c_ < FF ? 256 * (c_ >> 7) + (c_ & 127) : 256 * ((c_ - FF) >> 7) + 128 + ((c_ - FF) & 127); }
        else { r -= I_U; W = pp->in[26] + (size_t)l * FF * 1024; K = FF; ldw = 1024; nblk = 32; wo = W_DN; }
        tr_item(W, K, ldw, src0, nblk, WL + wo, dst0, scr, r, lane);
    }
    {
        const int gt = bid_opaque() * 512 + tid, NT = grid_opaque() * 512;
        for (int e = gt; e < 2 * 16 * 1024; e += NT) {
            const int l = e >> 14, r = (e >> 10) & 15, k = e & 1023;
            const int src = r < 8 ? 1536 + r : 5640 + (r - 8);
            bf16* WL = (bf16*)(p->ws + WS_W) + (size_t)l * W_LAYER;
            WL[W_IN + (size_t)(C_SMALL + r) * 1024 + k] = (bf16)pk1(p->in[5][(size_t)l * 1024 * NIN + (size_t)k * NIN + src]);
        }
    }
    __syncthreads();
    LAS float* cact = (LAS float*)lds;
    LAS float* part = (LAS float*)(lds + 65536);
    bool loaded = false;
    for (int it = bid_opaque(); it < 192; it += grid_opaque()) {
        if (!loaded) { for (int e = tid; e < 16384; e += 512) cact[e] = silu_f(p->in[1][e]); loaded = true; }
        __syncthreads();
        const int l = it / 96, n0 = (it % 96) * 64;
        const float* W = p->in[2] + (size_t)l * 1024 * 6144 + n0 + lane;
        float acc[16];
#pragma unroll
        for (int b = 0; b < 16; ++b) acc[b] = 0.f;
        for (int k16 = 0; k16 < 8; ++k16) {
            const int kb_ = wave * 128 + k16 * 16;
            float wr_[16];
#pragma unroll
            for (int i = 0; i < 16; ++i) wr_[i] = W[(size_t)(kb_ + i) * 6144];
#pragma unroll
            for (int q = 0; q < 4; ++q)
#pragma unroll
                for (int b = 0; b < 16; ++b) { const f32x4 cv = *(const LAS f32x4*)(cact + b * 1024 + kb_ + 4 * q); acc[b] += cv[0] * wr_[4 * q] + cv[1] * wr_[4 * q + 1] + cv[2] * wr_[4 * q + 2] + cv[3] * wr_[4 * q + 3]; }
        }
#pragma unroll
        for (int b = 0; b < 16; ++b) part[(wave * 16 + b) * 64 + lane] = acc[b];
        __syncthreads();
        for (int e = tid; e < 1024; e += 512) { const int b = e >> 6, j = e & 63; float s = 0.f;
#pragma unroll
            for (int w = 0; w < 8; ++w) s += part[(w * 16 + b) * 64 + j];
            ((float*)(p->ws + WS_MOD))[(size_t)(l * 16 + b) * 6144 + n0 + j] = s + p->in[3][(size_t)l * 6144 + n0 + j]; }
    }
}

__device__ __forceinline__ void norm_mod_phase(const float* src  , int row_base, const float* nw, const float* shift, const float* scale, bf16* dst, const bf16* wsmall  , float* smout  ) {
    const int tid_ = tid_opaque(), lane = tid_ & 63, wave = __builtin_amdgcn_readfirstlane(tid_ >> 6);
    const int gw = bid_opaque() * 8 + wave, NGW = grid_opaque() * 8;
    const int rpw = (MH + NGW - 1) / NGW, r0 = gw * rpw, r1 = r0 + rpw < MH ? r0 + rpw : MH;
    if (r0 >= r1) return;
    f32x4 wm[4], sh[4]; int bcur = -1;
    f32x4 v[4], vn[4];
    { const f32x4* xr = (const f32x4*)(src + (size_t)r0 * 1024) + lane;
#pragma unroll
      for (int j = 0; j < 4; ++j) vn[j] = xr[64 * j]; }
    for (int r = r0; r < r1; ++r) {
#pragma unroll
        for (int j = 0; j < 4; ++j) v[j] = vn[j];
        if (r + 1 < r1) { const f32x4* xr = (const f32x4*)(src + (size_t)(r + 1) * 1024) + lane;
#pragma unroll
            for (int j = 0; j < 4; ++j) vn[j] = xr[64 * j]; }
        const int b = (row_base + r) / SEQ;
        if (b != bcur) { bcur = b;
            f32x4 t0[4], t1[4];
#pragma unroll
            for (int j = 0; j < 4; ++j) { const int c = 4 * lane + 256 * j; t0[j] = *(const f32x4*)(nw + c); t1[j] = *(const f32x4*)(scale + (size_t)b * 6144 + c); sh[j] = *(const f32x4*)(shift + (size_t)b * 6144 + c); }
#pragma unroll
            for (int j = 0; j < 4; ++j) wm[j] = t0[j] * (t1[j] + 1.f); }
        float s = 0.f;
#pragma unroll
        for (int j = 0; j < 4; ++j) s += (v[j][0] * v[j][0] + v[j][1] * v[j][1]) + (v[j][2] * v[j][2] + v[j][3] * v[j][3]);
        const float rstd = rsqrtf(wave_sum(s) * (1.f / 1024.f) + EPS);
        u32x2* o8 = (u32x2*)(dst + (size_t)r * 1024) + lane;
#pragma unroll
        for (int j = 0; j < 4; ++j) { const f32x4 y = v[j] * rstd * wm[j] + sh[j]; u32x2 o; o.x = pk2(y[0], y[1]); o.y = pk2(y[2], y[3]); o8[64 * j] = o; }
    }
    if (wsmall != nullptr && rpw == 16) {
        asm volatile("s_waitcnt vmcnt(0)" ::: "memory");
        const int r16 = lane & 15, q4 = lane >> 4;
        const bf16* ap = dst + (size_t)(r0 + r16) * 1024 + q4 * 8; const bf16* bp = wsmall + (size_t)r16 * 1024 + q4 * 8;
        f32x4 acc = (f32x4){0.f, 0.f, 0.f, 0.f};
#pragma unroll 1
        for (int kb = 0; kb < 4; ++kb) {
            bf16x8 af[8], bfr[8];
#pragma unroll
            for (int i = 0; i < 8; ++i) { af[i] = *(const bf16x8*)(ap + (kb * 8 + i) * 32); bfr[i] = *(const bf16x8*)(bp + (kb * 8 + i) * 32); }
#pragma unroll
            for (int i = 0; i < 8; ++i) acc = __builtin_amdgcn_mfma_f32_16x16x32_bf16(af[i], bfr[i], acc, 0, 0, 0);
        }
#pragma unroll
        for (int j = 0; j < 4; ++j) smout[(size_t)(r0 + 4 * q4 + j) * 16 + r16] = acc[j];
    }
}

#define LBAR() do { asm volatile("s_waitcnt lgkmcnt(0)" ::: "memory"); __builtin_amdgcn_s_barrier(); asm volatile("" ::: "memory"); } while (0)

constexpr int HG_QS = 0, HG_KS = 17408, HG_QG = 34816, HG_KET = 52224, HG_GEND = 68608, HG_VT = 70656, HG_SB = 89088, HG_END = 123904;
static_assert(HG_END <= LDS_BYTES, "HGRN LDS map");
__device__ __forceinline__ bf16x8 mk_frag(unsigned a, unsigned b, unsigned c, unsigned d) { u32x4 u; u.x = a; u.y = b; u.z = c; u.w = d; return __builtin_bit_cast(bf16x8, u); }
__device__ __forceinline__ void hgrn_unit(KP p, int idx, int layer, LAS unsigned char* L0) {
    LAS unsigned char* L = lds_opaque(L0);
    const int tid = tid_opaque(), lane = tid & 63, wave = __builtin_amdgcn_readfirstlane(tid >> 6);
    const int bl = idx >> 3, h = (idx >> 1) & 3, dvh = idx & 1; const bool act = wave < 4; const int dvt = dvh * 4 + (wave & 3);
    const bf16* P = (const bf16*)(p->ws + WS_PROJ) + (size_t)bl * SEQ * NP;
    bf16* OR = (bf16*)(p->ws + WS_ORAW) + (size_t)bl * SEQ * OC + 512 + h * 128 + dvt * 16;
    const int pk = tid & 127, psub = tid >> 7;
    float lb = 0.f;
    if (layer == 1) { const float* lp = p->in[10]; lb = sigmoid_f(lp[512 + h * 128 + pk] - lp[h * 128 + pk]); }
    const int r16 = lane & 15, q4 = lane >> 4;
    f32x4 S[8];
#pragma unroll
    for (int i = 0; i < 8; ++i) S[i] = (f32x4){0.f, 0.f, 0.f, 0.f};
    { LAS unsigned char* SB = L + HG_SB + wave * 4352; for (int i = lane; i < 1088; i += 64) ((LAS unsigned*)SB)[i] = 0u; }
    unsigned rq[16], rf[16], rv[16];
    unsigned pq[8], pks[8], pqg[8], ke[8]; float gendv = 0.f;
#define HG_LOAD(mcx) do { if ((mcx) < 64) { const bf16* src_ = P + (size_t)((mcx) * 64 + psub * 16) * NP + h * 128 + pk; \
        _Pragma("unroll") for (int i = 0; i < 16; ++i) { rq[i] = src_[(size_t)i * NP + C_HQ]; rf[i] = src_[(size_t)i * NP + C_HF]; } \
        if (act) { const bf16* srv_ = P + (size_t)((mcx) * 64 + q4 * 16) * NP + C_HI + h * 128 + dvt * 16 + r16; \
            _Pragma("unroll") for (int i = 0; i < 16; ++i) rv[i] = srv_[(size_t)i * NP]; } } } while (0)
#define HG_COMPUTE() do { float qv[16], kv[16], G[16]; float run = 0.f; \
        _Pragma("unroll") for (int i = 0; i < 16; ++i) { const float qr = bf2f(rq[i]), fr = bf2f(rf[i]); const float sg = sigmoid_f(fr), f = lb + (1.f - lb) * sg; \
            run += __logf(f); G[i] = run; kv[i] = (1.f - lb) * (1.f - sg); qv[i] = silu_f(qr); } \
        const float Gref = G[7], Gend = G[15]; const float eref = __expf(Gref), c2 = __expf(Gend - Gref); \
        _Pragma("unroll") for (int i = 0; i < 8; ++i) { \
            const float e1a = __expf(G[2 * i] - Gref), r1a = __builtin_amdgcn_rcpf(e1a), e1b = __expf(G[2 * i + 1] - Gref), r1b = __builtin_amdgcn_rcpf(e1b); \
            pq[i] = pk2(qv[2 * i] * e1a, qv[2 * i + 1] * e1b); pks[i] = pk2(kv[2 * i] * r1a, kv[2 * i + 1] * r1b); \
            pqg[i] = pk2(qv[2 * i] * e1a * eref, qv[2 * i + 1] * e1b * eref); ke[i] = pk2(kv[2 * i] * r1a * c2, kv[2 * i + 1] * r1b * c2); } \
        gendv = __expf(Gend); } while (0)
#define HG_WRITE() do { _Pragma("unroll") for (int i = 0; i < 8; ++i) { const int t_ = psub * 16 + 2 * i; \
            *(LAS bf16*)(L + HG_QS + t_ * 272 + pk * 2) = (bf16)(pq[i] & 0xffffu); *(LAS bf16*)(L + HG_QS + (t_ + 1) * 272 + pk * 2) = (bf16)(pq[i] >> 16); \
            *(LAS bf16*)(L + HG_KS + t_ * 272 + pk * 2) = (bf16)(pks[i] & 0xffffu); *(LAS bf16*)(L + HG_KS + (t_ + 1) * 272 + pk * 2) = (bf16)(pks[i] >> 16); \
            *(LAS bf16*)(L + HG_QG + t_ * 272 + pk * 2) = (bf16)(pqg[i] & 0xffffu); *(LAS bf16*)(L + HG_QG + (t_ + 1) * 272 + pk * 2) = (bf16)(pqg[i] >> 16); } \
        LAS u32x4* kd_ = (LAS u32x4*)(L + HG_KET + (psub * 128 + pk) * 32); kd_[0] = (u32x4){ke[0], ke[1], ke[2], ke[3]}; kd_[1] = (u32x4){ke[4], ke[5], ke[6], ke[7]}; \
        *(LAS float*)(L + HG_GEND + (psub * 128 + pk) * 4) = gendv; } while (0)
    if (act) __builtin_amdgcn_s_setprio(2);
    HG_LOAD(0);
    if (!act) { HG_COMPUTE(); HG_LOAD(1); }
    for (int mc = 0; mc < 64; ++mc) {
        L = lds_opaque(L0);
        LAS unsigned char* VT = L + HG_VT + wave * 2304;
        LAS unsigned char* SB = L + HG_SB + wave * 4352;
        LBAR();
        if (act) {
            HG_COMPUTE(); HG_WRITE();
            {
                unsigned w[8];
#pragma unroll
                for (int i = 0; i < 8; ++i) w[i] = rv[2 * i] | (rv[2 * i + 1] << 16);
                LAS u32x4* vd = (LAS u32x4*)(VT + r16 * 144 + q4 * 32);
                vd[0] = (u32x4){w[0], w[1], w[2], w[3]}; vd[1] = (u32x4){w[4], w[5], w[6], w[7]};
            }
            HG_LOAD(mc + 1);
        } else {
            HG_WRITE();
        }
        LBAR();
        if (!act) { if (mc + 1 < 64) { HG_COMPUTE(); HG_LOAD(mc + 2); } }
        else
#pragma unroll 1
        for (int sb = 0; sb < 4; ++sb) {
            const int t0 = sb * 16;
            f32x4 sc = (f32x4){0.f, 0.f, 0.f, 0.f};
#pragma unroll
            for (int kk = 0; kk < 4; ++kk) {
                const bf16x8 a = *(const LAS bf16x8*)(L + HG_KS + (t0 + r16) * 272 + kk * 64 + q4 * 16);
                const bf16x8 b = *(const LAS bf16x8*)(L + HG_QS + (t0 + r16) * 272 + kk * 64 + q4 * 16);
                sc = __builtin_amdgcn_mfma_f32_16x16x32_bf16(a, b, sc, 0, 0, 0);
            }
#pragma unroll
            for (int j = 0; j < 4; ++j) if (4 * q4 + j > r16) sc[j] = 0.f;
            const bf16x8 a2 = mk_frag(pk2(sc[0], sc[1]), pk2(sc[2], sc[3]), 0u, 0u);
            const u32x2 vv = *(const LAS u32x2*)(VT + r16 * 144 + (t0 + 4 * q4) * 2);
            const bf16x8 b2 = mk_frag(vv.x, vv.y, 0u, 0u);
            f32x4 o = __builtin_amdgcn_mfma_f32_16x16x32_bf16(a2, b2, (f32x4){0.f, 0.f, 0.f, 0.f}, 0, 0, 0);
#pragma unroll
            for (int kk = 0; kk < 4; ++kk) {
                const bf16x8 a = *(const LAS bf16x8*)(L + HG_QG + (t0 + r16) * 272 + kk * 64 + q4 * 16);
                const bf16x8 b = *(const LAS bf16x8*)(SB + r16 * 272 + kk * 64 + q4 * 16);
                o = __builtin_amdgcn_mfma_f32_16x16x32_bf16(a, b, o, 0, 0, 0);
            }
            bf16* orow = OR + (size_t)(mc * 64 + t0 + 4 * q4) * OC + r16;
#pragma unroll
            for (int j = 0; j < 4; ++j) orow[(size_t)j * OC] = (bf16)pk1(o[j]);
#pragma unroll
            for (int kt = 0; kt < 8; ++kt) {
                const u32x2 ke = *(const LAS u32x2*)(L + HG_KET + (sb * 128 + kt * 16 + r16) * 32 + q4 * 8);
                const f32x4 ge = *(const LAS f32x4*)(L + HG_GEND + (sb * 128 + kt * 16 + 4 * q4) * 4);
                S[kt] = __builtin_amdgcn_mfma_f32_16x16x32_bf16(mk_frag(ke.x, ke.y, 0u, 0u), b2, S[kt] * ge, 0, 0, 0);
                *(LAS u32x2*)(SB + r16 * 272 + (kt * 16 + 4 * q4) * 2) = (u32x2){pk2(S[kt][0], S[kt][1]), pk2(S[kt][2], S[kt][3])};
            }
        }
    }
    __builtin_amdgcn_s_setprio(0);
    LBAR();
}


#undef HG_LOAD
#undef HG_COMPUTE
#undef HG_WRITE
constexpr int SD_CS = 0, SD_BS = 17408, SD_BT = 34816, SD_CBS = 53248  , SD_SC = SD_CBS + 2 * 9216, SD_PRIV = SD_SC + 1024, SD_PRIV_SZ = 8960, SD_END = SD_PRIV + 8 * SD_PRIV_SZ;
static_assert(SD_END <= LDS_BYTES, "SSD LDS map");
__device__ __forceinline__ void ssd_unit(KP p, int idx, int layer, LAS unsigned char* L0) {
    LAS unsigned char* L = lds_opaque(L0);
    const int tid = tid_opaque(), lane = tid & 63, wave = __builtin_amdgcn_readfirstlane(tid >> 6);
    const int r16 = lane & 15, q4 = lane >> 4;
    const int bl = idx >> 3, head = idx & 7, g = head >> 2;
    const int hh = 0, pt = wave & 3; const bool act = wave < 4;
    const bf16* P = (const bf16*)(p->ws + WS_PROJ) + (size_t)bl * SEQ * NP;
    const float* SM = (const float*)(p->ws + WS_SM) + (size_t)bl * SEQ * 16;
    bf16* OR = (bf16*)(p->ws + WS_ORAW) + (size_t)bl * SEQ * OC + 1024 + head * 64 + pt * 16;
    const int pc = tid & 255, phalf = tid >> 8, pn = pc & 127; const bool isB = pc >= 128;
    const int xi = (isB ? 512 : 768) + g * 128 + pn;
    const float* cwp = p->in[12] + (size_t)layer * 4096; const float* cbp = p->in[13] + (size_t)layer * 1024;
    const float cw0 = cwp[xi], cw1 = cwp[1024 + xi], cw2 = cwp[2048 + xi], cw3 = cwp[3072 + xi], cb = cbp[xi];
    const int xp = head * 64 + pt * 16 + r16;
    const float xw0 = cwp[xp], xw1 = cwp[1024 + xp], xw2 = cwp[2048 + xp], xw3 = cwp[3072 + xp], xb_ = cbp[xp];
    const float A_h = -__expf(p->in[14][layer * 8 + head]), dtb = p->in[15][layer * 8 + head], Dh = p->in[16][layer * 8 + head];
    f32x4 H[8];
#pragma unroll
    for (int i = 0; i < 8; ++i) H[i] = (f32x4){0.f, 0.f, 0.f, 0.f};
    { LAS unsigned char* HB = L + SD_PRIV + wave * SD_PRIV_SZ + 4608; for (int i = lane; i < 1088; i += 64) ((LAS unsigned*)HB)[i] = 0u; }
    unsigned rs[35], rx[19];
    {
        const bf16* src = P + (size_t)(phalf * 32) * NP + C_XBC + xi;
#pragma unroll
        for (int i = 0; i < 35; ++i) rs[i] = (phalf * 32 - 3 + i >= 0) ? (unsigned)src[(long)(i - 3) * NP] : 0u;
        const bf16* srx = P + (size_t)(q4 * 16) * NP + C_XBC + xp;
#pragma unroll
        for (int i = 0; i < 19; ++i) rx[i] = (act && q4 * 16 - 3 + i >= 0) ? (unsigned)srx[(long)(i - 3) * NP] : 0u;
    }
    for (int c = 0; c < 64; ++c) {
        L = lds_opaque(L0);
        LAS unsigned char* XT = L + SD_PRIV + wave * SD_PRIV_SZ; LAS unsigned char* XDT = XT + 2304; LAS unsigned char* HB = XT + 4608;
        LAS float* ACS = (LAS float*)(L + SD_SC) + hh * 64; LAS float* DT = (LAS float*)(L + SD_SC) + 128 + hh * 64;
        LBAR();
        {
            float x[35];
#pragma unroll
            for (int i = 0; i < 35; ++i) x[i] = bf2f(rs[i]);
            unsigned pkd[16]; unsigned lo = 0;
            LAS unsigned char* dst = L + (isB ? SD_BS : SD_CS) + (phalf * 32) * 272 + pn * 2;
#pragma unroll
            for (int j = 0; j < 32; ++j) {
                const unsigned b = f2bf(silu_f(cw0 * x[j] + cw1 * x[j + 1] + cw2 * x[j + 2] + cw3 * x[j + 3] + cb));
                *(LAS bf16*)(dst + j * 272) = (bf16)b;
                if (j & 1) pkd[j >> 1] = lo | (b << 16); else lo = b;
            }
            if (isB) { LAS u32x4* bt = (LAS u32x4*)(L + SD_BT + pn * 144 + phalf * 64);
#pragma unroll
                for (int i = 0; i < 4; ++i) bt[i] = (u32x4){pkd[4 * i], pkd[4 * i + 1], pkd[4 * i + 2], pkd[4 * i + 3]}; }
        }
        if (wave == 0) {
            const float dtv = softplus_f(SM[(size_t)(c * 64 + lane) * 16 + 8 + head] + dtb);
            const float v = wave_scan_incl(dtv * A_h, lane);
            ACS[lane] = v; DT[lane] = dtv;
            ACS[64 + lane] = __expf(v); DT[64 + lane] = __expf(rdl(v, 63) - v);
        }
        float xv[16];
        if (act) {
            float x[19];
#pragma unroll
            for (int i = 0; i < 19; ++i) x[i] = bf2f(rx[i]);
#pragma unroll
            for (int j = 0; j < 16; ++j) xv[j] = silu_f(xw0 * x[j] + xw1 * x[j + 1] + xw2 * x[j + 2] + xw3 * x[j + 3] + xb_);
        }
        if (c + 1 < 64) {
            const bf16* src = P + (size_t)((c + 1) * 64 + phalf * 32) * NP + C_XBC + xi;
#pragma unroll
            for (int i = 0; i < 35; ++i) rs[i] = src[(long)(i - 3) * NP];
            if (act) { const bf16* srx = P + (size_t)((c + 1) * 64 + q4 * 16) * NP + C_XBC + xp;
#pragma unroll
                for (int i = 0; i < 19; ++i) rx[i] = srx[(long)(i - 3) * NP]; }
        }
        LBAR();
        if (act) {
            unsigned a[8], b[8];
#pragma unroll
            for (int i = 0; i < 4; ++i) { const f32x4 d = *(const LAS f32x4*)(DT + q4 * 16 + 4 * i);
                a[2 * i] = pk2(xv[4 * i], xv[4 * i + 1]); a[2 * i + 1] = pk2(xv[4 * i + 2], xv[4 * i + 3]);
                b[2 * i] = pk2(xv[4 * i] * d[0], xv[4 * i + 1] * d[1]); b[2 * i + 1] = pk2(xv[4 * i + 2] * d[2], xv[4 * i + 3] * d[3]); }
            LAS u32x4* xd = (LAS u32x4*)(XT + r16 * 144 + q4 * 32); xd[0] = (u32x4){a[0], a[1], a[2], a[3]}; xd[1] = (u32x4){a[4], a[5], a[6], a[7]};
            LAS u32x4* yd = (LAS u32x4*)(XDT + r16 * 144 + q4 * 32); yd[0] = (u32x4){b[0], b[1], b[2], b[3]}; yd[1] = (u32x4){b[4], b[5], b[6], b[7]};
        }
        {
            const int tl = wave & 3;
            const LAS float* AC0 = (const LAS float*)(L + SD_SC);
            const f32x4 al0 = *(const LAS f32x4*)(AC0 + 16 * tl + 4 * q4);
#pragma unroll
            for (int u = 0; u < 2; ++u) { const int ts = 2 * (wave >> 2) + u;
                f32x4 acc = (f32x4){0.f, 0.f, 0.f, 0.f};
#pragma unroll
                for (int kk = 0; kk < 4; ++kk) {
                    const bf16x8 a = *(const LAS bf16x8*)(L + SD_CS + (16 * tl + r16) * 272 + kk * 64 + q4 * 16);
                    const bf16x8 b = *(const LAS bf16x8*)(L + SD_BS + (16 * ts + r16) * 272 + kk * 64 + q4 * 16);
                    acc = __builtin_amdgcn_mfma_f32_16x16x32_bf16(a, b, acc, 0, 0, 0);
                }
                const int sidx = 16 * ts + r16; const float as0 = AC0[sidx];
#pragma unroll
                for (int j = 0; j < 4; ++j) { const int l = 16 * tl + 4 * q4 + j;
                    *(LAS bf16*)(L + SD_CBS + l * 144 + sidx * 2) = (bf16)pk1(sidx <= l ? acc[j] * __expf(fminf(al0[j] - as0, 0.f)) : 0.f); }
            }
        }
        LBAR();
        if (act) {
        const float acs_last = ACS[63];
        const bf16x8 xb0 = *(const LAS bf16x8*)(XDT + r16 * 144 + q4 * 16), xb1 = *(const LAS bf16x8*)(XDT + r16 * 144 + 64 + q4 * 16);
#pragma unroll 1
        for (int tl = 0; tl < 4; ++tl) {
            f32x4 acc = (f32x4){0.f, 0.f, 0.f, 0.f};
#pragma unroll
            for (int kk = 0; kk < 4; ++kk) {
                const bf16x8 a = *(const LAS bf16x8*)(L + SD_CS + (16 * tl + r16) * 272 + kk * 64 + q4 * 16);
                const bf16x8 b = *(const LAS bf16x8*)(HB + r16 * 272 + kk * 64 + q4 * 16);
                acc = __builtin_amdgcn_mfma_f32_16x16x32_bf16(a, b, acc, 0, 0, 0);
            }
            acc = acc * *(const LAS f32x4*)(ACS + 64 + 16 * tl + 4 * q4);
            acc = __builtin_amdgcn_mfma_f32_16x16x32_bf16(*(const LAS bf16x8*)(L + SD_CBS + hh * 9216 + (16 * tl + r16) * 144 + q4 * 16), xb0, acc, 0, 0, 0);
            if (tl >= 2) acc = __builtin_amdgcn_mfma_f32_16x16x32_bf16(*(const LAS bf16x8*)(L + SD_CBS + hh * 9216 + (16 * tl + r16) * 144 + 64 + q4 * 16), xb1, acc, 0, 0, 0);
            const u32x2 xs = *(const LAS u32x2*)(XT + r16 * 144 + (16 * tl + 4 * q4) * 2);
            acc[0] += Dh * bflo(xs.x); acc[1] += Dh * bfhi(xs.x); acc[2] += Dh * bflo(xs.y); acc[3] += Dh * bfhi(xs.y);
            bf16* orow = OR + (size_t)(c * 64 + 16 * tl + 4 * q4) * OC + r16;
#pragma unroll
            for (int j = 0; j < 4; ++j) orow[(size_t)j * OC] = (bf16)pk1(acc[j]);
        }
        {
            bf16x8 xe[2];
#pragma unroll
            for (int kk = 0; kk < 2; ++kk) {
                const u32x4 xw = __builtin_bit_cast(u32x4, kk == 0 ? xb0 : xb1);
                const f32x4 s0 = *(const LAS f32x4*)(DT + 64 + kk * 32 + 8 * q4), s1 = *(const LAS f32x4*)(DT + 64 + kk * 32 + 8 * q4 + 4);
                float v[8];
                v[0] = bflo(xw.x); v[1] = bfhi(xw.x); v[2] = bflo(xw.y); v[3] = bfhi(xw.y); v[4] = bflo(xw.z); v[5] = bfhi(xw.z); v[6] = bflo(xw.w); v[7] = bfhi(xw.w);
#pragma unroll
                for (int e = 0; e < 8; ++e) v[e] *= (e < 4 ? s0[e & 3] : s1[e & 3]);
                xe[kk] = mk_frag(pk2(v[0], v[1]), pk2(v[2], v[3]), pk2(v[4], v[5]), pk2(v[6], v[7]));
            }
            const float eh = ACS[64 + 63];
#pragma unroll
            for (int nt = 0; nt < 8; ++nt) {
                H[nt] = H[nt] * eh;
#pragma unroll
                for (int kk = 0; kk < 2; ++kk) {
                    const bf16x8 a = *(const LAS bf16x8*)(L + SD_BT + (16 * nt + r16) * 144 + kk * 64 + q4 * 16);
                    H[nt] = __builtin_amdgcn_mfma_f32_16x16x32_bf16(a, xe[kk], H[nt], 0, 0, 0);
                }
                *(LAS u32x2*)(HB + r16 * 272 + (16 * nt + 4 * q4) * 2) = (u32x2){pk2(H[nt][0], H[nt][1]), pk2(H[nt][2], H[nt][3])};
            }
        }
        }
    }
    LBAR();
}


constexpr int GD_QN = 0, GD_KN = 17408, GD_VN = 34816, GD_MT = 52224, GD_KET = 68608, GD_SC = 87040, GD_PRIV = 88064, GD_PRIV_SZ = 6656, GD_WL = GD_PRIV + 8 * GD_PRIV_SZ, GD_END = GD_WL + 6144;
static_assert(GD_END <= LDS_BYTES, "GDN LDS map");
typedef float f32x2 __attribute__((ext_vector_type(2)));
__device__ __forceinline__ float red8(float v) { v += dppf<0xB1>(v); v += dppf<0x4E>(v); v += dppf<0x141>(v); return v; }
__device__ __forceinline__ float bfel(const u32x4& a, const u32x4& b, int c) { const u32x4& v = (c < 8) ? a : b; const unsigned w = v[(c & 7) >> 1]; return (c & 1) ? bfhi(w) : bflo(w); }
constexpr size_t AUXA_UNIT = 32768, AUXB_UNIT = 40960;
constexpr size_t WS_GE = 920 * 1024;
constexpr int GCNT_WORD = 3648;
constexpr int GCNT_UNUSED = 3584;
__device__ __forceinline__ void gdn1_load_rows(KP p, int u, u32x4 (&xr)[3][4][2]) {
    const int tid0 = tid_opaque(); const int bl = u >> 8, h = (u >> 6) & 3, c = u & 63, t = tid0 >> 3;
    const bf16* Pu = (const bf16*)(p->ws + WS_PROJ) + (size_t)bl * SEQ * NP + h * 128 + (tid0 & 7) * 16;
#pragma unroll
    for (int mat = 0; mat < 3; ++mat)
#pragma unroll
        for (int i = 0; i < 4; ++i) {
            if (c * 64 + t - 3 + i >= 0) { const bf16* src = Pu + (long)(c * 64 + t - 3 + i) * NP + mat * 512; xr[mat][i][0] = *(const u32x4*)src; xr[mat][i][1] = *(const u32x4*)(src + 8); }
            else { xr[mat][i][0] = (u32x4){0u, 0u, 0u, 0u}; xr[mat][i][1] = (u32x4){0u, 0u, 0u, 0u}; }
        }
}
__device__ __forceinline__ void gdn1_unit(KP p, int u, int layer, LAS unsigned char* L0, u32x4 (&xr)[3][4][2], bool load_w, int u_next) {
    LAS unsigned char* L = lds_opaque(L0);
    const int tid0 = tid_opaque(), wave = __builtin_amdgcn_readfirstlane(tid0 >> 6);
    const int bl = u >> 8, h = (u >> 6) & 3, c = u & 63;
    const float sA = __builtin_bit_cast(float, __builtin_amdgcn_readfirstlane(__builtin_bit_cast(int, -__expf(p->in[7][layer * 4 + h])))), sB = __builtin_bit_cast(float, __builtin_amdgcn_readfirstlane(__builtin_bit_cast(int, p->in[8][layer * 4 + h])));
    LBAR();
    if (load_w) {
        const float* cwp = p->in[6] + (size_t)layer * 4 * 1536;
        for (int e = tid0; e < 1536; e += 512) { const int mat = e >> 9, k = (e >> 7) & 3, col = e & 127; *(LAS float*)(L + GD_WL + e * 4) = cwp[k * 1536 + mat * 512 + h * 128 + col]; }
        LBAR();
    }
    {
        LAS float* GC = (LAS float*)(L + GD_SC); LAS float* BETA = GC + 64;
        {
            const int tid = tid_opaque();
            const int t = tid >> 3, seg = tid & 7;
#pragma unroll
            for (int mat = 0; mat < 3; ++mat) {
                float y[16]; float ss = 0.f;
#pragma unroll
                for (int cg = 0; cg < 4; ++cg) {
                    const LAS float* wl = (const LAS float*)(L + GD_WL) + mat * 512 + seg * 16 + 4 * cg;
                    const f32x4 w0 = *(const LAS f32x4*)(wl), w1 = *(const LAS f32x4*)(wl + 128), w2 = *(const LAS f32x4*)(wl + 256), w3 = *(const LAS f32x4*)(wl + 384);
#pragma unroll
                    for (int e = 0; e < 4; ++e) { const int ci = 4 * cg + e;
                        const float v = silu_f(w0[e] * bfel(xr[mat][0][0], xr[mat][0][1], ci) + w1[e] * bfel(xr[mat][1][0], xr[mat][1][1], ci) + w2[e] * bfel(xr[mat][2][0], xr[mat][2][1], ci) + w3[e] * bfel(xr[mat][3][0], xr[mat][3][1], ci));
                        y[ci] = v; ss += v * v; }
                }
                float r = 1.f;
                if (mat < 2) { ss = red8(ss); r = rsqrtf(ss + EPS) * (mat == 0 ? 0.08838834764831845f : 1.f); }
                LAS u32x4* d = (LAS u32x4*)(L + (mat == 0 ? GD_QN : mat == 1 ? GD_KN : GD_VN) + t * 272 + seg * 32);
                d[0] = (u32x4){pk2(y[0] * r, y[1] * r), pk2(y[2] * r, y[3] * r), pk2(y[4] * r, y[5] * r), pk2(y[6] * r, y[7] * r)};
                d[1] = (u32x4){pk2(y[8] * r, y[9] * r), pk2(y[10] * r, y[11] * r), pk2(y[12] * r, y[13] * r), pk2(y[14] * r, y[15] * r)};
            }
        }
        if (wave == 0) {
            const int tid = tid_opaque(), lane = tid & 63, r16 = lane & 15, q4 = lane >> 4; (void)r16; (void)q4; (void)lane;
            KP pp = kparams(); const float* sm = (const float*)(pp->ws + WS_SM) + ((size_t)bl * SEQ + c * 64 + lane) * 16;
            const float v = wave_scan_incl(sA * softplus_f(sm[h] + sB), lane);
            GC[lane] = v; BETA[lane] = sigmoid_f(sm[4 + h]);
        }
        LBAR();
        f32x4 at[2];
        {
            const int tid = tid_opaque(), lane = tid & 63, r16 = lane & 15, q4 = lane >> 4; (void)r16; (void)q4; (void)lane;
            const int tl = wave & 3;
            const f32x4 gl = *(const LAS f32x4*)(GC + 16 * tl + 4 * q4), bl4 = *(const LAS f32x4*)(BETA + 16 * tl + 4 * q4);
#pragma unroll
            for (int u = 0; u < 2; ++u) { const int ts = 2 * (wave >> 2) + u;
                f32x4 kk = (f32x4){0.f, 0.f, 0.f, 0.f}, qk = (f32x4){0.f, 0.f, 0.f, 0.f};
#pragma unroll
                for (int k4 = 0; k4 < 4; ++k4) {
                    const bf16x8 b = *(const LAS bf16x8*)(L + GD_KN + (16 * ts + r16) * 272 + k4 * 64 + q4 * 16);
                    const bf16x8 ak = *(const LAS bf16x8*)(L + GD_KN + (16 * tl + r16) * 272 + k4 * 64 + q4 * 16);
                    const bf16x8 aq = *(const LAS bf16x8*)(L + GD_QN + (16 * tl + r16) * 272 + k4 * 64 + q4 * 16);
                    kk = __builtin_amdgcn_mfma_f32_16x16x32_bf16(ak, b, kk, 0, 0, 0);
                    qk = __builtin_amdgcn_mfma_f32_16x16x32_bf16(aq, b, qk, 0, 0, 0);
                }
                const int sidx = 16 * ts + r16; const float gs = GC[sidx];
                f32x4 m;
#pragma unroll
                for (int j = 0; j < 4; ++j) { const int l = 16 * tl + 4 * q4 + j; const float dec = __expf(fminf(gl[j] - gs, 0.f));
                    m[j] = (sidx < l) ? bl4[j] * kk[j] * dec : 0.f; qk[j] = (sidx <= l) ? qk[j] * dec : 0.f; }
                *(LAS f32x4*)(L + GD_MT + sidx * 256 + (16 * tl + 4 * q4) * 4) = m;
                at[u] = qk;
            }
        }
        LBAR();
        f32x2 acc2[32];
        if (wave < 4) {
            const int tid = tid_opaque(), lane = tid & 63, r16 = lane & 15, q4 = lane >> 4; (void)r16; (void)q4; (void)lane;
            const LAS unsigned char* rb = L + (tid < 128 ? GD_VN : GD_KN) + (tid & 127) * 2;
#pragma unroll
            for (int l4 = 0; l4 < 16; ++l4) {
                const f32x4 b4 = *(const LAS f32x4*)(BETA + 4 * l4); f32x4 g4 = (f32x4){1.f, 1.f, 1.f, 1.f};
                if (tid >= 128) { const f32x4 gg = *(const LAS f32x4*)(GC + 4 * l4); g4 = (f32x4){__expf(gg[0]), __expf(gg[1]), __expf(gg[2]), __expf(gg[3])}; }
                acc2[2 * l4] = (f32x2){bf2f(*(const LAS bf16*)(rb + (4 * l4) * 272)) * b4[0] * g4[0], bf2f(*(const LAS bf16*)(rb + (4 * l4 + 1) * 272)) * b4[1] * g4[1]};
                acc2[2 * l4 + 1] = (f32x2){bf2f(*(const LAS bf16*)(rb + (4 * l4 + 2) * 272)) * b4[2] * g4[2], bf2f(*(const LAS bf16*)(rb + (4 * l4 + 3) * 272)) * b4[3] * g4[3]};
            }
#pragma unroll
            for (int s_ = 0; s_ < 63; ++s_) {
                const float xs = (s_ & 1) ? acc2[s_ >> 1][1] : acc2[s_ >> 1][0]; const f32x2 xs2 = (f32x2){xs, xs};
#pragma unroll
                for (int l4 = ((s_ + 1) >> 2) << 2; l4 < 64; l4 += 4) {
                    const f32x4 m = *(const LAS f32x4*)(L + GD_MT + s_ * 256 + l4 * 4);
                    acc2[l4 >> 1] -= (f32x2){m[0], m[1]} * xs2;
                    acc2[(l4 >> 1) + 1] -= (f32x2){m[2], m[3]} * xs2;
                }
            }
        } else {
            const int tid = tid_opaque(), lane = tid & 63, r16 = lane & 15, q4 = lane >> 4; (void)r16; (void)q4; (void)lane;
            const int tt = tid - 256, t = tt >> 2, sg = tt & 3;
            const float gt = GC[t]; const float eg = __expf(gt), ee = __expf(GC[63] - gt);
            LAS u32x4* qp = (LAS u32x4*)(L + GD_QN + t * 272 + sg * 64);
            const LAS u32x4* kp = (const LAS u32x4*)(L + GD_KN + t * 272 + sg * 64);
#pragma unroll
            for (int i = 0; i < 4; ++i) {
                const u32x4 w = qp[i];
                qp[i] = (u32x4){pk2(bflo(w.x) * eg, bfhi(w.x) * eg), pk2(bflo(w.y) * eg, bfhi(w.y) * eg), pk2(bflo(w.z) * eg, bfhi(w.z) * eg), pk2(bflo(w.w) * eg, bfhi(w.w) * eg)};
                const u32x4 kw = kp[i];
                LAS unsigned char* kd = L + GD_KET + (sg * 32 + i * 8) * 144 + t * 2;
                *(LAS bf16*)(kd + 0 * 144) = (bf16)pk1(bflo(kw.x) * ee); *(LAS bf16*)(kd + 1 * 144) = (bf16)pk1(bfhi(kw.x) * ee);
                *(LAS bf16*)(kd + 2 * 144) = (bf16)pk1(bflo(kw.y) * ee); *(LAS bf16*)(kd + 3 * 144) = (bf16)pk1(bfhi(kw.y) * ee);
                *(LAS bf16*)(kd + 4 * 144) = (bf16)pk1(bflo(kw.z) * ee); *(LAS bf16*)(kd + 5 * 144) = (bf16)pk1(bfhi(kw.z) * ee);
                *(LAS bf16*)(kd + 6 * 144) = (bf16)pk1(bflo(kw.w) * ee); *(LAS bf16*)(kd + 7 * 144) = (bf16)pk1(bfhi(kw.w) * ee);
            }
        }
        LBAR();
        if (wave < 2) {
            const int tid = tid_opaque(), lane = tid & 63, r16 = lane & 15, q4 = lane >> 4; (void)r16; (void)q4; (void)lane;
            LAS u32x2* ud = (LAS u32x2*)(L + GD_KN + tid * 136);
#pragma unroll
            for (int i = 0; i < 16; ++i) ud[i] = (u32x2){pk2(acc2[2 * i][0], acc2[2 * i][1]), pk2(acc2[2 * i + 1][0], acc2[2 * i + 1][1])};
        } else if (wave < 4) {
            const int tid = tid_opaque(), lane = tid & 63, r16 = lane & 15, q4 = lane >> 4; (void)r16; (void)q4; (void)lane;
            LAS unsigned char* wd = L + GD_VN + (tid - 128) * 2;
#pragma unroll
            for (int i = 0; i < 32; ++i) { *(LAS bf16*)(wd + (2 * i) * 272) = (bf16)pk1(acc2[i][0]); *(LAS bf16*)(wd + (2 * i + 1) * 272) = (bf16)pk1(acc2[i][1]); }
        }
        {
            const int tid = tid_opaque(), lane = tid & 63, r16 = lane & 15, q4 = lane >> 4; (void)r16; (void)q4; (void)lane;
            const int tl = wave & 3;
#pragma unroll
            for (int u = 0; u < 2; ++u) { const int ts = 2 * (wave >> 2) + u;
#pragma unroll
                for (int j = 0; j < 4; ++j) *(LAS bf16*)(L + GD_MT + (16 * tl + 4 * q4 + j) * 144 + (16 * ts + r16) * 2) = (bf16)pk1(at[u][j]); }
        }
        LBAR();
        {
            const int tid = tid_opaque();
            KP pp = kparams();
            const __amdgpu_buffer_rsrc_t ra_ = __builtin_amdgcn_make_buffer_rsrc((void*)(pp->ws + WS_H + (size_t)u * AUXA_UNIT), (short)0, (int)AUXA_UNIT, 0x00020000);
            const __amdgpu_buffer_rsrc_t rb_ = __builtin_amdgcn_make_buffer_rsrc((void*)(pp->ws + WS_OCAT + (size_t)u * AUXB_UNIT), (short)0, (int)AUXB_UNIT, 0x00020000);
#pragma unroll
            for (int k = 0; k < 2; ++k) { const int i = tid + 512 * k;
                __builtin_amdgcn_raw_buffer_store_b128(*(const LAS u32x4*)(L + GD_VN + (i >> 4) * 272 + (i & 15) * 16), ra_, i * 16, 0, 16);
                __builtin_amdgcn_raw_buffer_store_b128(*(const LAS u32x4*)(L + GD_QN + (i >> 4) * 272 + (i & 15) * 16), rb_, i * 16, 0, 16);
                __builtin_amdgcn_raw_buffer_store_b128(*(const LAS u32x4*)(L + GD_KET + (i >> 3) * 144 + (i & 7) * 16), rb_, 16384 + i * 16, 0, 16); }
#pragma unroll
            for (int k = 0; k < 4; ++k) { const int i = tid + 512 * k; __builtin_amdgcn_raw_buffer_store_b64(*(const LAS u32x2*)(L + GD_KN + (i >> 4) * 136 + (i & 15) * 8), ra_, 16384 + i * 8, 0, 16); }
            __builtin_amdgcn_raw_buffer_store_b128(*(const LAS u32x4*)(L + GD_MT + (tid >> 3) * 144 + (tid & 7) * 16), rb_, 32768 + tid * 16, 0, 16);
            if (tid == 0) __hip_atomic_store((float*)(pp->ws + WS_GE) + u, __expf(GC[63]), __ATOMIC_RELAXED, __HIP_MEMORY_SCOPE_AGENT);
            asm volatile("s_waitcnt vmcnt(0)" ::: "memory");
            __syncthreads();
            if (tid == 0) (void)__hip_atomic_fetch_add((unsigned*)(pp->ws + WS_BAR) + GCNT_WORD + c, 1u, __ATOMIC_RELAXED, __HIP_MEMORY_SCOPE_AGENT);
        }
    }
    gdn1_load_rows(kparams(), u_next, xr);
}
#define GDN2_ENSURE(cn) do { if ((cn) >= ready_upto) { const int hi_ = ready_upto + 8 < 64 ? ready_upto + 8 : 64; \
        if (tid_opaque() == 0) { unsigned* cnt_ = (unsigned*)(kparams()->ws + WS_BAR) + GCNT_WORD; unsigned sp_ = 0; \
            for (int cc_ = ready_upto; cc_ < hi_; ++cc_) while (__hip_atomic_load(cnt_ + cc_, __ATOMIC_RELAXED, __HIP_MEMORY_SCOPE_AGENT) < want) { __builtin_amdgcn_s_sleep(2); if (++sp_ > (1u << 24)) break; } \
            __builtin_amdgcn_fence(__ATOMIC_ACQUIRE, "agent"); asm volatile("s_waitcnt vmcnt(0)" ::: "memory"); } \
        __syncthreads(); ready_upto = hi_; } } while (0)
__device__ __forceinline__ void gdn2_unit(KP p, int idx, int layer, int pass, LAS unsigned char* L0) {
    const unsigned want = 32u * (unsigned)(pass + 1); int ready_upto = 0;
    LAS unsigned char* L = lds_opaque(L0);
    const int tid0 = tid_opaque(), wave = __builtin_amdgcn_readfirstlane(tid0 >> 6);
    const int bl = idx >> 2, h = idx & 3;
    { LAS unsigned char* SB = L + GD_PRIV + wave * GD_PRIV_SZ + 2304; for (int i = tid0 & 63; i < 1088; i += 64) ((LAS unsigned*)SB)[i] = 0u; }
    f32x4 S[8];
#pragma unroll
    for (int i = 0; i < 8; ++i) S[i] = (f32x4){0.f, 0.f, 0.f, 0.f};
    const size_t u0 = (size_t)(bl * 4 + h) * 64;
    u32x4 rw[2], rq[2], rk[2], ra; u32x2 ru[4]; float rge;
    GDN2_ENSURE(0);
    {
        const unsigned char* A = p->ws + WS_H + u0 * AUXA_UNIT; const unsigned char* B = p->ws + WS_OCAT + u0 * AUXB_UNIT;
#pragma unroll
        for (int k = 0; k < 2; ++k) { const int i = tid0 + 512 * k; rw[k] = ((const u32x4*)A)[i]; rq[k] = ((const u32x4*)B)[i]; rk[k] = ((const u32x4*)(B + 16384))[i]; }
#pragma unroll
        for (int k = 0; k < 4; ++k) ru[k] = ((const u32x2*)(A + 16384))[tid0 + 512 * k];
        ra = ((const u32x4*)(B + 32768))[tid0]; rge = ((const float*)(p->ws + WS_GE))[u0];
    }
    for (int c = 0; c < 64; ++c) {
        L = lds_opaque(L0);
        LAS unsigned char* VNT = L + GD_PRIV + wave * GD_PRIV_SZ; LAS unsigned char* SB = VNT + 2304;
        LBAR();
        const float ge = rge;
        {
            const int tid = tid_opaque();
#pragma unroll
            for (int k = 0; k < 2; ++k) { const int i = tid + 512 * k;
                *(LAS u32x4*)(L + GD_VN + (i >> 4) * 272 + (i & 15) * 16) = rw[k];
                *(LAS u32x4*)(L + GD_QN + (i >> 4) * 272 + (i & 15) * 16) = rq[k];
                *(LAS u32x4*)(L + GD_KET + (i >> 3) * 144 + (i & 7) * 16) = rk[k]; }
#pragma unroll
            for (int k = 0; k < 4; ++k) { const int i = tid + 512 * k; *(LAS u32x2*)(L + GD_KN + (i >> 4) * 136 + (i & 15) * 8) = ru[k]; }
            *(LAS u32x4*)(L + GD_MT + (tid >> 3) * 144 + (tid & 7) * 16) = ra;
        }
        LBAR();
        GDN2_ENSURE(c + 1 < 64 ? c + 1 : 63);
        {
            const int tid = tid_opaque(); KP pp = kparams();
            const size_t un = u0 + (c + 1 < 64 ? c + 1 : 63);
            const unsigned char* A = pp->ws + WS_H + un * AUXA_UNIT; const unsigned char* B = pp->ws + WS_OCAT + un * AUXB_UNIT;
#pragma unroll
            for (int k = 0; k < 2; ++k) { const int i = tid + 512 * k; rw[k] = ((const u32x4*)A)[i]; rq[k] = ((const u32x4*)B)[i]; rk[k] = ((const u32x4*)(B + 16384))[i]; }
#pragma unroll
            for (int k = 0; k < 4; ++k) ru[k] = ((const u32x2*)(A + 16384))[tid + 512 * k];
            ra = ((const u32x4*)(B + 32768))[tid]; rge = ((const float*)(pp->ws + WS_GE))[un];
        }
        {
            const int tid = tid_opaque(), lane = tid & 63, r16 = lane & 15, q4 = lane >> 4; (void)r16; (void)q4; (void)lane;
            KP pp = kparams(); bf16* ORp = (bf16*)(pp->ws + WS_ORAW) + (size_t)bl * SEQ * OC + h * 128 + wave * 16;
            bf16x8 sbf[4];
#pragma unroll
            for (int k4 = 0; k4 < 4; ++k4) sbf[k4] = *(const LAS bf16x8*)(SB + r16 * 272 + k4 * 64 + q4 * 16);
#pragma unroll
            for (int tl = 0; tl < 4; ++tl) {
                f32x4 p1 = (f32x4){0.f, 0.f, 0.f, 0.f};
#pragma unroll
                for (int k4 = 0; k4 < 4; ++k4) p1 = __builtin_amdgcn_mfma_f32_16x16x32_bf16(*(const LAS bf16x8*)(L + GD_VN + (16 * tl + r16) * 272 + k4 * 64 + q4 * 16), sbf[k4], p1, 0, 0, 0);
                const u32x2 uu = *(const LAS u32x2*)(L + GD_KN + (16 * wave + r16) * 136 + (16 * tl + 4 * q4) * 2);
                *(LAS u32x2*)(VNT + r16 * 144 + (16 * tl + 4 * q4) * 2) = (u32x2){pk2(bflo(uu.x) - p1[0], bfhi(uu.x) - p1[1]), pk2(bflo(uu.y) - p1[2], bfhi(uu.y) - p1[3])};
            }
            const bf16x8 vb0 = *(const LAS bf16x8*)(VNT + r16 * 144 + q4 * 16), vb1 = *(const LAS bf16x8*)(VNT + r16 * 144 + 64 + q4 * 16);
#pragma unroll
            for (int tl = 0; tl < 4; ++tl) {
                f32x4 o = (f32x4){0.f, 0.f, 0.f, 0.f};
#pragma unroll
                for (int k4 = 0; k4 < 4; ++k4) o = __builtin_amdgcn_mfma_f32_16x16x32_bf16(*(const LAS bf16x8*)(L + GD_QN + (16 * tl + r16) * 272 + k4 * 64 + q4 * 16), sbf[k4], o, 0, 0, 0);
                o = __builtin_amdgcn_mfma_f32_16x16x32_bf16(*(const LAS bf16x8*)(L + GD_MT + (16 * tl + r16) * 144 + q4 * 16), vb0, o, 0, 0, 0);
                if (tl >= 2) o = __builtin_amdgcn_mfma_f32_16x16x32_bf16(*(const LAS bf16x8*)(L + GD_MT + (16 * tl + r16) * 144 + 64 + q4 * 16), vb1, o, 0, 0, 0);
                bf16* orow = ORp + (size_t)(c * 64 + 16 * tl + 4 * q4) * OC + r16;
#pragma unroll
                for (int j = 0; j < 4; ++j) orow[(size_t)j * OC] = (bf16)pk1(o[j]);
            }
#pragma unroll
            for (int kt = 0; kt < 8; ++kt) {
                S[kt] = S[kt] * ge;
                S[kt] = __builtin_amdgcn_mfma_f32_16x16x32_bf16(*(const LAS bf16x8*)(L + GD_KET + (16 * kt + r16) * 144 + q4 * 16), vb0, S[kt], 0, 0, 0);
                S[kt] = __builtin_amdgcn_mfma_f32_16x16x32_bf16(*(const LAS bf16x8*)(L + GD_KET + (16 * kt + r16) * 144 + 64 + q4 * 16), vb1, S[kt], 0, 0, 0);
                *(LAS u32x2*)(SB + r16 * 272 + (16 * kt + 4 * q4) * 2) = (u32x2){pk2(S[kt][0], S[kt][1]), pk2(S[kt][2], S[kt][3])};
            }
        }
    }
    LBAR();
}

__device__ __forceinline__ void normgate_phase(KP p, int layer) {
    const int tid_ = tid_opaque(), lane = tid_ & 63, wave = __builtin_amdgcn_readfirstlane(tid_ >> 6);
    const bf16* P = (const bf16*)(p->ws + WS_PROJ); const bf16* ORAW = (const bf16*)(p->ws + WS_ORAW); bf16* OCAT = (bf16*)(p->ws + WS_OCAT);
    const int gw = bid_opaque() * 8 + wave, NGW = grid_opaque() * 8;
    const int c4 = 4 * lane;
    const f32x4 wg = *(const f32x4*)(p->in[9] + layer * 128 + (c4 & 127)), wh = *(const f32x4*)(p->in[11] + layer * 128 + (c4 & 127));
    const f32x4 ws0 = *(const f32x4*)(p->in[17] + layer * 512 + c4), ws1 = *(const f32x4*)(p->in[17] + layer * 512 + 256 + c4);
    const int rpw = (MH + NGW - 1) / NGW, r0 = gw * rpw, r1 = r0 + rpw < MH ? r0 + rpw : MH;
    if (r0 >= r1) return;
    u32x2 on[6], zn[6];
    { const bf16* o = ORAW + (size_t)r0 * OC + c4; const bf16* pr = P + (size_t)r0 * NP + c4;
#pragma unroll
      for (int j = 0; j < 6; ++j) on[j] = *(const u32x2*)(o + 256 * j);
      zn[0] = *(const u32x2*)(pr + C_GZ); zn[1] = *(const u32x2*)(pr + C_GZ + 256); zn[2] = *(const u32x2*)(pr + C_HG); zn[3] = *(const u32x2*)(pr + C_HG + 256); zn[4] = *(const u32x2*)(pr + C_SZ); zn[5] = *(const u32x2*)(pr + C_SZ + 256); }
    for (int r = r0; r < r1; ++r) {
        bf16* oc = OCAT + (size_t)r * OC + c4;
        f32x4 v[6]; u32x2 z[6];
#pragma unroll
        for (int j = 0; j < 6; ++j) { v[j] = (f32x4){bflo(on[j].x), bfhi(on[j].x), bflo(on[j].y), bfhi(on[j].y)}; z[j] = zn[j]; }
        if (r + 1 < r1) { const bf16* o = ORAW + (size_t)(r + 1) * OC + c4; const bf16* pr = P + (size_t)(r + 1) * NP + c4;
#pragma unroll
            for (int j = 0; j < 6; ++j) on[j] = *(const u32x2*)(o + 256 * j);
            zn[0] = *(const u32x2*)(pr + C_GZ); zn[1] = *(const u32x2*)(pr + C_GZ + 256); zn[2] = *(const u32x2*)(pr + C_HG); zn[3] = *(const u32x2*)(pr + C_HG + 256); zn[4] = *(const u32x2*)(pr + C_SZ); zn[5] = *(const u32x2*)(pr + C_SZ + 256); }
#pragma unroll
        for (int j = 0; j < 6; ++j) {
            f32x4 g; g[0] = silu_f(bflo(z[j].x)); g[1] = silu_f(bfhi(z[j].x)); g[2] = silu_f(bflo(z[j].y)); g[3] = silu_f(bfhi(z[j].y));
            f32x4 x = v[j]; if (j >= 4) x = x * g;
            float ss = (x[0] * x[0] + x[1] * x[1]) + (x[2] * x[2] + x[3] * x[3]);
            ss = red16(ss);
            const float s0 = rdl(ss, 0), s1 = rdl(ss, 16), s2 = rdl(ss, 32), s3 = rdl(ss, 48);
            float tot, inv;
            if (j >= 4) { tot = (s0 + s1) + (s2 + s3); inv = 1.f / 256.f; } else { tot = lane < 32 ? s0 + s1 : s2 + s3; inv = 1.f / 128.f; }
            const float rstd = rsqrtf(tot * inv + EPS);
            const f32x4 w = j < 2 ? wg : j < 4 ? wh : j == 4 ? ws0 : ws1;
            f32x4 y = x * rstd * w; if (j < 4) y = y * g;
            u32x2 ov; ov.x = pk2(y[0], y[1]); ov.y = pk2(y[2], y[3]);
            *(u32x2*)(oc + 256 * j) = ov;
        }
    }
}

__device__ __forceinline__ void glu_fix_phase(KP p, int layer) {
    const bf16* RB = (const bf16*)(p->ws + WS_RAWB); bf16* G = (bf16*)(p->ws + WS_G);
    const float* cw = p->in[24] + (size_t)layer * 3 * FF2; const float* cbp = p->in[25] + (size_t)layer * FF2;
    const int gt = bid_opaque() * 512 + tid_opaque(), NT = grid_opaque() * 512;
    constexpr int NPAIR = FF / 2;
    for (int idx = gt; idx < (MH / 64) * NPAIR; idx += NT) {
        const int b = idx / NPAIR, c = (idx % NPAIR) * 2;
        unsigned g[4], v[4];
#pragma unroll
        for (int s_ = 0; s_ < 4; ++s_) { g[s_] = *(const unsigned*)(RB + (size_t)(b * 4 + s_) * FF2 + c); v[s_] = *(const unsigned*)(RB + (size_t)(b * 4 + s_) * FF2 + FF + c); }
        if (((b * 64) % SEQ) == 0) { g[0] = 0u; g[1] = 0u; v[0] = 0u; v[1] = 0u; }
        float wg[3][2], wv[3][2];
#pragma unroll
        for (int k = 0; k < 3; ++k) { wg[k][0] = cw[k * FF2 + c]; wg[k][1] = cw[k * FF2 + c + 1]; wv[k][0] = cw[k * FF2 + FF + c]; wv[k][1] = cw[k * FF2 + FF + c + 1]; }
        const float bg0 = cbp[c], bg1 = cbp[c + 1], bv0 = cbp[FF + c], bv1 = cbp[FF + c + 1];
#pragma unroll
        for (int r = 0; r < 2; ++r) {
            const float ga = wg[0][0] * bflo(g[r]) + wg[1][0] * bflo(g[r + 1]) + wg[2][0] * bflo(g[r + 2]) + bg0;
            const float gb = wg[0][1] * bfhi(g[r]) + wg[1][1] * bfhi(g[r + 1]) + wg[2][1] * bfhi(g[r + 2]) + bg1;
            const float va = wv[0][0] * bflo(v[r]) + wv[1][0] * bflo(v[r + 1]) + wv[2][0] * bflo(v[r + 2]) + bv0;
            const float vb = wv[0][1] * bfhi(v[r]) + wv[1][1] * bfhi(v[r + 1]) + wv[2][1] * bfhi(v[r + 2]) + bv1;
            *(unsigned*)(G + (size_t)(b * 64 + r) * FF + c) = pk2(silu_f(ga) * va, silu_f(gb) * vb);
        }
    }
}

__device__ __forceinline__ void final_norm_phase(KP p) {
    const int tid_ = tid_opaque(), lane = tid_ & 63, wave = __builtin_amdgcn_readfirstlane(tid_ >> 6);
    const int gw = bid_opaque() * 8 + wave, NGW = grid_opaque() * 8;
    const float* nw = p->in[27];
    const int rpw = (MTOT + NGW - 1) / NGW, r0 = gw * rpw, r1 = r0 + rpw < MTOT ? r0 + rpw : MTOT;
    if (r0 >= r1) return;
    f32x4 w[4], v[4], vn[4];
#pragma unroll
    for (int j = 0; j < 4; ++j) { w[j] = *(const f32x4*)(nw + 4 * lane + 256 * j); vn[j] = ((const f32x4*)(p->out + (size_t)r0 * 1024) + lane)[64 * j]; }
    for (int r = r0; r < r1; ++r) {
#pragma unroll
        for (int j = 0; j < 4; ++j) v[j] = vn[j];
        if (r + 1 < r1) {
#pragma unroll
            for (int j = 0; j < 4; ++j) vn[j] = ((const f32x4*)(p->out + (size_t)(r + 1) * 1024) + lane)[64 * j]; }
        float s = 0.f;
#pragma unroll
        for (int j = 0; j < 4; ++j) s += (v[j][0] * v[j][0] + v[j][1] * v[j][1]) + (v[j][2] * v[j][2] + v[j][3] * v[j][3]);
        const float rstd = rsqrtf(wave_sum(s) * (1.f / 1024.f) + EPS);
        f32x4* xr = (f32x4*)(p->out + (size_t)r * 1024) + lane;
#pragma unroll
        for (int j = 0; j < 4; ++j) xr[64 * j] = v[j] * rstd * w[j];
    }
}


#define XB_TMO      128
#define XB_XCNT(j)  (256  + 64 * (j))
#define XB_XSUB(j)  (1280 + 64 * (j))
#define XB_XGEN(j)  (2304 + 64 * (j))
#define XB_TOP      3328
#define XB_TOPGEN   3392
#define XCD_BAR_WORDS 3456
#define XB_SPIN_CAP (1u << 20)
__device__ __forceinline__ unsigned xb_ld(unsigned* p)              { return __hip_atomic_load(p, __ATOMIC_RELAXED, __HIP_MEMORY_SCOPE_AGENT); }
__device__ __forceinline__ unsigned xb_add(unsigned* p, unsigned v) { return __hip_atomic_fetch_add(p, v, __ATOMIC_RELAXED, __HIP_MEMORY_SCOPE_AGENT); }
__device__ __forceinline__ unsigned xb_xcc_id() { return (unsigned)__builtin_amdgcn_s_getreg((3 << 11) | 20) & 0xFu; }
#define XB_SPIN(cond, bar) do { unsigned _sp = 0; while (cond) { __builtin_amdgcn_s_sleep(1); \
    if ((++_sp & 255u) == 0u) { if (xb_ld(&(bar)[XB_TMO])) break; if (_sp > XB_SPIN_CAP) { atomicAdd(&(bar)[XB_TMO], 1u); break; } } } } while (0)
struct XcdBarrier { unsigned* bar; unsigned x; volatile LAS unsigned* st; };
__device__ __forceinline__ XcdBarrier xcd_barrier_post(unsigned* bar, volatile LAS unsigned* st) {
    XcdBarrier b; b.bar = bar; b.x = xb_xcc_id(); b.st = st;
    if (threadIdx.x == 0) (void)xb_add(&bar[XB_XCNT(b.x)], 1u);
    return b;
}
__device__ __forceinline__ void xcd_barrier_complete(unsigned* bar, unsigned x, unsigned& nloc, unsigned& nx) {
    const unsigned G = gridDim.x * gridDim.y * gridDim.z;
    unsigned sum, cnt, mine, sp = 0u;
    for (;;) {
        sum = 0u; cnt = 0u; mine = 0u;
#pragma unroll
        for (unsigned j = 0; j < 16; ++j) { const unsigned c = xb_ld(&bar[XB_XCNT(j)]); sum += c; cnt += (c > 0u) ? 1u : 0u; mine = (j == x) ? c : mine; }
        if (sum == G) break;
        __builtin_amdgcn_s_sleep(1);
        if ((++sp & 255u) == 0u) { if (xb_ld(&bar[XB_TMO])) break; if (sp > XB_SPIN_CAP) { atomicAdd(&bar[XB_TMO], 1u); break; } }
    }
    nloc = mine > 0u ? mine : 1u; nx = cnt > 0u ? cnt : 1u;
}
__device__ __forceinline__ void xcd_barrier(const XcdBarrier& b) {
    asm volatile("s_waitcnt vmcnt(0)" ::: "memory");
    __syncthreads();
    if (threadIdx.x == 0) {
        unsigned* bar = b.bar;
        __builtin_amdgcn_s_waitcnt(0);
        unsigned nloc = b.st[0], nx = b.st[1];
        if (nloc == 0u) { xcd_barrier_complete(bar, b.x, nloc, nx); b.st[0] = nloc; b.st[1] = nx; }
        const unsigned old = xb_add(&bar[XB_XSUB(b.x)], 1u);
        const unsigned gen = old / nloc;
        if (old + 1u == (gen + 1u) * nloc) {
            __builtin_amdgcn_fence(__ATOMIC_RELEASE, "agent");
            asm volatile("s_waitcnt vmcnt(0)" ::: "memory");
            const unsigned og = xb_add(&bar[XB_TOP], 1u);
            const unsigned tg = og / nx;
            if (og + 1u == (tg + 1u) * nx) xb_add(&bar[XB_TOPGEN], 1u);
            else XB_SPIN(xb_ld(&bar[XB_TOPGEN]) == tg, bar);
            __builtin_amdgcn_fence(__ATOMIC_ACQUIRE, "agent");
            xb_add(&bar[XB_XGEN(b.x)], 1u);
            asm volatile("s_waitcnt vmcnt(0)" ::: "memory");
        } else {
            XB_SPIN(xb_ld(&bar[XB_XGEN(b.x)]) == gen, bar);
            __builtin_amdgcn_fence(__ATOMIC_ACQUIRE, "agent");
            asm volatile("s_waitcnt vmcnt(0)" ::: "memory");
        }
    }
    __syncthreads();
}

__global__ void __launch_bounds__(512, 2) mk_fwd(Params pv) {
    extern __shared__ __attribute__((aligned(16))) unsigned char lds_raw[];
    LAS unsigned char* lds = (LAS unsigned char*)lds_raw;
    cg::grid_group grid = cg::this_grid();
    const int ph_lo = pv.ph_lo, ph_hi = pv.ph_hi;
    volatile LAS unsigned* xst = (volatile LAS unsigned*)(lds + XB_ST_OFF);
    if (threadIdx.x < 2) xst[threadIdx.x] = 0u;
    __syncthreads();
    (void)xcd_barrier_post((unsigned*)(pv.ws + WS_BAR), xst);

    for (int ph = ph_lo; ph < ph_hi; ++ph) {
        if (ph > ph_lo) { if (ph == ph_lo + 1) grid.sync(); else { XcdBarrier xb_; xb_.bar = (unsigned*)(kparams()->ws + WS_BAR); xb_.x = xb_xcc_id(); xb_.st = (volatile LAS unsigned*)(lds_opaque(lds) + XB_ST_OFF); xcd_barrier(xb_); } }
        KP p = kparams();
        const int G = grid_opaque();
        unsigned char* ws = p->ws;
        if (ph == 0) { p0_prologue(p, lds); continue; }
        if (ph == NPH - 1) { final_norm_phase(p); continue; }
        const int q = ph - 1, layer = q / 20, hb = (q / 10) % 2, sub = q % 10;
        const int row_base = hb * MH;
        const float* mod = (const float*)(ws + WS_MOD) + (size_t)layer * 16 * 6144;
        const bf16* WL = (const bf16*)(ws + WS_W) + (size_t)layer * W_LAYER;
        bf16* HBUF = (bf16*)(ws + WS_H);
        const bf16* gA = nullptr; const bf16* gB = nullptr; int nt = 0, lda = 0, ldb = 0, nN = 0, epi = -1;
        switch (sub) {
        case 0: {
            const float* xin = (layer == 0 ? p->in[0] : p->out);
            norm_mod_phase(xin + (size_t)row_base * 1024, row_base, p->in[4] + layer * 1024, mod + 0, mod + 1024, HBUF, WL + W_IN + (size_t)C_SMALL * 1024, (float*)(ws + WS_SM));
        } break;
        case 1:
            gA = HBUF; gB = WL + W_IN; nt = 16; lda = 1024; ldb = 1024; nN = ((MH + G * 8 - 1) / (G * 8) == 16) ? C_SMALL / 256 : NP / 256; epi = 0; break;
        case 2: {
            const int b = bid_opaque();
            if (b < 64) ssd_unit(p, b, layer, lds);
            else if (b < 128) hgrn_unit(p, b - 64, layer, lds);
            else if (b < 160) gdn2_unit(p, b - 128, layer, layer * 2 + hb, lds);
            else if (G - 160 >= 32 && (G - 160) % 32 == 0) {
                u32x4 xr[3][4][2]; const int st = G - 160; int j = b - 160;
                gdn1_load_rows(p, ((j & 31) << 6) | (j >> 5), xr);
                for (; j < 2048; j += st) { const int jn = j + st < 2048 ? j + st : j; gdn1_unit(p, ((j & 31) << 6) | (j >> 5), layer, lds, xr, j == b - 160, ((jn & 31) << 6) | (jn >> 5)); }
            } else {
                u32x4 xr[3][4][2]; const int st = G - 160;
                for (int j = b - 160; j < 2048; j += st) { gdn1_load_rows(p, ((j & 31) << 6) | (j >> 5), xr); gdn1_unit(p, ((j & 31) << 6) | (j >> 5), layer, lds, xr, true, ((j & 31) << 6) | (j >> 5)); }
            }
        } break;
        case 3:
            normgate_phase(p, layer);
            break;
        case 4:
            gA = (const bf16*)(ws + WS_OCAT); gB = WL + W_BR; nt = 24; lda = OC; ldb = OC; nN = 4; epi = 1; break;
        case 5:
            gA = HBUF; gB = WL + W_OUT; nt = 16; lda = 1024; ldb = 1024; nN = 4; epi = 4; break;
        case 6:
            norm_mod_phase(p->out + (size_t)row_base * 1024, row_base, p->in[22] + layer * 1024, mod + 3072, mod + 4096, HBUF, nullptr, nullptr);
            break;
        case 7:
            gA = HBUF; gB = WL + W_UP; nt = 16; lda = 1024; ldb = 1024; nN = FF2 / 256; epi = 5; break;
        case 8:
            glu_fix_phase(p, layer);
            break;
        default:
            gA = (const bf16*)(ws + WS_G); gB = WL + W_DN; nt = FF / 64; lda = FF; ldb = FF; nN = 4; epi = 6; break;
        }
        if (epi >= 0) pg8::gemm_phase(lds, gA, gB, nt, lda, ldb, nN, epi, layer, row_base);
    }
}

extern "C" void kernel_launch(void* const* d_in, const int* in_sizes, int n_in, void* d_out, int out_size, void* d_ws, size_t ws_size, hipStream_t stream) {
    static int grid = 0;
    if (grid == 0) {
        if (n_in != 28 || out_size != MTOT * DM || ws_size < WS_END) { fprintf(stderr, "kernel_launch: unexpected problem: n_in %d out %d ws %zu (need %zu)\n", n_in, out_size, ws_size, (size_t)WS_END); grid = -1; return; }
        int dev = 0, cus = 0, per_cu = 0;
        hipGetDevice(&dev); hipDeviceGetAttribute(&cus, hipDeviceAttributeMultiprocessorCount, dev);
        hipFuncSetAttribute((const void*)mk_fwd, hipFuncAttributeMaxDynamicSharedMemorySize, LDS_BYTES);
        hipOccupancyMaxActiveBlocksPerMultiprocessor(&per_cu, (const void*)mk_fwd, 512, LDS_BYTES);
        if (per_cu < 1) { fprintf(stderr, "kernel_launch: occupancy query says %d blocks per CU\n", per_cu); per_cu = 1; }
        (void)hipGetLastError();
        grid = cus;
        if (grid < 192) { fprintf(stderr, "kernel_launch: %d CUs: the mixer phase needs at least 192 workgroups\n", grid); grid = -1; return; }
    }
    if (grid < 0) return;
    Params p{};
    for (int i = 0; i < 28; ++i) p.in[i] = (const float*)d_in[i];
    p.out = (float*)d_out; p.ws = (unsigned char*)d_ws;
#if MK_COOP
    p.ph_lo = 0; p.ph_hi = NPH;
    (void)hipMemsetAsync((char*)d_ws + WS_BAR, 0, 16384, stream);
    void* args[] = {&p};
    hipError_t e = hipLaunchCooperativeKernel((const void*)mk_fwd, dim3(grid), dim3(512), args, LDS_BYTES, stream);
    if (e != hipSuccess) fprintf(stderr, "cooperative launch failed: %s (grid %d)\n", hipGetErrorString(e), grid);
#else
    for (int ph = 0; ph < NPH; ++ph) { p.ph_lo = ph; p.ph_hi = ph + 1; hipLaunchKernelGGL(mk_fwd, dim3(grid), dim3(512), LDS_BYTES, stream, p); }
#endif
}
```
